# Optimizing an MI355X kernel written in HIP

```python
import math
import jax
import jax.numpy as jnp
from jax import lax
import numpy as np

D_MODEL = 2048
BATCH = 16
SEQ = 256
DEPTH = 4
DEC_BATCH = 8
DEC_SEQ = 1024
PAST_LEN = 256

GRID_W = 64
N_MIXERS = 3
N_A = (DEPTH + 2) // 3
N_B = (DEPTH + 1) // 3
N_C = DEPTH // 3
NORM_EPS = 1e-6

MLA_HEADS = 16
QK_NOPE = 128
QK_ROPE = 64
V_HEAD = 128
KV_LORA = 512
MLA_WIDTH = MLA_HEADS * V_HEAD
MLA_NQ = MLA_HEADS * (QK_NOPE + QK_ROPE)
MLA_IN = MLA_NQ + KV_LORA + QK_ROPE + MLA_WIDTH
ROPE_BASE = 10000.0
Q_BLOCK = 128

S5_WIDTH = D_MODEL
S5_GROUP = 16
S5_GROUPS = S5_WIDTH // S5_GROUP
S5_STATE = 64
DT_MIN = 1e-3
DT_MAX = 1e-1

GLA_HEADS = 4
GLA_DK = D_MODEL // 2 // GLA_HEADS
GLA_DV = D_MODEL // GLA_HEADS
GATE_RANK = 16
GATE_NORM = 16.0
GLA_CHUNK = 64
GLA_NK = GLA_HEADS * GLA_DK
GLA_NV = GLA_HEADS * GLA_DV
GLA_IN = 2 * GLA_NK + 2 * GLA_NV + 2 * GATE_RANK

kernel_name = "hybrid_diffusion_mla_s5_gla_step"


def rms_norm(x, g):
    xf = x.astype(jnp.float32)
    y = xf * lax.rsqrt(jnp.mean(xf * xf, axis=-1, keepdims=True) + NORM_EPS)
    return (y * g.astype(jnp.float32)).astype(x.dtype)


def ada_modulation(cond, w, b):
    m = jax.nn.silu(cond) @ w + b
    shift, scale, gate = jnp.split(m[:, None, :], 3, axis=-1)
    return shift, scale, gate


def axial_rope_angles(n_tok):
    rows = n_tok // GRID_W
    row = jnp.repeat(jnp.arange(rows), GRID_W).astype(jnp.float32)
    col = jnp.tile(jnp.arange(GRID_W), rows).astype(jnp.float32)
    half = QK_ROPE // 2
    inv_freq = 1.0 / (ROPE_BASE ** (jnp.arange(0, half, 2, dtype=jnp.float32) / half))
    return row[:, None] * inv_freq, col[:, None] * inv_freq


def rotate_half_pairs(x, ang):
    x1, x2 = jnp.split(x, 2, axis=-1)
    cos = jnp.cos(ang)[:, None, :].astype(x.dtype)
    sin = jnp.sin(ang)[:, None, :].astype(x.dtype)
    return jnp.concatenate([x1 * cos - x2 * sin, x1 * sin + x2 * cos], axis=-1)


def apply_axial_rope(x, ang_row, ang_col):
    xr, xc = jnp.split(x, 2, axis=-1)
    return jnp.concatenate([rotate_half_pairs(xr, ang_row), rotate_half_pairs(xc, ang_col)], axis=-1)


def blocked_attention(q, k, v):
    b, s, h, dq = q.shape
    nb = s // Q_BLOCK
    scale = dq ** -0.5
    qb = q.reshape(b, nb, Q_BLOCK, h, dq).transpose(1, 0, 2, 3, 4)

    def one_block(qi):
        sc = jnp.einsum('bqhd,bkhd->bhqk', qi, k).astype(jnp.float32) * scale
        p = jax.nn.softmax(sc, axis=-1).astype(v.dtype)
        return jnp.einsum('bhqk,bkhd->bqhd', p, v)

    o = lax.map(one_block, qb)
    return o.transpose(1, 0, 2, 3, 4).reshape(b, s, h, v.shape[-1])


def mla_project(h, w_in, kv_norm):
    b, t, _ = h.shape
    q, ckv, krope, gate = jnp.split(h @ w_in, [MLA_NQ, MLA_NQ + KV_LORA, MLA_NQ + KV_LORA + QK_ROPE], axis=-1)
    q = q.reshape(b, t, MLA_HEADS, QK_NOPE + QK_ROPE)
    return q, rms_norm(ckv, kv_norm), krope, gate


def mla_keys_values(ckv, krope, w_ukv):
    b, t, _ = ckv.shape
    kv = (ckv @ w_ukv).reshape(b, t, MLA_HEADS, QK_NOPE + V_HEAD)
    k_nope, v = jnp.split(kv, [QK_NOPE], axis=-1)
    k_rope = jnp.broadcast_to(krope[:, :, None, :], (b, t, MLA_HEADS, QK_ROPE))
    return jnp.concatenate([k_nope, k_rope], axis=-1), v


def mla_output(o, gate, w_out):
    b, t = o.shape[:2]
    return (o.reshape(b, t, MLA_WIDTH) * jax.nn.silu(gate)) @ w_out


def mla_context(h, w_in, kv_norm, w_ukv, w_out):
    q, ckv, krope, gate = mla_project(h, w_in, kv_norm)
    k, v = mla_keys_values(ckv, krope, w_ukv)
    return mla_output(blocked_attention(q, k, v), gate, w_out), ckv, krope


def mla_latent(h, ckv_ctx, krope_ctx, w_in, kv_norm, w_ukv, w_out):
    ang_r, ang_c = axial_rope_angles(h.shape[1])
    q, ckv, krope, gate = mla_project(h, w_in, kv_norm)
    q_nope, q_rope = jnp.split(q, [QK_NOPE], axis=-1)
    q = jnp.concatenate([q_nope, apply_axial_rope(q_rope, ang_r, ang_c)], axis=-1)
    krope = apply_axial_rope(krope[:, :, None, :], ang_r, ang_c)[:, :, 0]
    ckv_all = jnp.concatenate([ckv, ckv_ctx.astype(ckv.dtype)], axis=1)
    krope_all = jnp.concatenate([krope, krope_ctx.astype(krope.dtype)], axis=1)
    k, v = mla_keys_values(ckv_all, krope_all, w_ukv)
    return mla_output(blocked_attention(q, k, v), gate, w_out)


def s5_discretise(a_re, a_im, log_dt, b_re, b_im):
    a = lax.complex(a_re.astype(jnp.float32), a_im.astype(jnp.float32))
    dt = jnp.exp(log_dt.astype(jnp.float32))[:, None]
    a_bar = jnp.exp(a * dt)
    bmat = lax.complex(b_re.astype(jnp.float32), b_im.astype(jnp.float32))
    b_bar = ((a_bar - 1.0) / a)[..., None] * bmat
    return a_bar, b_bar


def s5_scan(u, a_bar, b_bar, cmat, h0, reverse):
    length = u.shape[1]
    edge = -1 if reverse else 0
    bu = jnp.einsum('gnp,blgp->blgn', b_bar, u)
    bu = bu.at[:, edge].add(a_bar * h0)
    a = jnp.broadcast_to(a_bar, (1, length) + a_bar.shape)

    def combine(e1, e2):
        a1, b1 = e1
        a2, b2 = e2
        return a2 * a1, a2 * b1 + b2

    _, states = lax.associative_scan(combine, (a, bu), reverse=reverse, axis=1)
    y = jnp.einsum('gpn,blgn->blgp', cmat, states).real
    return y, states[:, edge]


def s5_mixer(h, h0, w_in, a_re, a_im, log_dt, b_re, b_im, c_re, c_im, d, w_glu, b_glu, w_out):
    bsz, length, _ = h.shape
    u, gate = jnp.split(h @ w_in, 2, axis=-1)
    uf = u.astype(jnp.float32)
    ug = uf.reshape(bsz, length, S5_GROUPS, S5_GROUP)
    y = d.astype(jnp.float32) * uf
    finals = []
    for di in range(2):
        a_bar, b_bar = s5_discretise(a_re[di], a_im[di], log_dt[di], b_re[di], b_im[di])
        cmat = lax.complex(c_re[di].astype(jnp.float32), c_im[di].astype(jnp.float32))
        h_init = lax.complex(h0[:, di, ..., 0].astype(jnp.float32), h0[:, di, ..., 1].astype(jnp.float32))
        yd, hf = s5_scan(ug, a_bar, b_bar, cmat, h_init, reverse=(di == 1))
        y = y + yd.reshape(bsz, length, S5_WIDTH)
        finals.append(jnp.stack([hf.real, hf.imag], axis=-1))
    y = jax.nn.gelu(y).astype(h.dtype)
    y = y * jax.nn.sigmoid(y @ w_glu + b_glu)
    out = (y * jax.nn.silu(gate)) @ w_out
    return out, jnp.stack(finals, axis=1)


def gla_direction(q, k, v, g, s0):
    bsz, length, nh, dk = q.shape
    dv = v.shape[-1]
    nc = length // GLA_CHUNK

    def chunks(x):
        return x.reshape(bsz, nc, GLA_CHUNK, nh, x.shape[-1])

    qc, kc, vc, gc = chunks(q), chunks(k), chunks(v), chunks(g)
    bcum = jnp.cumsum(gc, axis=2)
    blast = bcum[:, :, -1:]
    q_t = qc * jnp.exp(bcum)
    k_t = kc * jnp.exp(-bcum)
    k_d = kc * jnp.exp(blast - bcum)
    mask = jnp.tril(jnp.ones((GLA_CHUNK, GLA_CHUNK), dtype=bool))
    att = jnp.where(mask, jnp.einsum('bnchk,bnshk->bnhcs', q_t, k_t), 0.0)
    o_intra = jnp.einsum('bnhcs,bnshv->bnchv', att, vc)

    def step(s, xs):
        qn, kn, vn, dn = xs
        o = jnp.einsum('bchk,bhkv->bchv', qn, s)
        s = dn[..., None] * s + jnp.einsum('bchk,bchv->bhkv', kn, vn)
        return s, o

    xs = (q_t.swapaxes(0, 1), k_d.swapaxes(0, 1), vc.swapaxes(0, 1), jnp.exp(blast[:, :, 0]).swapaxes(0, 1))
    s_fin, o_inter = lax.scan(step, s0, xs)
    o = o_intra + o_inter.swapaxes(0, 1)
    return o.reshape(bsz, length, nh, dv), s_fin


def gla_mixer(h, s0, w_in, w_g2, b_g, norm_g, w_out):
    bsz, length, _ = h.shape
    q, k, v, r, glr = jnp.split(h @ w_in, [GLA_NK, 2 * GLA_NK, 2 * GLA_NK + GLA_NV, 2 * GLA_NK + 2 * GLA_NV], axis=-1)
    q = q.astype(jnp.float32).reshape(bsz, length, GLA_HEADS, GLA_DK) * (GLA_DK ** -0.5)
    k = k.astype(jnp.float32).reshape(bsz, length, GLA_HEADS, GLA_DK)
    v = v.astype(jnp.float32).reshape(bsz, length, GLA_HEADS, GLA_DV)
    glr = glr.astype(jnp.float32).reshape(bsz, length, 2, GATE_RANK)
    o = jnp.zeros((bsz, length, GLA_HEADS, GLA_DV), jnp.float32)
    finals = []
    for di in range(2):
        g = jax.nn.log_sigmoid(glr[:, :, di] @ w_g2[di].astype(jnp.float32) + b_g[di].astype(jnp.float32)) / GATE_NORM
        g = g.reshape(bsz, length, GLA_HEADS, GLA_DK)
        rev = (lambda a: jnp.flip(a, axis=1)) if di == 1 else (lambda a: a)
        od, sf = gla_direction(rev(q), rev(k), rev(v), rev(g), s0[:, di].astype(jnp.float32))
        o = o + rev(od)
        finals.append(sf)
    o = rms_norm(o, norm_g).reshape(bsz, length, GLA_NV).astype(h.dtype)
    out = (o * jax.nn.silu(r)) @ w_out
    return out, jnp.stack(finals, axis=1)


def setup_inputs(seed: int = 0) -> dict:
    key = jax.random.key(seed)
    keys = iter(jax.random.split(key, 48))
    f32 = jnp.float32

    def nrm(shape, scale=1.0):
        return jax.random.normal(next(keys), shape, f32) * scale

    x_prompt = nrm((BATCH, SEQ, D_MODEL))
    x_sample = nrm((DEC_BATCH, DEC_SEQ, D_MODEL))
    cache_mla_ckv = nrm((DEC_BATCH, N_A, PAST_LEN, KV_LORA))
    cache_mla_krope = nrm((DEC_BATCH, N_A, PAST_LEN, QK_ROPE))
    state_s5 = nrm((DEC_BATCH, N_B, 2, S5_GROUPS, S5_STATE, 2), 0.5)
    state_gla = nrm((DEC_BATCH, N_C, 2, GLA_HEADS, GLA_DK, GLA_DV))
    c = nrm((DEC_BATCH, D_MODEL))
    c_ctx = nrm((D_MODEL,))
    ada_w = nrm((DEPTH, D_MODEL, 3 * D_MODEL), 0.5 * D_MODEL ** -0.5)
    ada_b = nrm((DEPTH, 3 * D_MODEL), 0.02)
    norm_pre = 1.0 + nrm((DEPTH, D_MODEL), 0.02)
    norm_post = 1.0 + nrm((DEPTH, D_MODEL), 0.02)
    mla_w_in = nrm((N_A, D_MODEL, MLA_IN), D_MODEL ** -0.5)
    mla_kv_norm = 1.0 + nrm((N_A, KV_LORA), 0.02)
    mla_w_ukv = nrm((N_A, KV_LORA, MLA_HEADS * (QK_NOPE + V_HEAD)), KV_LORA ** -0.5)
    mla_w_out = nrm((N_A, MLA_WIDTH, D_MODEL), MLA_WIDTH ** -0.5)
    s5_w_in = nrm((N_B, D_MODEL, 2 * S5_WIDTH), D_MODEL ** -0.5)
    s5_a_re = -0.5 + nrm((N_B, 2, S5_GROUPS, S5_STATE), 0.01)
    s5_a_im = np.pi * jnp.arange(S5_STATE, dtype=f32) + nrm((N_B, 2, S5_GROUPS, S5_STATE), 0.01)
    s5_log_dt = jax.random.uniform(next(keys), (N_B, 2, S5_GROUPS), f32, math.log(DT_MIN), math.log(DT_MAX))
    s5_b_re = nrm((N_B, 2, S5_GROUPS, S5_STATE, S5_GROUP), (2.0 * S5_GROUP) ** -0.5)
    s5_b_im = nrm((N_B, 2, S5_GROUPS, S5_STATE, S5_GROUP), (2.0 * S5_GROUP) ** -0.5)
    s5_c_re = nrm((N_B, 2, S5_GROUPS, S5_GROUP, S5_STATE), (2.0 * S5_STATE) ** -0.5)
    s5_c_im = nrm((N_B, 2, S5_GROUPS, S5_GROUP, S5_STATE), (2.0 * S5_STATE) ** -0.5)
    s5_d = nrm((N_B, S5_WIDTH), 0.5)
    s5_w_glu = nrm((N_B, S5_WIDTH, S5_WIDTH), S5_WIDTH ** -0.5)
    s5_b_glu = nrm((N_B, S5_WIDTH), 0.02)
    s5_w_out = nrm((N_B, S5_WIDTH, D_MODEL), S5_WIDTH ** -0.5)
    gla_w_in = nrm((N_C, D_MODEL, GLA_IN), D_MODEL ** -0.5)
    gla_w_g2 = nrm((N_C, 2, GATE_RANK, GLA_NK), GATE_RANK ** -0.5)
    gla_b_g = nrm((N_C, 2, GLA_NK), 0.02)
    gla_norm = 1.0 + nrm((N_C, GLA_DV), 0.02)
    gla_w_out = nrm((N_C, GLA_NV, D_MODEL), GLA_NV ** -0.5)
    return {
        'x_prompt': x_prompt, 'x_sample': x_sample,
        'cache_mla_ckv': cache_mla_ckv, 'cache_mla_krope': cache_mla_krope,
        'state_s5': state_s5, 'state_gla': state_gla,
        'c': c, 'c_ctx': c_ctx,
        'ada_w': ada_w, 'ada_b': ada_b, 'norm_pre': norm_pre, 'norm_post': norm_post,
        'mla_w_in': mla_w_in, 'mla_kv_norm': mla_kv_norm, 'mla_w_ukv': mla_w_ukv, 'mla_w_out': mla_w_out,
        's5_w_in': s5_w_in, 's5_a_re': s5_a_re, 's5_a_im': s5_a_im, 's5_log_dt': s5_log_dt,
        's5_b_re': s5_b_re, 's5_b_im': s5_b_im, 's5_c_re': s5_c_re, 's5_c_im': s5_c_im,
        's5_d': s5_d, 's5_w_glu': s5_w_glu, 's5_b_glu': s5_b_glu, 's5_w_out': s5_w_out,
        'gla_w_in': gla_w_in, 'gla_w_g2': gla_w_g2, 'gla_b_g': gla_b_g, 'gla_norm': gla_norm,
        'gla_w_out': gla_w_out,
    }


def reference(x_prompt, x_sample, cache_mla_ckv, cache_mla_krope, state_s5, state_gla, c, c_ctx,
              ada_w, ada_b, norm_pre, norm_post,
              mla_w_in, mla_kv_norm, mla_w_ukv, mla_w_out,
              s5_w_in, s5_a_re, s5_a_im, s5_log_dt, s5_b_re, s5_b_im, s5_c_re, s5_c_im,
              s5_d, s5_w_glu, s5_b_glu, s5_w_out,
              gla_w_in, gla_w_g2, gla_b_g, gla_norm, gla_w_out):
    ctx_batch = x_prompt.shape[0]
    xp, xs = x_prompt, x_sample
    ckv_out, krope_out, s5_out, gla_out = [], [], [], []
    for l in range(DEPTH):
        kind, j = l % N_MIXERS, l // N_MIXERS
        shift_p, scale_p, gate_p = ada_modulation(c_ctx[None, :], ada_w[l], ada_b[l])
        shift_s, scale_s, gate_s = ada_modulation(c, ada_w[l], ada_b[l])
        hp = rms_norm(xp, norm_pre[l]) * (1.0 + scale_p) + shift_p
        hs = rms_norm(xs, norm_pre[l]) * (1.0 + scale_s) + shift_s
        if kind == 0:
            wts = (mla_w_in[j], mla_kv_norm[j], mla_w_ukv[j], mla_w_out[j])
            op, ckv, krope = mla_context(hp, *wts)
            os_ = mla_latent(hs, cache_mla_ckv[:, j], cache_mla_krope[:, j], *wts)
            ckv_out.append(ckv)
            krope_out.append(krope)
        elif kind == 1:
            wts = (s5_w_in[j], s5_a_re[j], s5_a_im[j], s5_log_dt[j], s5_b_re[j], s5_b_im[j],
                   s5_c_re[j], s5_c_im[j], s5_d[j], s5_w_glu[j], s5_b_glu[j], s5_w_out[j])
            zero_state = jnp.zeros((ctx_batch, 2, S5_GROUPS, S5_STATE, 2), jnp.float32)
            op, st = s5_mixer(hp, zero_state, *wts)
            os_, _ = s5_mixer(hs, state_s5[:, j], *wts)
            s5_out.append(st)
        else:
            wts = (gla_w_in[j], gla_w_g2[j], gla_b_g[j], gla_norm[j], gla_w_out[j])
            zero_state = jnp.zeros((ctx_batch, 2, GLA_HEADS, GLA_DK, GLA_DV), jnp.float32)
            op, st = gla_mixer(hp, zero_state, *wts)
            os_, _ = gla_mixer(hs, state_gla[:, j], *wts)
            gla_out.append(st)
        xp = xp + gate_p * rms_norm(op, norm_post[l])
        xs = xs + gate_s * rms_norm(os_, norm_post[l])
    y_prompt = xp
    y_sample = xs
    new_mla_ckv = jnp.stack(ckv_out, axis=1)
    new_mla_krope = jnp.stack(krope_out, axis=1)
    new_state_s5 = jnp.stack(s5_out, axis=1)
    new_state_gla = jnp.stack(gla_out, axis=1)
    return (y_prompt, y_sample, new_mla_ckv, new_mla_krope, new_state_s5, new_state_gla)
```

```cpp
#include <hip/hip_runtime.h>
#include <hip/hip_cooperative_groups.h>
#include <stdint.h>
#include <cstdio>
namespace cg = cooperative_groups;

#ifndef COOP
#define COOP 1
#endif

typedef unsigned short u16;
typedef short bf16x8 __attribute__((ext_vector_type(8)));
typedef short s16x4 __attribute__((ext_vector_type(4)));
typedef float f32x16 __attribute__((ext_vector_type(16)));
typedef float f32x4 __attribute__((ext_vector_type(4)));
typedef float f32x2 __attribute__((ext_vector_type(2)));
typedef unsigned u32x4 __attribute__((ext_vector_type(4)));
typedef unsigned u32x2 __attribute__((ext_vector_type(2)));
typedef __bf16 bfv2 __attribute__((ext_vector_type(2)));
#define DI __device__ __forceinline__
#define MFMA32(a, b, c) __builtin_amdgcn_mfma_f32_32x32x16_bf16((a), (b), (c), 0, 0, 0)

constexpr int D = 2048, NTOK = 12288, NCTX = 4096;
constexpr float EPS = 1e-6f;
constexpr size_t OUT_CKV = 25165824, OUT_KROPE = 29360128, OUT_S5 = 29884416, OUT_GLA = 30408704;
constexpr size_t WS_WT_MLA_IN = 0;
constexpr size_t WS_WT_MLA_UKV = WS_WT_MLA_IN + 2ull * 5760 * 2048 * 2;
constexpr size_t WS_WT_MLA_OUT = WS_WT_MLA_UKV + 2ull * 4096 * 512 * 2;
constexpr size_t WS_WT_S5_IN = WS_WT_MLA_OUT + 2ull * 2048 * 2048 * 2;
constexpr size_t WS_WT_S5_GLU = WS_WT_S5_IN + 4096ull * 2048 * 2;
constexpr size_t WS_WT_S5_OUT = WS_WT_S5_GLU + 2048ull * 2048 * 2;
constexpr size_t WS_WT_GLA_IN = WS_WT_S5_OUT + 2048ull * 2048 * 2;
constexpr size_t WS_WT_GLA_OUT = WS_WT_GLA_IN + 6272ull * 2048 * 2;
constexpr size_t WS_MOD = WS_WT_GLA_OUT + 2048ull * 2048 * 2;
constexpr size_t WS_H = WS_MOD + 4ull * 9 * 6144 * 4;
constexpr size_t WS_OP = WS_H + 12288ull * 2048 * 2;
constexpr size_t WS_SCR = WS_OP + 12288ull * 2048 * 4;
constexpr size_t A_QB = WS_SCR;
constexpr size_t A_CKVRAW = A_QB + 12288ull * 3072 * 2;
constexpr size_t A_CKVALL = A_CKVRAW + 12288ull * 512 * 4;
constexpr size_t A_SGATE = A_CKVALL + 14336ull * 512 * 2;
constexpr size_t A_KB = A_SGATE + 12288ull * 2048 * 2;
constexpr size_t A_VT = A_KB + 14336ull * 16 * 192 * 2;
constexpr size_t B_U = WS_SCR;
constexpr size_t B_SGATE = B_U + 12288ull * 2048 * 4;
constexpr size_t B_YB = B_SGATE + 12288ull * 2048 * 2;
constexpr size_t B_Z = B_YB + 12288ull * 2048 * 4;
constexpr size_t C_QG = WS_SCR;
constexpr size_t C_KG = C_QG + 12288ull * 1024 * 2;
constexpr size_t C_VT = C_KG + 12288ull * 1024 * 2;
constexpr size_t C_SGATE = C_VT + 12288ull * 2048 * 2;
constexpr size_t C_GLR = C_SGATE + 12288ull * 2048 * 2;
constexpr size_t C_QT = C_GLR + 12288ull * 32 * 4;
constexpr size_t C_KT = C_QT + 2ull * 12288 * 1024 * 2;
constexpr size_t C_KDT = C_KT + 2ull * 12288 * 1024 * 2;
constexpr size_t C_DN = C_KDT + 2ull * 12288 * 1024 * 2;
constexpr size_t C_OB = C_DN + 2ull * 192 * 1024 * 4;

struct Params {
  const float *x_prompt, *x_sample, *cache_ckv, *cache_krope, *state_s5, *state_gla, *c, *c_ctx;
  const float *ada_w, *ada_b, *norm_pre, *norm_post;
  const float *mla_w_in, *mla_kv_norm, *mla_w_ukv, *mla_w_out;
  const float *s5_w_in, *s5_a_re, *s5_a_im, *s5_log_dt, *s5_b_re, *s5_b_im, *s5_c_re, *s5_c_im, *s5_d, *s5_w_glu, *s5_b_glu, *s5_w_out;
  const float *gla_w_in, *gla_w_g2, *gla_b_g, *gla_norm, *gla_w_out;
  float* out;
  char* ws;
};

DI unsigned pk2(float a, float b) { f32x2 v; v.x = a; v.y = b; bfv2 r = __builtin_convertvector(v, bfv2); return __builtin_bit_cast(unsigned, r); }
DI u16 f2bf(float a) { return (u16)(pk2(a, 0.f) & 0xffffu); }
DI float bf2f(u16 v) { return __uint_as_float(((unsigned)v) << 16); }
DI float bflo(unsigned v) { return __uint_as_float(v << 16); }
DI float bfhi(unsigned v) { return __uint_as_float(v & 0xffff0000u); }
DI float siluf(float x) { return x / (1.f + __expf(-x)); }
DI float sigmf(float x) { return 1.f / (1.f + __expf(-x)); }
DI int crow(int reg, int h) { return (reg & 3) + 8 * (reg >> 2) + 4 * h; }
DI void st_bf4(u16* p, float a, float b, float c, float d) { u32x2 v; v.x = pk2(a, b); v.y = pk2(c, d); *(u32x2*)p = v; }
DI bf16x8 pack8(const f32x16& x, int s) {
  u32x4 p;
  p.x = pk2(x[8 * s + 0], x[8 * s + 1]); p.y = pk2(x[8 * s + 2], x[8 * s + 3]);
  p.z = pk2(x[8 * s + 4], x[8 * s + 5]); p.w = pk2(x[8 * s + 6], x[8 * s + 7]);
  return __builtin_bit_cast(bf16x8, p);
}
DI bf16x8 cat4(s16x4 lo, s16x4 hi) { return __builtin_shufflevector(lo, hi, 0, 1, 2, 3, 4, 5, 6, 7); }
DI float wave_sum(float v) {
#pragma unroll
  for (int o = 32; o >= 1; o >>= 1) v += __shfl_xor(v, o);
  return v;
}
DI int cond_of(int T) { return T < NCTX ? 8 : ((T - NCTX) >> 10); }
DI int kvrow_of(int T) { return T < NCTX ? T : NCTX + ((T - NCTX) >> 10) * 1280 + ((T - NCTX) & 1023); }

DI void ada_phase(const Params& p, float* smem) {
  const int tid = threadIdx.x;
  float* mod = (float*)(p.ws + WS_MOD);
  for (int it = blockIdx.x; it < 384; it += gridDim.x) {
    const int l = it / 96, n0 = (it % 96) * 64;
    __syncthreads();
    for (int i = tid; i < 9 * 2048; i += 256) { const int cd = i >> 11, k = i & 2047; const float v = cd < 8 ? p.c[cd * 2048 + k] : p.c_ctx[k]; smem[i] = siluf(v); }
    __syncthreads();
    const int c4 = tid & 15, ks = tid >> 4;
    const float* w = p.ada_w + (size_t)l * 2048 * 6144 + n0 + c4 * 4;
    float acc[9][4];
#pragma unroll
    for (int cd = 0; cd < 9; ++cd)
#pragma unroll
      for (int e = 0; e < 4; ++e) acc[cd][e] = 0.f;
#pragma unroll 4
    for (int kk = 0; kk < 128; ++kk) {
      const int k = ks * 128 + kk;
      const f32x4 wv = __builtin_nontemporal_load((const f32x4*)(w + (size_t)k * 6144));
#pragma unroll
      for (int cd = 0; cd < 9; ++cd) {
        const float s = smem[cd * 2048 + k];
#pragma unroll
        for (int e = 0; e < 4; ++e) acc[cd][e] += s * wv[e];
      }
    }
    __syncthreads();
#pragma unroll
    for (int cd = 0; cd < 9; ++cd)
#pragma unroll
      for (int e = 0; e < 4; ++e) smem[(ks * 9 + cd) * 64 + c4 * 4 + e] = acc[cd][e];
    __syncthreads();
    for (int o = tid; o < 576; o += 256) {
      const int cd = o >> 6, col = o & 63;
      float s = 0.f;
#pragma unroll
      for (int k2 = 0; k2 < 16; ++k2) s += smem[(k2 * 9 + cd) * 64 + col];
      mod[(size_t)(l * 9 + cd) * 6144 + n0 + col] = s + p.ada_b[l * 6144 + n0 + col];
    }
  }
  __syncthreads();
}

DI void transpose_job(const float* __restrict__ src, u16* __restrict__ dst, int K, int N, int Npad, float* tile) {
  const int tid = threadIdx.x;
  const int nkt = K / 64, total = nkt * (Npad / 64);
  for (int t = blockIdx.x; t < total; t += gridDim.x) {
    const int k0 = (t % nkt) * 64, n0 = (t / nkt) * 64;
    const int c = tid & 63, r0 = tid >> 6;
#pragma unroll
    for (int i = 0; i < 16; ++i) { const int r = r0 + 4 * i; tile[r * 65 + c] = (n0 + c < N) ? src[(size_t)(k0 + r) * N + n0 + c] : 0.f; }
    __syncthreads();
    const int n = tid >> 2, ks = (tid & 3) * 16;
    u32x4 v0, v1;
    v0.x = pk2(tile[(ks + 0) * 65 + n], tile[(ks + 1) * 65 + n]); v0.y = pk2(tile[(ks + 2) * 65 + n], tile[(ks + 3) * 65 + n]);
    v0.z = pk2(tile[(ks + 4) * 65 + n], tile[(ks + 5) * 65 + n]); v0.w = pk2(tile[(ks + 6) * 65 + n], tile[(ks + 7) * 65 + n]);
    v1.x = pk2(tile[(ks + 8) * 65 + n], tile[(ks + 9) * 65 + n]); v1.y = pk2(tile[(ks + 10) * 65 + n], tile[(ks + 11) * 65 + n]);
    v1.z = pk2(tile[(ks + 12) * 65 + n], tile[(ks + 13) * 65 + n]); v1.w = pk2(tile[(ks + 14) * 65 + n], tile[(ks + 15) * 65 + n]);
    u16* d = dst + (size_t)(n0 + n) * K + k0 + ks;
    *(u32x4*)d = v0; *(u32x4*)(d + 8) = v1;
    __syncthreads();
  }
}

DI void phase0(const Params& p, char* smem) {
  ada_phase(p, (float*)smem);
  float* tile = (float*)smem;
  char* ws = p.ws;
  for (int j = 0; j < 2; ++j) {
    transpose_job(p.mla_w_in + (size_t)j * 2048 * 5696, (u16*)(ws + WS_WT_MLA_IN) + (size_t)j * 5760 * 2048, 2048, 5696, 5760, tile);
    transpose_job(p.mla_w_ukv + (size_t)j * 512 * 4096, (u16*)(ws + WS_WT_MLA_UKV) + (size_t)j * 4096 * 512, 512, 4096, 4096, tile);
    transpose_job(p.mla_w_out + (size_t)j * 2048 * 2048, (u16*)(ws + WS_WT_MLA_OUT) + (size_t)j * 2048 * 2048, 2048, 2048, 2048, tile);
  }
  transpose_job(p.s5_w_in, (u16*)(ws + WS_WT_S5_IN), 2048, 4096, 4096, tile);
  transpose_job(p.s5_w_glu, (u16*)(ws + WS_WT_S5_GLU), 2048, 2048, 2048, tile);
  transpose_job(p.s5_w_out, (u16*)(ws + WS_WT_S5_OUT), 2048, 2048, 2048, tile);
  transpose_job(p.gla_w_in, (u16*)(ws + WS_WT_GLA_IN), 2048, 6176, 6272, tile);
  transpose_job(p.gla_w_out, (u16*)(ws + WS_WT_GLA_OUT), 2048, 2048, 2048, tile);
}

DI void norm_phase(const Params& p, int l, bool first) {
  const int lane = threadIdx.x & 63, wv = threadIdx.x >> 6;
  const float* mod = (const float*)(p.ws + WS_MOD);
  const float* OP = (const float*)(p.ws + WS_OP);
  u16* H = (u16*)(p.ws + WS_H);
  for (int T = blockIdx.x * 4 + wv; T < NTOK; T += gridDim.x * 4) {
    const int cd = cond_of(T);
    const float* xin = T < NCTX ? p.x_prompt + (size_t)T * D : p.x_sample + (size_t)(T - NCTX) * D;
    float* xrow = p.out + (size_t)T * D;
    f32x4 x[8];
    if (first) {
#pragma unroll
      for (int j = 0; j < 8; ++j) x[j] = *(const f32x4*)(xin + (j * 64 + lane) * 4);
    } else {
      const float* xold = (l == 1) ? xin : xrow;
      const float* op = OP + (size_t)T * D;
      f32x4 o[8];
      float ss = 0.f;
#pragma unroll
      for (int j = 0; j < 8; ++j) { o[j] = *(const f32x4*)(op + (j * 64 + lane) * 4); ss += o[j][0] * o[j][0] + o[j][1] * o[j][1] + o[j][2] * o[j][2] + o[j][3] * o[j][3]; }
      ss = wave_sum(ss);
      const float rstd = rsqrtf(ss * (1.f / D) + EPS);
      const float* npost = p.norm_post + (l - 1) * D;
      const float* gate = mod + (size_t)((l - 1) * 9 + cd) * 6144 + 4096;
#pragma unroll
      for (int j = 0; j < 8; ++j) {
        const int col = (j * 64 + lane) * 4;
        const f32x4 xo = *(const f32x4*)(xold + col), np = *(const f32x4*)(npost + col), g = *(const f32x4*)(gate + col);
        x[j] = xo + g * (o[j] * rstd * np);
        *(f32x4*)(xrow + col) = x[j];
      }
    }
    if (l < 4) {
      float ss = 0.f;
#pragma unroll
      for (int j = 0; j < 8; ++j) ss += x[j][0] * x[j][0] + x[j][1] * x[j][1] + x[j][2] * x[j][2] + x[j][3] * x[j][3];
      ss = wave_sum(ss);
      const float rstd = rsqrtf(ss * (1.f / D) + EPS);
      const float* npre = p.norm_pre + l * D;
      const float* sh = mod + (size_t)(l * 9 + cd) * 6144;
      u16* hrow = H + (size_t)T * D;
#pragma unroll
      for (int j = 0; j < 8; ++j) {
        const int col = (j * 64 + lane) * 4;
        const f32x4 np = *(const f32x4*)(npre + col), s1 = *(const f32x4*)(sh + col), sc = *(const f32x4*)(sh + 2048 + col);
        const f32x4 hv = x[j] * rstd * np * (1.f + sc) + s1;
        st_bf4(hrow + col, hv[0], hv[1], hv[2], hv[3]);
      }
    }
  }
}

template <bool SWAP, class Epi>
DI void gemm_tile(const u16* __restrict__ A, int lda, const u16* __restrict__ Bt, int ldb, int K, int m0, int n0, const Epi& epi, char* smem) {
  u16* As = (u16*)smem;
  u16* Bs = As + 2 * 9216;
  const int tid = threadIdx.x, lane = tid & 63, w = tid >> 6, r = lane & 31, h = lane >> 5;
  const int wm = w >> 1, wn = w & 1;
  const int lrow = tid >> 3, lseg = tid & 7;
  const u16* Ag = A + (size_t)(m0 + lrow) * lda + lseg * 8;
  const u16* Bg = Bt + (size_t)(n0 + lrow) * ldb + lseg * 8;
  u32x4 ra[4], rb[4];
  f32x16 acc[2][2];
#pragma unroll
  for (int i = 0; i < 2; ++i)
#pragma unroll
    for (int j = 0; j < 2; ++j)
#pragma unroll
      for (int e = 0; e < 16; ++e) acc[i][j][e] = 0.f;
#pragma unroll
  for (int q = 0; q < 4; ++q) { ra[q] = *(const u32x4*)(Ag + (size_t)(32 * q) * lda); rb[q] = *(const u32x4*)(Bg + (size_t)(32 * q) * ldb); }
#pragma unroll
  for (int q = 0; q < 4; ++q) { *(u32x4*)(As + (lrow + 32 * q) * 72 + lseg * 8) = ra[q]; *(u32x4*)(Bs + (lrow + 32 * q) * 72 + lseg * 8) = rb[q]; }
  __syncthreads();
  const int nk = K >> 6;
  for (int kt = 0; kt < nk; ++kt) {
    const bool more = kt + 1 < nk;
    if (more) {
      const int k0 = (kt + 1) << 6;
#pragma unroll
      for (int q = 0; q < 4; ++q) { ra[q] = *(const u32x4*)(Ag + (size_t)(32 * q) * lda + k0); rb[q] = *(const u32x4*)(Bg + (size_t)(32 * q) * ldb + k0); }
    }
    const u16* as = As + (kt & 1) * 9216 + (wm * 64 + r) * 72 + h * 8;
    const u16* bs = Bs + (kt & 1) * 9216 + (wn * 64 + r) * 72 + h * 8;
#pragma unroll
    for (int ks = 0; ks < 4; ++ks) {
      bf16x8 a[2], b[2];
      a[0] = *(const bf16x8*)(as + ks * 16); a[1] = *(const bf16x8*)(as + 32 * 72 + ks * 16);
      b[0] = *(const bf16x8*)(bs + ks * 16); b[1] = *(const bf16x8*)(bs + 32 * 72 + ks * 16);
#pragma unroll
      for (int i = 0; i < 2; ++i)
#pragma unroll
        for (int j = 0; j < 2; ++j) acc[i][j] = SWAP ? MFMA32(b[j], a[i], acc[i][j]) : MFMA32(a[i], b[j], acc[i][j]);
    }
    if (more) {
      u16* ad = As + ((kt + 1) & 1) * 9216; u16* bd = Bs + ((kt + 1) & 1) * 9216;
#pragma unroll
      for (int q = 0; q < 4; ++q) { *(u32x4*)(ad + (lrow + 32 * q) * 72 + lseg * 8) = ra[q]; *(u32x4*)(bd + (lrow + 32 * q) * 72 + lseg * 8) = rb[q]; }
    }
    __syncthreads();
  }
#pragma unroll
  for (int i = 0; i < 2; ++i)
#pragma unroll
    for (int j = 0; j < 2; ++j) epi(m0 + wm * 64 + i * 32, n0 + wn * 64 + j * 32, acc[i][j], r, h);
}

template <class F>
DI void for_tiles(int MT, int NT, const F& f) {
  const int G = gridDim.x;
  if ((G & 7) == 0 && (MT & 7) == 0) {
    const int G8 = G >> 3, xcd = blockIdx.x & 7, loc = blockIdx.x >> 3;
    const int SM = MT >> 3, SN = (NT + 7) >> 3, total = SM * SN * 64;
    for (int i = 0;; ++i) {
      const int u = (i * 8 + xcd) * G8 + loc;
      if (u >= total) break;
      const int sup = u >> 6, win = u & 63;
      const int mt = (sup % SM) * 8 + (win & 7), nt = (sup / SM) * 8 + (win >> 3);
      if (nt < NT) f(mt, nt);
    }
  } else {
    for (int t = blockIdx.x; t < MT * NT; t += G) f(t % MT, t / MT);
  }
}

DI void rope16(f32x16& v, int pos, int h) {
#pragma unroll
  for (int g = 0; g < 2; ++g)
#pragma unroll
    for (int e = 0; e < 4; ++e) {
      const int f = 8 * g + 4 * h + e;
      const float invf = exp2f(-(float)f * 0.83048202372184058696f);
      const float rev = ((float)pos * invf) * 0.15915494309189533577f;
      const float sn = __builtin_amdgcn_sinf(rev), cs = __builtin_amdgcn_cosf(rev);
      const float x1 = v[4 * g + e], x2 = v[4 * (g + 2) + e];
      v[4 * g + e] = x1 * cs - x2 * sn;
      v[4 * (g + 2) + e] = x1 * sn + x2 * cs;
    }
}

DI void mla_g1(const Params& p, int j, char* smem) {
  char* ws = p.ws;
  const u16* H = (const u16*)(ws + WS_H);
  const u16* Wt = (const u16*)(ws + WS_WT_MLA_IN) + (size_t)j * 5760 * 2048;
  u16* QB = (u16*)(ws + A_QB); float* CKVRAW = (float*)(ws + A_CKVRAW); u16* SG = (u16*)(ws + A_SGATE); u16* KB = (u16*)(ws + A_KB);
  float* okr = p.out + OUT_KROPE;
  auto epi = [&](int tm, int tn, const f32x16& acc, int r, int h) {
    const int m = tm + r;
    if (tn < 3072) {
      const int within = tn % 192;
      f32x16 v = acc;
      if (within >= 128 && m >= NCTX) { const int tl = (m - NCTX) & 1023; rope16(v, within < 160 ? (tl >> 6) : (tl & 63), h); }
#pragma unroll
      for (int g = 0; g < 4; ++g) st_bf4(QB + (size_t)m * 3072 + tn + 8 * g + 4 * h, v[4 * g], v[4 * g + 1], v[4 * g + 2], v[4 * g + 3]);
    } else if (tn < 3584) {
#pragma unroll
      for (int g = 0; g < 4; ++g) { f32x4 o = {acc[4 * g], acc[4 * g + 1], acc[4 * g + 2], acc[4 * g + 3]}; *(f32x4*)(CKVRAW + (size_t)m * 512 + (tn - 3072) + 8 * g + 4 * h) = o; }
    } else if (tn < 3648) {
      f32x16 v = acc;
      const int c0 = tn - 3584;
      if (m >= NCTX) { const int tl = (m - NCTX) & 1023; rope16(v, c0 == 0 ? (tl >> 6) : (tl & 63), h); }
      else {
        const int b = m >> 8, t = m & 255;
#pragma unroll
        for (int g = 0; g < 4; ++g) { f32x4 o = {v[4 * g], v[4 * g + 1], v[4 * g + 2], v[4 * g + 3]}; *(f32x4*)(okr + ((size_t)(b * 2 + j) * 256 + t) * 64 + c0 + 8 * g + 4 * h) = o; }
      }
      const size_t R = kvrow_of(m);
      for (int hd = 0; hd < 16; ++hd)
#pragma unroll
        for (int g = 0; g < 4; ++g) st_bf4(KB + (R * 16 + hd) * 192 + 128 + c0 + 8 * g + 4 * h, v[4 * g], v[4 * g + 1], v[4 * g + 2], v[4 * g + 3]);
    } else if (tn < 5696) {
#pragma unroll
      for (int g = 0; g < 4; ++g) st_bf4(SG + (size_t)m * 2048 + (tn - 3648) + 8 * g + 4 * h, siluf(acc[4 * g]), siluf(acc[4 * g + 1]), siluf(acc[4 * g + 2]), siluf(acc[4 * g + 3]));
    }
  };
  for_tiles(96, 45, [&](int mt, int nt) { gemm_tile<true>(H, 2048, Wt, 2048, 2048, mt * 128, nt * 128, epi, smem); });
}

DI void mla_a2(const Params& p, int j) {
  char* ws = p.ws;
  const int lane = threadIdx.x & 63, wv = threadIdx.x >> 6;
  const float* CKVRAW = (const float*)(ws + A_CKVRAW); u16* CKVALL = (u16*)(ws + A_CKVALL); u16* KB = (u16*)(ws + A_KB);
  const float* kvn = p.mla_kv_norm + j * 512;
  float* ockv = p.out + OUT_CKV;
  for (int R = blockIdx.x * 4 + wv; R < 14336; R += gridDim.x * 4) {
    int T = -1, cb = 0, ct = 0;
    if (R < NCTX) T = R;
    else { const int r2 = R - NCTX; cb = r2 / 1280; const int tp = r2 - cb * 1280; if (tp < 1024) T = NCTX + cb * 1024 + tp; else ct = tp - 1024; }
    u16* dst = CKVALL + (size_t)R * 512;
    if (T >= 0) {
      const float* src = CKVRAW + (size_t)T * 512;
      const f32x4 a = *(const f32x4*)(src + lane * 4), b = *(const f32x4*)(src + 256 + lane * 4);
      float ss = a[0] * a[0] + a[1] * a[1] + a[2] * a[2] + a[3] * a[3] + b[0] * b[0] + b[1] * b[1] + b[2] * b[2] + b[3] * b[3];
      ss = wave_sum(ss);
      const float rstd = rsqrtf(ss * (1.f / 512.f) + EPS);
      const f32x4 g0 = *(const f32x4*)(kvn + lane * 4), g1 = *(const f32x4*)(kvn + 256 + lane * 4);
      const f32x4 y0 = a * rstd * g0, y1 = b * rstd * g1;
      st_bf4(dst + lane * 4, y0[0], y0[1], y0[2], y0[3]);
      st_bf4(dst + 256 + lane * 4, y1[0], y1[1], y1[2], y1[3]);
      if (T < NCTX) {
        float* o = ockv + ((size_t)((T >> 8) * 2 + j) * 256 + (T & 255)) * 512;
        *(f32x4*)(o + lane * 4) = y0; *(f32x4*)(o + 256 + lane * 4) = y1;
      }
    } else {
      const float* src = p.cache_ckv + ((size_t)(cb * 2 + j) * 256 + ct) * 512;
      const f32x4 a = *(const f32x4*)(src + lane * 4), b = *(const f32x4*)(src + 256 + lane * 4);
      st_bf4(dst + lane * 4, a[0], a[1], a[2], a[3]);
      st_bf4(dst + 256 + lane * 4, b[0], b[1], b[2], b[3]);
      const float kr = p.cache_krope[((size_t)(cb * 2 + j) * 256 + ct) * 64 + lane];
      const u16 kb = f2bf(kr);
      for (int hd = 0; hd < 16; ++hd) KB[((size_t)R * 16 + hd) * 192 + 128 + lane] = kb;
    }
  }
}

DI void mla_g2(const Params& p, int j, char* smem) {
  char* ws = p.ws;
  const u16* CKVALL = (const u16*)(ws + A_CKVALL);
  const u16* Wt = (const u16*)(ws + WS_WT_MLA_UKV) + (size_t)j * 4096 * 512;
  u16* KB = (u16*)(ws + A_KB); u16* VT = (u16*)(ws + A_VT);
  auto epiK = [&](int tm, int tn, const f32x16& acc, int r, int h) {
    const size_t R = tm + r; const int hd = tn >> 8, wi = tn & 255;
#pragma unroll
    for (int g = 0; g < 4; ++g) st_bf4(KB + (R * 16 + hd) * 192 + wi + 8 * g + 4 * h, acc[4 * g], acc[4 * g + 1], acc[4 * g + 2], acc[4 * g + 3]);
  };
  auto epiV = [&](int tm, int tn, const f32x16& acc, int r, int h) {
    const int n = tn + r; const int hd = n >> 8, d = (n & 255) - 128;
    size_t base; int nkeys, key0;
    if (tm < NCTX) { base = (size_t)(tm >> 8) * 256 * 2048; nkeys = 256; key0 = tm & 255; }
    else { const int r2 = tm - NCTX; const int b = r2 / 1280; base = (size_t)NCTX * 2048 + (size_t)b * 1280 * 2048; nkeys = 1280; key0 = r2 - b * 1280; }
    u16* dst = VT + base + (size_t)(hd * 128 + d) * nkeys + key0;
#pragma unroll
    for (int g = 0; g < 4; ++g) st_bf4(dst + 8 * g + 4 * h, acc[4 * g], acc[4 * g + 1], acc[4 * g + 2], acc[4 * g + 3]);
  };
  for_tiles(112, 32, [&](int mt, int nt) {
    if ((nt & 1) == 0) gemm_tile<true>(CKVALL, 512, Wt, 512, 512, mt * 128, nt * 128, epiK, smem);
    else gemm_tile<false>(CKVALL, 512, Wt, 512, 512, mt * 128, nt * 128, epiV, smem);
  });
}

DI void mla_attn(const Params& p) {
  char* ws = p.ws;
  const u16* QB = (const u16*)(ws + A_QB); const u16* KB = (const u16*)(ws + A_KB); const u16* VT = (const u16*)(ws + A_VT); const u16* SG = (const u16*)(ws + A_SGATE);
  u16* OG = (u16*)(ws + WS_H);
  const int lane = threadIdx.x & 63, w = threadIdx.x >> 6, r = lane & 31, h = lane >> 5;
  const float SC = 0.07216878364870322f * 1.4426950408889634f;
  for (int it = blockIdx.x; it < 1536; it += gridDim.x) {
    int head, T0, R0, nkeys; size_t vbase;
    if (it < 1024) { const int b = it >> 7; head = (it >> 3) & 15; T0 = NCTX + b * 1024 + (it & 7) * 128; R0 = NCTX + b * 1280; nkeys = 1280; vbase = (size_t)NCTX * 2048 + (size_t)b * 1280 * 2048; }
    else { const int i2 = it - 1024; const int b = i2 >> 5; head = (i2 >> 1) & 15; T0 = b * 256 + (i2 & 1) * 128; R0 = b * 256; nkeys = 256; vbase = (size_t)b * 256 * 2048; }
    T0 += w * 32;
    bf16x8 qf[12];
    const u16* qp = QB + (size_t)(T0 + r) * 3072 + head * 192 + 8 * h;
#pragma unroll
    for (int ks = 0; ks < 12; ++ks) qf[ks] = *(const bf16x8*)(qp + ks * 16);
    f32x16 O[4];
#pragma unroll
    for (int dt = 0; dt < 4; ++dt)
#pragma unroll
      for (int e = 0; e < 16; ++e) O[dt][e] = 0.f;
    float mrun = -INFINITY, lrun = 0.f;
    const u16* kp = KB + ((size_t)(R0 + r) * 16 + head) * 192 + 8 * h;
    const u16* vp = VT + vbase + (size_t)(head * 128 + r) * nkeys + 4 * h;
    for (int kt = 0; kt < nkeys; kt += 32) {
      f32x16 S;
#pragma unroll
      for (int e = 0; e < 16; ++e) S[e] = 0.f;
      const u16* kq = kp + (size_t)kt * 16 * 192;
#pragma unroll
      for (int ks = 0; ks < 12; ++ks) { const bf16x8 kf = *(const bf16x8*)(kq + ks * 16); S = MFMA32(kf, qf[ks], S); }
      float mx = -INFINITY;
#pragma unroll
      for (int e = 0; e < 16; ++e) { S[e] *= SC; mx = fmaxf(mx, S[e]); }
      mx = fmaxf(mx, __shfl_xor(mx, 32));
      const float mnew = fmaxf(mrun, mx);
      const float alpha = __builtin_amdgcn_exp2f(mrun - mnew);
      mrun = mnew;
      float ps = 0.f;
#pragma unroll
      for (int e = 0; e < 16; ++e) { S[e] = __builtin_amdgcn_exp2f(S[e] - mnew); ps += S[e]; }
      lrun = lrun * alpha + ps;
#pragma unroll
      for (int dt = 0; dt < 4; ++dt)
#pragma unroll
        for (int e = 0; e < 16; ++e) O[dt][e] *= alpha;
#pragma unroll
      for (int s = 0; s < 2; ++s) {
        const bf16x8 pf = pack8(S, s);
#pragma unroll
        for (int dt = 0; dt < 4; ++dt) {
          const u16* vq = vp + (size_t)(dt * 32) * nkeys + kt + 16 * s;
          const s16x4 lo = *(const s16x4*)vq, hi = *(const s16x4*)(vq + 8);
          O[dt] = MFMA32(cat4(lo, hi), pf, O[dt]);
        }
      }
    }
    lrun += __shfl_xor(lrun, 32);
    const float inv = 1.f / lrun;
#pragma unroll
    for (int dt = 0; dt < 4; ++dt)
#pragma unroll
      for (int g = 0; g < 4; ++g) {
        const size_t o = (size_t)(T0 + r) * 2048 + head * 128 + dt * 32 + 8 * g + 4 * h;
        const u32x2 sg = *(const u32x2*)(SG + o);
        st_bf4(OG + o, O[dt][4 * g] * inv * bflo(sg.x), O[dt][4 * g + 1] * inv * bfhi(sg.x), O[dt][4 * g + 2] * inv * bflo(sg.y), O[dt][4 * g + 3] * inv * bfhi(sg.y));
      }
  }
}

DI void gemm_out(const Params& p, const u16* A, const u16* Wt, char* smem) {
  float* OP = (float*)(p.ws + WS_OP);
  auto epi = [&](int tm, int tn, const f32x16& acc, int r, int h) {
    const size_t m = tm + r;
#pragma unroll
    for (int g = 0; g < 4; ++g) { f32x4 o = {acc[4 * g], acc[4 * g + 1], acc[4 * g + 2], acc[4 * g + 3]}; *(f32x4*)(OP + m * 2048 + tn + 8 * g + 4 * h) = o; }
  };
  for_tiles(96, 16, [&](int mt, int nt) { gemm_tile<true>(A, 2048, Wt, 2048, 2048, mt * 128, nt * 128, epi, smem); });
}

DI void s5_g1(const Params& p, char* smem) {
  char* ws = p.ws;
  const u16* H = (const u16*)(ws + WS_H); const u16* Wt = (const u16*)(ws + WS_WT_S5_IN);
  float* U = (float*)(ws + B_U); u16* SG = (u16*)(ws + B_SGATE);
  auto epi = [&](int tm, int tn, const f32x16& acc, int r, int h) {
    const size_t m = tm + r;
    if (tn < 2048) {
#pragma unroll
      for (int g = 0; g < 4; ++g) { f32x4 o = {acc[4 * g], acc[4 * g + 1], acc[4 * g + 2], acc[4 * g + 3]}; *(f32x4*)(U + m * 2048 + tn + 8 * g + 4 * h) = o; }
    } else {
#pragma unroll
      for (int g = 0; g < 4; ++g) st_bf4(SG + m * 2048 + (tn - 2048) + 8 * g + 4 * h, siluf(acc[4 * g]), siluf(acc[4 * g + 1]), siluf(acc[4 * g + 2]), siluf(acc[4 * g + 3]));
    }
  };
  for_tiles(96, 32, [&](int mt, int nt) { gemm_tile<true>(H, 2048, Wt, 2048, 2048, mt * 128, nt * 128, epi, smem); });
}

DI void s5_scan(const Params& p) {
  char* ws = p.ws;
  const float* U = (const float*)(ws + B_U);
  float* YF = (float*)(ws + WS_OP); float* YB = (float*)(ws + B_YB);
  const int lane = threadIdx.x & 63;
  const int w = __builtin_amdgcn_readfirstlane(threadIdx.x >> 6);
  const bool b5 = lane & 32, b4 = lane & 16, b3 = lane & 8, b2 = lane & 4;
  const int pout = (b5 ? 8 : 0) + (b4 ? 4 : 0) + (b3 ? 2 : 0) + (b2 ? 1 : 0);
  for (int it = blockIdx.x * 4 + w; it < 6144; it += gridDim.x * 4) {
    const int dir = it & 1; int rest = it >> 1;
    const bool lat = rest < 1024;
    int b, g, L, T0;
    if (lat) { b = rest >> 7; g = rest & 127; L = 1024; T0 = NCTX + b * 1024; }
    else { rest -= 1024; b = rest >> 7; g = rest & 127; L = 256; T0 = b * 256; }
    const int n = lane;
    const int pidx = (dir * 128 + g) * 64 + n;
    const float are = p.s5_a_re[pidx], aim = p.s5_a_im[pidx];
    const float dt = __expf(p.s5_log_dt[dir * 128 + g]);
    const float mag = __expf(are * dt), rev = (aim * dt) * 0.15915494309189533577f;
    const float abr = mag * __builtin_amdgcn_cosf(rev), abi = mag * __builtin_amdgcn_sinf(rev);
    const float nr = abr - 1.f, ni = abi, den = 1.f / (are * are + aim * aim);
    const float cr = (nr * are + ni * aim) * den, ci = (ni * are - nr * aim) * den;
    float bre[16], bim[16], cre[16], cim[16];
    {
      const float* br = p.s5_b_re + (size_t)pidx * 16; const float* bi = p.s5_b_im + (size_t)pidx * 16;
#pragma unroll
      for (int q = 0; q < 4; ++q) {
        const f32x4 x = *(const f32x4*)(br + 4 * q), y = *(const f32x4*)(bi + 4 * q);
#pragma unroll
        for (int e = 0; e < 4; ++e) { bre[4 * q + e] = cr * x[e] - ci * y[e]; bim[4 * q + e] = cr * y[e] + ci * x[e]; }
      }
      const float* c1 = p.s5_c_re + (size_t)(dir * 128 + g) * 16 * 64 + n; const float* c2 = p.s5_c_im + (size_t)(dir * 128 + g) * 16 * 64 + n;
#pragma unroll
      for (int q = 0; q < 16; ++q) { cre[q] = c1[q * 64]; cim[q] = c2[q * 64]; }
    }
    float hr = 0.f, hi = 0.f;
    if (lat) { const float* s0 = p.state_s5 + ((size_t)((b * 2 + dir) * 128 + g) * 64 + n) * 2; hr = s0[0]; hi = s0[1]; }
    float* Y = dir ? YB : YF;
    const float* ub = U + (size_t)T0 * 2048 + g * 16;
    const int t0 = dir ? L - 1 : 0, tstep = dir ? -1 : 1;
    f32x4 un[4];
#pragma unroll
    for (int q = 0; q < 4; ++q) un[q] = *(const f32x4*)(ub + (size_t)t0 * 2048 + 4 * q);
    int t = t0;
    for (int s = 0; s < L; ++s) {
      f32x4 u[4];
#pragma unroll
      for (int q = 0; q < 4; ++q) u[q] = un[q];
      const int tn = (s + 1 < L) ? t + tstep : t;
#pragma unroll
      for (int q = 0; q < 4; ++q) un[q] = *(const f32x4*)(ub + (size_t)tn * 2048 + 4 * q);
      float br_ = 0.f, bi_ = 0.f;
#pragma unroll
      for (int q = 0; q < 16; ++q) { br_ += bre[q] * u[q >> 2][q & 3]; bi_ += bim[q] * u[q >> 2][q & 3]; }
      const float nhr = abr * hr - abi * hi + br_, nhi = abr * hi + abi * hr + bi_;
      hr = nhr; hi = nhi;
      if (!lat && s == 0) { float* so = p.out + OUT_S5 + ((size_t)((b * 2 + dir) * 128 + g) * 64 + n) * 2; so[0] = hr; so[1] = hi; }
      float v[16];
#pragma unroll
      for (int q = 0; q < 16; ++q) v[q] = cre[q] * hr - cim[q] * hi;
      float w8[8], w4[4], w2[2];
#pragma unroll
      for (int q = 0; q < 8; ++q) { const float keep = b5 ? v[q + 8] : v[q], send = b5 ? v[q] : v[q + 8]; w8[q] = keep + __shfl_xor(send, 32); }
#pragma unroll
      for (int q = 0; q < 4; ++q) { const float keep = b4 ? w8[q + 4] : w8[q], send = b4 ? w8[q] : w8[q + 4]; w4[q] = keep + __shfl_xor(send, 16); }
#pragma unroll
      for (int q = 0; q < 2; ++q) { const float keep = b3 ? w4[q + 2] : w4[q], send = b3 ? w4[q] : w4[q + 2]; w2[q] = keep + __shfl_xor(send, 8); }
      float w1;
      { const float keep = b2 ? w2[1] : w2[0], send = b2 ? w2[0] : w2[1]; w1 = keep + __shfl_xor(send, 4); }
      w1 += __shfl_xor(w1, 2);
      w1 += __shfl_xor(w1, 1);
      if ((lane & 3) == 0) Y[(size_t)(T0 + t) * 2048 + g * 16 + pout] = w1;
      t = tn;
    }
  }
}

DI float gelu_tanh(float x) {
  const float t = 0.7978845608028654f * (x + 0.044715f * x * x * x);
  const float e = __expf(2.f * t);
  const float th = 1.f - 2.f / (e + 1.f);
  return 0.5f * x * (1.f + th);
}

DI void s5_combine(const Params& p) {
  char* ws = p.ws;
  const float* U = (const float*)(ws + B_U); const float* YF = (const float*)(ws + WS_OP); const float* YB = (const float*)(ws + B_YB);
  u16* YG = (u16*)(ws + WS_H);
  const size_t n4 = (size_t)NTOK * 2048 / 4;
  for (size_t i = (size_t)blockIdx.x * 256 + threadIdx.x; i < n4; i += (size_t)gridDim.x * 256) {
    const int col = (int)((i * 4) & 2047);
    const f32x4 u = *(const f32x4*)(U + i * 4), a = *(const f32x4*)(YF + i * 4), b = *(const f32x4*)(YB + i * 4), d = *(const f32x4*)(p.s5_d + col);
    const f32x4 y = d * u + a + b;
    st_bf4(YG + i * 4, gelu_tanh(y[0]), gelu_tanh(y[1]), gelu_tanh(y[2]), gelu_tanh(y[3]));
  }
}

DI void s5_g2(const Params& p, char* smem) {
  char* ws = p.ws;
  const u16* YG = (const u16*)(ws + WS_H); const u16* Wt = (const u16*)(ws + WS_WT_S5_GLU); const u16* SG = (const u16*)(ws + B_SGATE);
  u16* Z = (u16*)(ws + B_Z);
  auto epi = [&](int tm, int tn, const f32x16& acc, int r, int h) {
    const size_t m = tm + r;
#pragma unroll
    for (int g = 0; g < 4; ++g) {
      const int n = tn + 8 * g + 4 * h;
      const f32x4 bg = *(const f32x4*)(p.s5_b_glu + n);
      const u32x2 yv = *(const u32x2*)(YG + m * 2048 + n), sg = *(const u32x2*)(SG + m * 2048 + n);
      st_bf4(Z + m * 2048 + n, bflo(yv.x) * sigmf(acc[4 * g] + bg[0]) * bflo(sg.x), bfhi(yv.x) * sigmf(acc[4 * g + 1] + bg[1]) * bfhi(sg.x),
             bflo(yv.y) * sigmf(acc[4 * g + 2] + bg[2]) * bflo(sg.y), bfhi(yv.y) * sigmf(acc[4 * g + 3] + bg[3]) * bfhi(sg.y));
    }
  };
  for_tiles(96, 16, [&](int mt, int nt) { gemm_tile<true>(YG, 2048, Wt, 2048, 2048, mt * 128, nt * 128, epi, smem); });
}

DI void gla_g1(const Params& p, char* smem) {
  char* ws = p.ws;
  const u16* H = (const u16*)(ws + WS_H); const u16* Wt = (const u16*)(ws + WS_WT_GLA_IN);
  u16* QG = (u16*)(ws + C_QG); u16* KG = (u16*)(ws + C_KG); u16* VT = (u16*)(ws + C_VT); u16* SG = (u16*)(ws + C_SGATE); float* GLR = (float*)(ws + C_GLR);
  auto epi = [&](int tm, int tn, const f32x16& acc, int r, int h) {
    const size_t m = tm + r;
    if (tn < 1024) {
#pragma unroll
      for (int g = 0; g < 4; ++g) st_bf4(QG + m * 1024 + tn + 8 * g + 4 * h, acc[4 * g] * 0.0625f, acc[4 * g + 1] * 0.0625f, acc[4 * g + 2] * 0.0625f, acc[4 * g + 3] * 0.0625f);
    } else if (tn < 2048) {
#pragma unroll
      for (int g = 0; g < 4; ++g) st_bf4(KG + m * 1024 + (tn - 1024) + 8 * g + 4 * h, acc[4 * g], acc[4 * g + 1], acc[4 * g + 2], acc[4 * g + 3]);
    } else if (tn >= 4096 && tn < 6144) {
#pragma unroll
      for (int g = 0; g < 4; ++g) st_bf4(SG + m * 2048 + (tn - 4096) + 8 * g + 4 * h, siluf(acc[4 * g]), siluf(acc[4 * g + 1]), siluf(acc[4 * g + 2]), siluf(acc[4 * g + 3]));
    } else if (tn == 6144) {
#pragma unroll
      for (int g = 0; g < 4; ++g) { f32x4 o = {acc[4 * g], acc[4 * g + 1], acc[4 * g + 2], acc[4 * g + 3]}; *(f32x4*)(GLR + m * 32 + 8 * g + 4 * h) = o; }
    }
  };
  auto epiV = [&](int tm, int tn, const f32x16& acc, int r, int h) {
    const int dv = tn - 2048 + r;
    u16* dst = VT + ((size_t)(tm >> 6) * 2048 + dv) * 64 + (tm & 63);
#pragma unroll
    for (int g = 0; g < 4; ++g) st_bf4(dst + 8 * g + 4 * h, acc[4 * g], acc[4 * g + 1], acc[4 * g + 2], acc[4 * g + 3]);
  };
  for_tiles(96, 49, [&](int mt, int nt) {
    if (nt >= 16 && nt < 32) gemm_tile<false>(H, 2048, Wt, 2048, 2048, mt * 128, nt * 128, epiV, smem);
    else gemm_tile<true>(H, 2048, Wt, 2048, 2048, mt * 128, nt * 128, epi, smem);
  });
}

DI float logsigf(float z) { return fminf(z, 0.f) - __logf(1.f + __expf(-fabsf(z))); }

DI void gla_gate(const Params& p, float* smem) {
  char* ws = p.ws;
  const u16* QG = (const u16*)(ws + C_QG); const u16* KG = (const u16*)(ws + C_KG); const float* GLR = (const float*)(ws + C_GLR);
  u16* QT = (u16*)(ws + C_QT); u16* KT = (u16*)(ws + C_KT); u16* KDT = (u16*)(ws + C_KDT); float* DN = (float*)(ws + C_DN);
  const int tid = threadIdx.x;
  for (int it = blockIdx.x; it < 1536; it += gridDim.x) {
    const int dir = it & 1, hd = (it >> 1) & 3, c = it >> 3;
    const int ch = hd * 256 + tid;
    __syncthreads();
    for (int i = tid; i < 1024; i += 256) smem[i] = GLR[(size_t)(c * 64 + (i >> 4)) * 32 + dir * 16 + (i & 15)];
    __syncthreads();
    float wg[16];
#pragma unroll
    for (int q = 0; q < 16; ++q) wg[q] = p.gla_w_g2[(size_t)(dir * 16 + q) * 1024 + ch];
    const float bg = p.gla_b_g[dir * 1024 + ch];
    float tot = 0.f;
    for (int i = 0; i < 64; ++i) {
      float z = bg;
#pragma unroll
      for (int q = 0; q < 16; ++q) z += smem[i * 16 + q] * wg[q];
      tot += logsigf(z) * 0.0625f;
    }
    DN[(size_t)(dir * 192 + c) * 1024 + ch] = __expf(tot);
    float run = 0.f;
    u16* kdrow = KDT + ((size_t)((dir * 192 + c) * 4 + hd) * 256 + tid) * 64;
    for (int i8 = 0; i8 < 8; ++i8) {
      float kdv[8];
#pragma unroll
      for (int e = 0; e < 8; ++e) {
        const int ii = i8 * 8 + e;
        const int i = dir ? 63 - ii : ii;
        float z = bg;
#pragma unroll
        for (int q = 0; q < 16; ++q) z += smem[i * 16 + q] * wg[q];
        run += logsigf(z) * 0.0625f;
        const size_t T = (size_t)c * 64 + i;
        const float q_ = bf2f(QG[T * 1024 + ch]), k_ = bf2f(KG[T * 1024 + ch]);
        QT[((size_t)dir * NTOK + T) * 1024 + ch] = f2bf(q_ * __expf(run));
        KT[((size_t)dir * NTOK + T) * 1024 + ch] = f2bf(k_ * __expf(-run));
        kdv[e] = k_ * __expf(tot - run);
      }
      u32x4 pk;
      if (dir) { pk.x = pk2(kdv[7], kdv[6]); pk.y = pk2(kdv[5], kdv[4]); pk.z = pk2(kdv[3], kdv[2]); pk.w = pk2(kdv[1], kdv[0]); }
      else { pk.x = pk2(kdv[0], kdv[1]); pk.y = pk2(kdv[2], kdv[3]); pk.z = pk2(kdv[4], kdv[5]); pk.w = pk2(kdv[6], kdv[7]); }
      const int tb = dir ? 56 - i8 * 8 : i8 * 8;
      *(u32x4*)(kdrow + tb) = pk;
    }
  }
  __syncthreads();
}

DI void gla_main(const Params& p, char* smem) {
  char* ws = p.ws;
  const u16* QT = (const u16*)(ws + C_QT); const u16* KT = (const u16*)(ws + C_KT); const u16* KDT = (const u16*)(ws + C_KDT); const u16* VT = (const u16*)(ws + C_VT);
  const float* DN = (const float*)(ws + C_DN);
  float* OF = (float*)(ws + WS_OP); float* OB = (float*)(ws + C_OB);
  u16* att = (u16*)smem;
  const int lane = threadIdx.x & 63, w = threadIdx.x >> 6, r = lane & 31, h = lane >> 5;
  for (int it = blockIdx.x; it < 768; it += gridDim.x) {
    const bool lat = it < 256;
    const int i2 = lat ? it : it - 256;
    const int bs = i2 >> 5, hd = (i2 >> 3) & 3, dir = (i2 >> 2) & 1, sl = i2 & 3;
    const int nc = lat ? 16 : 4, T0 = lat ? NCTX + bs * 1024 : bs * 256;
    const int vcol0 = hd * 512 + sl * 128 + w * 32;
    f32x16 S[8];
    if (lat) {
      const float* s0 = p.state_gla + ((size_t)((bs * 2 + dir) * 4 + hd) * 256) * 512 + (sl * 128 + w * 32 + r);
#pragma unroll
      for (int mt = 0; mt < 8; ++mt)
#pragma unroll
        for (int e = 0; e < 16; ++e) S[mt][e] = s0[(size_t)(32 * mt + crow(e, h)) * 512];
    } else {
#pragma unroll
      for (int mt = 0; mt < 8; ++mt)
#pragma unroll
        for (int e = 0; e < 16; ++e) S[mt][e] = 0.f;
    }
    float* OD = dir ? OB : OF;
    for (int cc = 0; cc < nc; ++cc) {
      const int c = dir ? nc - 1 - cc : cc;
      const int Tc = T0 + c * 64, cgx = Tc >> 6;
      const u16* qt = QT + ((size_t)dir * NTOK + Tc) * 1024 + hd * 256;
      const u16* kt = KT + ((size_t)dir * NTOK + Tc) * 1024 + hd * 256;
      const u16* kdT = KDT + ((size_t)((dir * 192 + cgx) * 4 + hd) * 256) * 64;
      const u16* vT = VT + ((size_t)cgx * 2048 + vcol0 + r) * 64;
      const float* dn = DN + (size_t)(dir * 192 + cgx) * 1024 + hd * 256;
      {
        f32x16 a;
#pragma unroll
        for (int e = 0; e < 16; ++e) a[e] = 0.f;
        const int ci = w >> 1, si = w & 1;
        const u16* qa = qt + (size_t)(32 * ci + r) * 1024 + 8 * h; const u16* kb = kt + (size_t)(32 * si + r) * 1024 + 8 * h;
#pragma unroll
        for (int ks = 0; ks < 16; ++ks) a = MFMA32(*(const bf16x8*)(qa + ks * 16), *(const bf16x8*)(kb + ks * 16), a);
#pragma unroll
        for (int e = 0; e < 16; ++e) {
          const int cr_ = 32 * ci + crow(e, h), sc_ = 32 * si + r;
          const bool keep = dir ? (sc_ >= cr_) : (sc_ <= cr_);
          att[cr_ * 72 + sc_] = keep ? f2bf(a[e]) : (u16)0;
        }
      }
      __syncthreads();
      f32x16 o[2];
#pragma unroll
      for (int q = 0; q < 2; ++q)
#pragma unroll
        for (int e = 0; e < 16; ++e) o[q][e] = 0.f;
#pragma unroll
      for (int mt = 0; mt < 8; ++mt)
#pragma unroll
        for (int s = 0; s < 2; ++s) {
          const bf16x8 sf = pack8(S[mt], s);
#pragma unroll
          for (int q = 0; q < 2; ++q) {
            const u16* qa = qt + (size_t)(32 * q + r) * 1024 + 32 * mt + 16 * s + 4 * h;
            const s16x4 lo = *(const s16x4*)qa, hi = *(const s16x4*)(qa + 8);
            o[q] = MFMA32(cat4(lo, hi), sf, o[q]);
          }
        }
      bf16x8 vf[4];
#pragma unroll
      for (int ks = 0; ks < 4; ++ks) vf[ks] = *(const bf16x8*)(vT + ks * 16 + 8 * h);
#pragma unroll
      for (int q = 0; q < 2; ++q)
#pragma unroll
        for (int ks = 0; ks < 4; ++ks) { const bf16x8 af = *(const bf16x8*)(att + (32 * q + r) * 72 + ks * 16 + 8 * h); o[q] = MFMA32(af, vf[ks], o[q]); }
#pragma unroll
      for (int q = 0; q < 2; ++q)
#pragma unroll
        for (int e = 0; e < 16; ++e) OD[(size_t)(Tc + 32 * q + crow(e, h)) * 2048 + vcol0 + r] = o[q][e];
#pragma unroll
      for (int mt = 0; mt < 8; ++mt) {
#pragma unroll
        for (int g = 0; g < 4; ++g) {
          const f32x4 d4 = *(const f32x4*)(dn + 32 * mt + 8 * g + 4 * h);
#pragma unroll
          for (int e = 0; e < 4; ++e) S[mt][4 * g + e] *= d4[e];
        }
#pragma unroll
        for (int ks = 0; ks < 4; ++ks) { const bf16x8 af = *(const bf16x8*)(kdT + (size_t)(32 * mt + r) * 64 + ks * 16 + 8 * h); S[mt] = MFMA32(af, vf[ks], S[mt]); }
      }
      __syncthreads();
    }
    if (!lat) {
      float* so = p.out + OUT_GLA + ((size_t)((bs * 2 + dir) * 4 + hd) * 256) * 512 + (sl * 128 + w * 32 + r);
#pragma unroll
      for (int mt = 0; mt < 8; ++mt)
#pragma unroll
        for (int e = 0; e < 16; ++e) so[(size_t)(32 * mt + crow(e, h)) * 512] = S[mt][e];
    }
  }
}

DI void gla_norm(const Params& p) {
  char* ws = p.ws;
  const float* OF = (const float*)(ws + WS_OP); const float* OB = (const float*)(ws + C_OB); const u16* SG = (const u16*)(ws + C_SGATE);
  u16* OG = (u16*)(ws + WS_H);
  const int lane = threadIdx.x & 63, wv = threadIdx.x >> 6;
  for (int T = blockIdx.x * 4 + wv; T < NTOK; T += gridDim.x * 4) {
    f32x4 x[8];
    float ss[4] = {0.f, 0.f, 0.f, 0.f};
#pragma unroll
    for (int j = 0; j < 8; ++j) {
      const size_t o = (size_t)T * 2048 + (j * 64 + lane) * 4;
      x[j] = *(const f32x4*)(OF + o) + *(const f32x4*)(OB + o);
      ss[j >> 1] += x[j][0] * x[j][0] + x[j][1] * x[j][1] + x[j][2] * x[j][2] + x[j][3] * x[j][3];
    }
#pragma unroll
    for (int q = 0; q < 4; ++q) ss[q] = rsqrtf(wave_sum(ss[q]) * (1.f / 512.f) + EPS);
#pragma unroll
    for (int j = 0; j < 8; ++j) {
      const int col = (j * 64 + lane) * 4;
      const size_t o = (size_t)T * 2048 + col;
      const f32x4 ng = *(const f32x4*)(p.gla_norm + (col & 511));
      const u32x2 sg = *(const u32x2*)(SG + o);
      const f32x4 y = x[j] * ss[j >> 1] * ng;
      st_bf4(OG + o, y[0] * bflo(sg.x), y[1] * bfhi(sg.x), y[2] * bflo(sg.y), y[3] * bfhi(sg.y));
    }
  }
}

constexpr int NPHASE = 26;
template <int PH>
DI void run_phase(const Params& p, char* smem) {
  char* ws = p.ws;
  if constexpr (PH == 0) phase0(p, smem);
  else if constexpr (PH == 1) norm_phase(p, 0, true);
  else if constexpr (PH == 2) mla_g1(p, 0, smem);
  else if constexpr (PH == 3) mla_a2(p, 0);
  else if constexpr (PH == 4) mla_g2(p, 0, smem);
  else if constexpr (PH == 5) mla_attn(p);
  else if constexpr (PH == 6) gemm_out(p, (const u16*)(ws + WS_H), (const u16*)(ws + WS_WT_MLA_OUT), smem);
  else if constexpr (PH == 7) norm_phase(p, 1, false);
  else if constexpr (PH == 8) s5_g1(p, smem);
  else if constexpr (PH == 9) s5_scan(p);
  else if constexpr (PH == 10) s5_combine(p);
  else if constexpr (PH == 11) s5_g2(p, smem);
  else if constexpr (PH == 12) gemm_out(p, (const u16*)(ws + B_Z), (const u16*)(ws + WS_WT_S5_OUT), smem);
  else if constexpr (PH == 13) norm_phase(p, 2, false);
  else if constexpr (PH == 14) gla_g1(p, smem);
  else if constexpr (PH == 15) gla_gate(p, (float*)smem);
  else if constexpr (PH == 16) gla_main(p, smem);
  else if constexpr (PH == 17) gla_norm(p);
  else if constexpr (PH == 18) gemm_out(p, (const u16*)(ws + WS_H), (const u16*)(ws + WS_WT_GLA_OUT), smem);
  else if constexpr (PH == 19) norm_phase(p, 3, false);
  else if constexpr (PH == 20) mla_g1(p, 1, smem);
  else if constexpr (PH == 21) mla_a2(p, 1);
  else if constexpr (PH == 22) mla_g2(p, 1, smem);
  else if constexpr (PH == 23) mla_attn(p);
  else if constexpr (PH == 24) gemm_out(p, (const u16*)(ws + WS_H), (const u16*)(ws + WS_WT_MLA_OUT) + (size_t)2048 * 2048, smem);
  else if constexpr (PH == 25) norm_phase(p, 4, false);
}

template <int PH>
DI void run_from(const Params& p, char* smem, cg::grid_group& grid) {
  run_phase<PH>(p, smem);
  if constexpr (PH + 1 < NPHASE) { grid.sync(); run_from<PH + 1>(p, smem, grid); }
}

#if COOP
__global__ void __launch_bounds__(256, 2) mega(Params p) {
  __shared__ __attribute__((aligned(16))) char smem[73728];
  cg::grid_group grid = cg::this_grid();
  run_from<0>(p, smem, grid);
}
#else
template <int PH>
__global__ void __launch_bounds__(256, 2) phase_k(Params p) {
  __shared__ __attribute__((aligned(16))) char smem[73728];
  run_phase<PH>(p, smem);
}
template <int PH>
static void launch_from(const Params& p, int grid, hipStream_t stream) {
  hipLaunchKernelGGL(phase_k<PH>, dim3(grid), dim3(256), 0, stream, p);
  if constexpr (PH + 1 < NPHASE) launch_from<PH + 1>(p, grid, stream);
}
#endif

extern "C" void kernel_launch(void* const* d_in, const int* in_sizes, int n_in, void* d_out, int out_size, void* d_ws, size_t ws_size, hipStream_t stream) {
  static int grid_blocks = 0;
  if (!grid_blocks) {
    int dev = 0, cus = 0, per_cu = 0;
    (void)hipGetDevice(&dev);
    (void)hipDeviceGetAttribute(&cus, hipDeviceAttributeMultiprocessorCount, dev);
#if COOP
    (void)hipOccupancyMaxActiveBlocksPerMultiprocessor(&per_cu, mega, 256, 0);
#else
    per_cu = 2;
#endif
    if (per_cu < 1) per_cu = 1;
    if (per_cu > 2) per_cu = 2;
    grid_blocks = cus * per_cu;
  }
  Params p{};
  const float** pp = (const float**)&p;
  for (int i = 0; i < 33; ++i) pp[i] = (const float*)d_in[i];
  p.out = (float*)d_out;
  p.ws = (char*)d_ws;
#if COOP
  void* args[] = {&p};
  hipError_t e = hipLaunchCooperativeKernel((void*)mega, dim3(grid_blocks), dim3(256), args, 0, stream);
  if (e != hipSuccess) fprintf(stderr, "cooperative launch failed: %s (grid %d)\n", hipGetErrorString(e), grid_blocks);
#else
  launch_from<0>(p, grid_blocks, stream);
#endif
}
```

```cpp
#include <hip/hip_runtime.h>
#include <hip/hip_cooperative_groups.h>
#include <stdint.h>
#include <cstdio>
namespace cg = cooperative_groups;

#ifndef COOP
#define COOP 1
#endif

typedef unsigned short u16;
typedef short bf16x8 __attribute__((ext_vector_type(8)));
typedef short s16x4 __attribute__((ext_vector_type(4)));
typedef float f32x16 __attribute__((ext_vector_type(16)));
typedef float f32x4 __attribute__((ext_vector_type(4)));
typedef float f32x2 __attribute__((ext_vector_type(2)));
typedef unsigned u32x4 __attribute__((ext_vector_type(4)));
typedef unsigned u32x2 __attribute__((ext_vector_type(2)));
typedef __bf16 bfv2 __attribute__((ext_vector_type(2)));
#define DI __device__ __forceinline__
#define MFMA32(a, b, c) __builtin_amdgcn_mfma_f32_32x32x16_bf16((a), (b), (c), 0, 0, 0)

constexpr int D = 2048, NTOK = 12288, NCTX = 4096;
constexpr float EPS = 1e-6f;
constexpr size_t OUT_CKV = 25165824, OUT_KROPE = 29360128, OUT_S5 = 29884416, OUT_GLA = 30408704;
constexpr size_t WS_BAR = 0;
constexpr size_t WS_WT_MLA_IN = 16384;
constexpr size_t WS_WT_MLA_UKV = WS_WT_MLA_IN + 2ull * 5760 * 2048 * 2;
constexpr size_t WS_WT_MLA_OUT = WS_WT_MLA_UKV + 2ull * 4096 * 512 * 2;
constexpr size_t WS_WT_S5_IN = WS_WT_MLA_OUT + 2ull * 2048 * 2048 * 2;
constexpr size_t WS_WT_S5_GLU = WS_WT_S5_IN + 4096ull * 2048 * 2;
constexpr size_t WS_WT_S5_OUT = WS_WT_S5_GLU + 2048ull * 2048 * 2;
constexpr size_t WS_WT_GLA_IN = WS_WT_S5_OUT + 2048ull * 2048 * 2;
constexpr size_t WS_WT_GLA_OUT = WS_WT_GLA_IN + 6272ull * 2048 * 2;
constexpr size_t WS_MOD = WS_WT_GLA_OUT + 2048ull * 2048 * 2;
constexpr size_t WS_H = WS_MOD + 4ull * 9 * 6144 * 4;
constexpr size_t WS_OP = WS_H + 12288ull * 2048 * 2;
constexpr size_t WS_SCR = WS_OP + 12288ull * 2048 * 4;
constexpr size_t A_QB = WS_SCR;
constexpr size_t A_CKVRAW = A_QB + 12288ull * 3072 * 2;
constexpr size_t A_CKVALL = A_CKVRAW + 12288ull * 512 * 4;
constexpr size_t A_SGATE = A_CKVALL + 14336ull * 512 * 2;
constexpr size_t A_KB = A_SGATE + 12288ull * 2048 * 2;
constexpr size_t A_VT = A_KB + 14336ull * 16 * 192 * 2;
constexpr size_t B_U = WS_SCR;
constexpr size_t B_SGATE = B_U + 12288ull * 2048 * 4;
constexpr size_t B_YB = B_SGATE + 12288ull * 2048 * 2;
constexpr size_t B_Z = B_YB + 12288ull * 2048 * 4;
constexpr size_t C_QG = WS_SCR;
constexpr size_t C_KG = C_QG + 12288ull * 1024 * 2;
constexpr size_t C_VT = C_KG + 12288ull * 1024 * 2;
constexpr size_t C_SGATE = C_VT + 12288ull * 2048 * 2;
constexpr size_t C_GLR = C_SGATE + 12288ull * 2048 * 2;
constexpr size_t C_QT = C_GLR + 12288ull * 32 * 4;
constexpr size_t C_KT = C_QT + 2ull * 12288 * 1024 * 2;
constexpr size_t C_KDT = C_KT + 2ull * 12288 * 1024 * 2;
constexpr size_t C_DN = C_KDT + 2ull * 12288 * 1024 * 2;
constexpr size_t C_OB = C_DN + 2ull * 192 * 1024 * 4;

struct Params {
  const float *x_prompt, *x_sample, *cache_ckv, *cache_krope, *state_s5, *state_gla, *c, *c_ctx;
  const float *ada_w, *ada_b, *norm_pre, *norm_post;
  const float *mla_w_in, *mla_kv_norm, *mla_w_ukv, *mla_w_out;
  const float *s5_w_in, *s5_a_re, *s5_a_im, *s5_log_dt, *s5_b_re, *s5_b_im, *s5_c_re, *s5_c_im, *s5_d, *s5_w_glu, *s5_b_glu, *s5_w_out;
  const float *gla_w_in, *gla_w_g2, *gla_b_g, *gla_norm, *gla_w_out;
  float* out;
  char* ws;
};

DI unsigned pk2(float a, float b) { f32x2 v; v.x = a; v.y = b; bfv2 r = __builtin_convertvector(v, bfv2); return __builtin_bit_cast(unsigned, r); }
DI u16 f2bf(float a) { return (u16)(pk2(a, 0.f) & 0xffffu); }
DI float bf2f(u16 v) { return __uint_as_float(((unsigned)v) << 16); }
DI float bflo(unsigned v) { return __uint_as_float(v << 16); }
DI float bfhi(unsigned v) { return __uint_as_float(v & 0xffff0000u); }
DI float siluf(float x) { return x / (1.f + __expf(-x)); }
DI float sigmf(float x) { return 1.f / (1.f + __expf(-x)); }
DI int crow(int reg, int h) { return (reg & 3) + 8 * (reg >> 2) + 4 * h; }
DI void st_bf4(u16* p, float a, float b, float c, float d) { u32x2 v; v.x = pk2(a, b); v.y = pk2(c, d); *(u32x2*)p = v; }
DI bf16x8 pack8(const f32x16& x, int s) {
  u32x4 p;
  p.x = pk2(x[8 * s + 0], x[8 * s + 1]); p.y = pk2(x[8 * s + 2], x[8 * s + 3]);
  p.z = pk2(x[8 * s + 4], x[8 * s + 5]); p.w = pk2(x[8 * s + 6], x[8 * s + 7]);
  return __builtin_bit_cast(bf16x8, p);
}
DI bf16x8 cat4(s16x4 lo, s16x4 hi) { return __builtin_shufflevector(lo, hi, 0, 1, 2, 3, 4, 5, 6, 7); }
DI float wave_sum(float v) {
#pragma unroll
  for (int o = 32; o >= 1; o >>= 1) v += __shfl_xor(v, o);
  return v;
}
DI int cond_of(int T) { return T < NCTX ? 8 : ((T - NCTX) >> 10); }
DI int kvrow_of(int T) { return T < NCTX ? T : NCTX + ((T - NCTX) >> 10) * 1280 + ((T - NCTX) & 1023); }

DI void ada_phase(const Params& p, float* smem) {
  const int tid = threadIdx.x;
  float* mod = (float*)(p.ws + WS_MOD);
  for (int it = blockIdx.x; it < 384; it += gridDim.x) {
    const int l = it / 96, n0 = (it % 96) * 64;
    __syncthreads();
    for (int i = tid; i < 9 * 2048; i += 256) { const int cd = i >> 11, k = i & 2047; const float v = cd < 8 ? p.c[cd * 2048 + k] : p.c_ctx[k]; smem[i] = siluf(v); }
    __syncthreads();
    const int c4 = tid & 15, ks = tid >> 4;
    const float* w = p.ada_w + (size_t)l * 2048 * 6144 + n0 + c4 * 4;
    float acc[9][4];
#pragma unroll
    for (int cd = 0; cd < 9; ++cd)
#pragma unroll
      for (int e = 0; e < 4; ++e) acc[cd][e] = 0.f;
#pragma unroll 4
    for (int kk = 0; kk < 128; ++kk) {
      const int k = ks * 128 + kk;
      const f32x4 wv = __builtin_nontemporal_load((const f32x4*)(w + (size_t)k * 6144));
#pragma unroll
      for (int cd = 0; cd < 9; ++cd) {
        const float s = smem[cd * 2048 + k];
#pragma unroll
        for (int e = 0; e < 4; ++e) acc[cd][e] += s * wv[e];
      }
    }
    __syncthreads();
#pragma unroll
    for (int cd = 0; cd < 9; ++cd)
#pragma unroll
      for (int e = 0; e < 4; ++e) smem[(ks * 9 + cd) * 64 + c4 * 4 + e] = acc[cd][e];
    __syncthreads();
    for (int o = tid; o < 576; o += 256) {
      const int cd = o >> 6, col = o & 63;
      float s = 0.f;
#pragma unroll
      for (int k2 = 0; k2 < 16; ++k2) s += smem[(k2 * 9 + cd) * 64 + col];
      mod[(size_t)(l * 9 + cd) * 6144 + n0 + col] = s + p.ada_b[l * 6144 + n0 + col];
    }
  }
  __syncthreads();
}

DI void transpose_job(const float* __restrict__ src, u16* __restrict__ dst, int K, int N, int Npad, float* tile) {
  const int tid = threadIdx.x;
  const int nkt = K / 64, total = nkt * (Npad / 64);
  for (int t = blockIdx.x; t < total; t += gridDim.x) {
    const int k0 = (t % nkt) * 64, n0 = (t / nkt) * 64;
    const int c = tid & 63, r0 = tid >> 6;
#pragma unroll
    for (int i = 0; i < 16; ++i) { const int r = r0 + 4 * i; tile[r * 65 + c] = (n0 + c < N) ? src[(size_t)(k0 + r) * N + n0 + c] : 0.f; }
    __syncthreads();
    const int n = tid >> 2, ks = (tid & 3) * 16;
    u32x4 v0, v1;
    v0.x = pk2(tile[(ks + 0) * 65 + n], tile[(ks + 1) * 65 + n]); v0.y = pk2(tile[(ks + 2) * 65 + n], tile[(ks + 3) * 65 + n]);
    v0.z = pk2(tile[(ks + 4) * 65 + n], tile[(ks + 5) * 65 + n]); v0.w = pk2(tile[(ks + 6) * 65 + n], tile[(ks + 7) * 65 + n]);
    v1.x = pk2(tile[(ks + 8) * 65 + n], tile[(ks + 9) * 65 + n]); v1.y = pk2(tile[(ks + 10) * 65 + n], tile[(ks + 11) * 65 + n]);
    v1.z = pk2(tile[(ks + 12) * 65 + n], tile[(ks + 13) * 65 + n]); v1.w = pk2(tile[(ks + 14) * 65 + n], tile[(ks + 15) * 65 + n]);
    u16* d = dst + (size_t)(n0 + n) * K + k0 + ks;
    *(u32x4*)d = v0; *(u32x4*)(d + 8) = v1;
    __syncthreads();
  }
}

DI void phase0(const Params& p, char* smem) {
  ada_phase(p, (float*)smem);
  float* tile = (float*)smem;
  char* ws = p.ws;
  for (int j = 0; j < 2; ++j) {
    transpose_job(p.mla_w_in + (size_t)j * 2048 * 5696, (u16*)(ws + WS_WT_MLA_IN) + (size_t)j * 5760 * 2048, 2048, 5696, 5760, tile);
    transpose_job(p.mla_w_ukv + (size_t)j * 512 * 4096, (u16*)(ws + WS_WT_MLA_UKV) + (size_t)j * 4096 * 512, 512, 4096, 4096, tile);
    transpose_job(p.mla_w_out + (size_t)j * 2048 * 2048, (u16*)(ws + WS_WT_MLA_OUT) + (size_t)j * 2048 * 2048, 2048, 2048, 2048, tile);
  }
  transpose_job(p.s5_w_in, (u16*)(ws + WS_WT_S5_IN), 2048, 4096, 4096, tile);
  transpose_job(p.s5_w_glu, (u16*)(ws + WS_WT_S5_GLU), 2048, 2048, 2048, tile);
  transpose_job(p.s5_w_out, (u16*)(ws + WS_WT_S5_OUT), 2048, 2048, 2048, tile);
  transpose_job(p.gla_w_in, (u16*)(ws + WS_WT_GLA_IN), 2048, 6176, 6272, tile);
  transpose_job(p.gla_w_out, (u16*)(ws + WS_WT_GLA_OUT), 2048, 2048, 2048, tile);
}

DI void norm_phase(const Params& p, int l, bool first) {
  const int lane = threadIdx.x & 63, wv = threadIdx.x >> 6;
  const float* mod = (const float*)(p.ws + WS_MOD);
  const float* OP = (const float*)(p.ws + WS_OP);
  u16* H = (u16*)(p.ws + WS_H);
  for (int T = blockIdx.x * 4 + wv; T < NTOK; T += gridDim.x * 4) {
    const int cd = cond_of(T);
    const float* xin = T < NCTX ? p.x_prompt + (size_t)T * D : p.x_sample + (size_t)(T - NCTX) * D;
    float* xrow = p.out + (size_t)T * D;
    f32x4 x[8];
    if (first) {
#pragma unroll
      for (int j = 0; j < 8; ++j) x[j] = *(const f32x4*)(xin + (j * 64 + lane) * 4);
    } else {
      const float* xold = (l == 1) ? xin : xrow;
      const float* op = OP + (size_t)T * D;
      f32x4 o[8];
      float ss = 0.f;
#pragma unroll
      for (int j = 0; j < 8; ++j) { o[j] = *(const f32x4*)(op + (j * 64 + lane) * 4); ss += o[j][0] * o[j][0] + o[j][1] * o[j][1] + o[j][2] * o[j][2] + o[j][3] * o[j][3]; }
      ss = wave_sum(ss);
      const float rstd = rsqrtf(ss * (1.f / D) + EPS);
      const float* npost = p.norm_post + (l - 1) * D;
      const float* gate = mod + (size_t)((l - 1) * 9 + cd) * 6144 + 4096;
#pragma unroll
      for (int j = 0; j < 8; ++j) {
        const int col = (j * 64 + lane) * 4;
        const f32x4 xo = *(const f32x4*)(xold + col), np = *(const f32x4*)(npost + col), g = *(const f32x4*)(gate + col);
        x[j] = xo + g * (o[j] * rstd * np);
        *(f32x4*)(xrow + col) = x[j];
      }
    }
    if (l < 4) {
      float ss = 0.f;
#pragma unroll
      for (int j = 0; j < 8; ++j) ss += x[j][0] * x[j][0] + x[j][1] * x[j][1] + x[j][2] * x[j][2] + x[j][3] * x[j][3];
      ss = wave_sum(ss);
      const float rstd = rsqrtf(ss * (1.f / D) + EPS);
      const float* npre = p.norm_pre + l * D;
      const float* sh = mod + (size_t)(l * 9 + cd) * 6144;
      u16* hrow = H + (size_t)T * D;
#pragma unroll
      for (int j = 0; j < 8; ++j) {
        const int col = (j * 64 + lane) * 4;
        const f32x4 np = *(const f32x4*)(npre + col), s1 = *(const f32x4*)(sh + col), sc = *(const f32x4*)(sh + 2048 + col);
        const f32x4 hv = x[j] * rstd * np * (1.f + sc) + s1;
        st_bf4(hrow + col, hv[0], hv[1], hv[2], hv[3]);
      }
    }
  }
}

template <bool SWAP, class Epi>
DI void gemm_tile(const u16* __restrict__ A, int lda, const u16* __restrict__ Bt, int ldb, int K, int m0, int n0, const Epi& epi, char* smem) {
  u16* As = (u16*)smem;
  u16* Bs = As + 2 * 9216;
  const int tid = threadIdx.x, lane = tid & 63, w = tid >> 6, r = lane & 31, h = lane >> 5;
  const int wm = w >> 1, wn = w & 1;
  const int lrow = tid >> 3, lseg = tid & 7;
  const u16* Ag = A + (size_t)(m0 + lrow) * lda + lseg * 8;
  const u16* Bg = Bt + (size_t)(n0 + lrow) * ldb + lseg * 8;
  u32x4 ra[4], rb[4];
  f32x16 acc[2][2];
#pragma unroll
  for (int i = 0; i < 2; ++i)
#pragma unroll
    for (int j = 0; j < 2; ++j)
#pragma unroll
      for (int e = 0; e < 16; ++e) acc[i][j][e] = 0.f;
#pragma unroll
  for (int q = 0; q < 4; ++q) { ra[q] = *(const u32x4*)(Ag + (size_t)(32 * q) * lda); rb[q] = *(const u32x4*)(Bg + (size_t)(32 * q) * ldb); }
#pragma unroll
  for (int q = 0; q < 4; ++q) { *(u32x4*)(As + (lrow + 32 * q) * 72 + lseg * 8) = ra[q]; *(u32x4*)(Bs + (lrow + 32 * q) * 72 + lseg * 8) = rb[q]; }
  __syncthreads();
  const int nk = K >> 6;
  for (int kt = 0; kt < nk; ++kt) {
    const bool more = kt + 1 < nk;
    if (more) {
      const int k0 = (kt + 1) << 6;
#pragma unroll
      for (int q = 0; q < 4; ++q) { ra[q] = *(const u32x4*)(Ag + (size_t)(32 * q) * lda + k0); rb[q] = *(const u32x4*)(Bg + (size_t)(32 * q) * ldb + k0); }
    }
    const u16* as = As + (kt & 1) * 9216 + (wm * 64 + r) * 72 + h * 8;
    const u16* bs = Bs + (kt & 1) * 9216 + (wn * 64 + r) * 72 + h * 8;
#pragma unroll
    for (int ks = 0; ks < 4; ++ks) {
      bf16x8 a[2], b[2];
      a[0] = *(const bf16x8*)(as + ks * 16); a[1] = *(const bf16x8*)(as + 32 * 72 + ks * 16);
      b[0] = *(const bf16x8*)(bs + ks * 16); b[1] = *(const bf16x8*)(bs + 32 * 72 + ks * 16);
#pragma unroll
      for (int i = 0; i < 2; ++i)
#pragma unroll
        for (int j = 0; j < 2; ++j) acc[i][j] = SWAP ? MFMA32(b[j], a[i], acc[i][j]) : MFMA32(a[i], b[j], acc[i][j]);
    }
    if (more) {
      u16* ad = As + ((kt + 1) & 1) * 9216; u16* bd = Bs + ((kt + 1) & 1) * 9216;
#pragma unroll
      for (int q = 0; q < 4; ++q) { *(u32x4*)(ad + (lrow + 32 * q) * 72 + lseg * 8) = ra[q]; *(u32x4*)(bd + (lrow + 32 * q) * 72 + lseg * 8) = rb[q]; }
    }
    __syncthreads();
  }
#pragma unroll
  for (int i = 0; i < 2; ++i)
#pragma unroll
    for (int j = 0; j < 2; ++j) epi(m0 + wm * 64 + i * 32, n0 + wn * 64 + j * 32, acc[i][j], r, h);
}

template <class F>
DI void for_tiles(int MT, int NT, const F& f) {
  const int G = gridDim.x;
  if ((G & 7) == 0 && (MT & 7) == 0) {
    const int G8 = G >> 3, xcd = blockIdx.x & 7, loc = blockIdx.x >> 3;
    const int SM = MT >> 3, SN = (NT + 7) >> 3, total = SM * SN * 64;
    for (int i = 0;; ++i) {
      const int u = (i * 8 + xcd) * G8 + loc;
      if (u >= total) break;
      const int sup = u >> 6, win = u & 63;
      const int mt = (sup % SM) * 8 + (win & 7), nt = (sup / SM) * 8 + (win >> 3);
      if (nt < NT) f(mt, nt);
    }
  } else {
    for (int t = blockIdx.x; t < MT * NT; t += G) f(t % MT, t / MT);
  }
}

DI void rope16(f32x16& v, int pos, int h) {
#pragma unroll
  for (int g = 0; g < 2; ++g)
#pragma unroll
    for (int e = 0; e < 4; ++e) {
      const int f = 8 * g + 4 * h + e;
      const float invf = exp2f(-(float)f * 0.83048202372184058696f);
      const float rev = ((float)pos * invf) * 0.15915494309189533577f;
      const float sn = __builtin_amdgcn_sinf(rev), cs = __builtin_amdgcn_cosf(rev);
      const float x1 = v[4 * g + e], x2 = v[4 * (g + 2) + e];
      v[4 * g + e] = x1 * cs - x2 * sn;
      v[4 * (g + 2) + e] = x1 * sn + x2 * cs;
    }
}

DI void mla_g1(const Params& p, int j, char* smem) {
  char* ws = p.ws;
  const u16* H = (const u16*)(ws + WS_H);
  const u16* Wt = (const u16*)(ws + WS_WT_MLA_IN) + (size_t)j * 5760 * 2048;
  u16* QB = (u16*)(ws + A_QB); float* CKVRAW = (float*)(ws + A_CKVRAW); u16* SG = (u16*)(ws + A_SGATE); u16* KB = (u16*)(ws + A_KB);
  float* okr = p.out + OUT_KROPE;
  auto epi = [&](int tm, int tn, const f32x16& acc, int r, int h) {
    const int m = tm + r;
    if (tn < 3072) {
      const int within = tn % 192;
      f32x16 v = acc;
      if (within >= 128 && m >= NCTX) { const int tl = (m - NCTX) & 1023; rope16(v, within < 160 ? (tl >> 6) : (tl & 63), h); }
#pragma unroll
      for (int g = 0; g < 4; ++g) st_bf4(QB + (size_t)m * 3072 + tn + 8 * g + 4 * h, v[4 * g], v[4 * g + 1], v[4 * g + 2], v[4 * g + 3]);
    } else if (tn < 3584) {
#pragma unroll
      for (int g = 0; g < 4; ++g) { f32x4 o = {acc[4 * g], acc[4 * g + 1], acc[4 * g + 2], acc[4 * g + 3]}; *(f32x4*)(CKVRAW + (size_t)m * 512 + (tn - 3072) + 8 * g + 4 * h) = o; }
    } else if (tn < 3648) {
      f32x16 v = acc;
      const int c0 = tn - 3584;
      if (m >= NCTX) { const int tl = (m - NCTX) & 1023; rope16(v, c0 == 0 ? (tl >> 6) : (tl & 63), h); }
      else {
        const int b = m >> 8, t = m & 255;
#pragma unroll
        for (int g = 0; g < 4; ++g) { f32x4 o = {v[4 * g], v[4 * g + 1], v[4 * g + 2], v[4 * g + 3]}; *(f32x4*)(okr + ((size_t)(b * 2 + j) * 256 + t) * 64 + c0 + 8 * g + 4 * h) = o; }
      }
      const size_t R = kvrow_of(m);
      for (int hd = 0; hd < 16; ++hd)
#pragma unroll
        for (int g = 0; g < 4; ++g) st_bf4(KB + (R * 16 + hd) * 192 + 128 + c0 + 8 * g + 4 * h, v[4 * g], v[4 * g + 1], v[4 * g + 2], v[4 * g + 3]);
    } else if (tn < 5696) {
#pragma unroll
      for (int g = 0; g < 4; ++g) st_bf4(SG + (size_t)m * 2048 + (tn - 3648) + 8 * g + 4 * h, siluf(acc[4 * g]), siluf(acc[4 * g + 1]), siluf(acc[4 * g + 2]), siluf(acc[4 * g + 3]));
    }
  };
  for_tiles(96, 45, [&](int mt, int nt) { gemm_tile<true>(H, 2048, Wt, 2048, 2048, mt * 128, nt * 128, epi, smem); });
}

DI void mla_a2(const Params& p, int j) {
  char* ws = p.ws;
  const int lane = threadIdx.x & 63, wv = threadIdx.x >> 6;
  const float* CKVRAW = (const float*)(ws + A_CKVRAW); u16* CKVALL = (u16*)(ws + A_CKVALL); u16* KB = (u16*)(ws + A_KB);
  const float* kvn = p.mla_kv_norm + j * 512;
  float* ockv = p.out + OUT_CKV;
  for (int R = blockIdx.x * 4 + wv; R < 14336; R += gridDim.x * 4) {
    int T = -1, cb = 0, ct = 0;
    if (R < NCTX) T = R;
    else { const int r2 = R - NCTX; cb = r2 / 1280; const int tp = r2 - cb * 1280; if (tp < 1024) T = NCTX + cb * 1024 + tp; else ct = tp - 1024; }
    u16* dst = CKVALL + (size_t)R * 512;
    if (T >= 0) {
      const float* src = CKVRAW + (size_t)T * 512;
      const f32x4 a = *(const f32x4*)(src + lane * 4), b = *(const f32x4*)(src + 256 + lane * 4);
      float ss = a[0] * a[0] + a[1] * a[1] + a[2] * a[2] + a[3] * a[3] + b[0] * b[0] + b[1] * b[1] + b[2] * b[2] + b[3] * b[3];
      ss = wave_sum(ss);
      const float rstd = rsqrtf(ss * (1.f / 512.f) + EPS);
      const f32x4 g0 = *(const f32x4*)(kvn + lane * 4), g1 = *(const f32x4*)(kvn + 256 + lane * 4);
      const f32x4 y0 = a * rstd * g0, y1 = b * rstd * g1;
      st_bf4(dst + lane * 4, y0[0], y0[1], y0[2], y0[3]);
      st_bf4(dst + 256 + lane * 4, y1[0], y1[1], y1[2], y1[3]);
      if (T < NCTX) {
        float* o = ockv + ((size_t)((T >> 8) * 2 + j) * 256 + (T & 255)) * 512;
        *(f32x4*)(o + lane * 4) = y0; *(f32x4*)(o + 256 + lane * 4) = y1;
      }
    } else {
      const float* src = p.cache_ckv + ((size_t)(cb * 2 + j) * 256 + ct) * 512;
      const f32x4 a = *(const f32x4*)(src + lane * 4), b = *(const f32x4*)(src + 256 + lane * 4);
      st_bf4(dst + lane * 4, a[0], a[1], a[2], a[3]);
      st_bf4(dst + 256 + lane * 4, b[0], b[1], b[2], b[3]);
      const float kr = p.cache_krope[((size_t)(cb * 2 + j) * 256 + ct) * 64 + lane];
      const u16 kb = f2bf(kr);
      for (int hd = 0; hd < 16; ++hd) KB[((size_t)R * 16 + hd) * 192 + 128 + lane] = kb;
    }
  }
}

DI void mla_g2(const Params& p, int j, char* smem) {
  char* ws = p.ws;
  const u16* CKVALL = (const u16*)(ws + A_CKVALL);
  const u16* Wt = (const u16*)(ws + WS_WT_MLA_UKV) + (size_t)j * 4096 * 512;
  u16* KB = (u16*)(ws + A_KB); u16* VT = (u16*)(ws + A_VT);
  auto epiK = [&](int tm, int tn, const f32x16& acc, int r, int h) {
    const size_t R = tm + r; const int hd = tn >> 8, wi = tn & 255;
#pragma unroll
    for (int g = 0; g < 4; ++g) st_bf4(KB + (R * 16 + hd) * 192 + wi + 8 * g + 4 * h, acc[4 * g], acc[4 * g + 1], acc[4 * g + 2], acc[4 * g + 3]);
  };
  auto epiV = [&](int tm, int tn, const f32x16& acc, int r, int h) {
    const int n = tn + r; const int hd = n >> 8, d = (n & 255) - 128;
    size_t base; int nkeys, key0;
    if (tm < NCTX) { base = (size_t)(tm >> 8) * 256 * 2048; nkeys = 256; key0 = tm & 255; }
    else { const int r2 = tm - NCTX; const int b = r2 / 1280; base = (size_t)NCTX * 2048 + (size_t)b * 1280 * 2048; nkeys = 1280; key0 = r2 - b * 1280; }
    u16* dst = VT + base + (size_t)(hd * 128 + d) * nkeys + key0;
#pragma unroll
    for (int g = 0; g < 4; ++g) st_bf4(dst + 8 * g + 4 * h, acc[4 * g], acc[4 * g + 1], acc[4 * g + 2], acc[4 * g + 3]);
  };
  for_tiles(112, 32, [&](int mt, int nt) {
    if ((nt & 1) == 0) gemm_tile<true>(CKVALL, 512, Wt, 512, 512, mt * 128, nt * 128, epiK, smem);
    else gemm_tile<false>(CKVALL, 512, Wt, 512, 512, mt * 128, nt * 128, epiV, smem);
  });
}

DI void mla_attn(const Params& p) {
  char* ws = p.ws;
  const u16* QB = (const u16*)(ws + A_QB); const u16* KB = (const u16*)(ws + A_KB); const u16* VT = (const u16*)(ws + A_VT); const u16* SG = (const u16*)(ws + A_SGATE);
  u16* OG = (u16*)(ws + WS_H);
  const int lane = threadIdx.x & 63, w = threadIdx.x >> 6, r = lane & 31, h = lane >> 5;
  const float SC = 0.07216878364870322f * 1.4426950408889634f;
  for (int it = blockIdx.x; it < 1536; it += gridDim.x) {
    int head, T0, R0, nkeys; size_t vbase;
    if (it < 1024) { const int b = it >> 7; head = (it >> 3) & 15; T0 = NCTX + b * 1024 + (it & 7) * 128; R0 = NCTX + b * 1280; nkeys = 1280; vbase = (size_t)NCTX * 2048 + (size_t)b * 1280 * 2048; }
    else { const int i2 = it - 1024; const int b = i2 >> 5; head = (i2 >> 1) & 15; T0 = b * 256 + (i2 & 1) * 128; R0 = b * 256; nkeys = 256; vbase = (size_t)b * 256 * 2048; }
    T0 += w * 32;
    bf16x8 qf[12];
    const u16* qp = QB + (size_t)(T0 + r) * 3072 + head * 192 + 8 * h;
#pragma unroll
    for (int ks = 0; ks < 12; ++ks) qf[ks] = *(const bf16x8*)(qp + ks * 16);
    f32x16 O[4];
#pragma unroll
    for (int dt = 0; dt < 4; ++dt)
#pragma unroll
      for (int e = 0; e < 16; ++e) O[dt][e] = 0.f;
    float mrun = -INFINITY, lrun = 0.f;
    const u16* kp = KB + ((size_t)(R0 + r) * 16 + head) * 192 + 8 * h;
    const u16* vp = VT + vbase + (size_t)(head * 128 + r) * nkeys + 4 * h;
    for (int kt = 0; kt < nkeys; kt += 32) {
      f32x16 S;
#pragma unroll
      for (int e = 0; e < 16; ++e) S[e] = 0.f;
      const u16* kq = kp + (size_t)kt * 16 * 192;
#pragma unroll
      for (int ks = 0; ks < 12; ++ks) { const bf16x8 kf = *(const bf16x8*)(kq + ks * 16); S = MFMA32(kf, qf[ks], S); }
      float mx = -INFINITY;
#pragma unroll
      for (int e = 0; e < 16; ++e) { S[e] *= SC; mx = fmaxf(mx, S[e]); }
      mx = fmaxf(mx, __shfl_xor(mx, 32));
      const float mnew = fmaxf(mrun, mx);
      const float alpha = __builtin_amdgcn_exp2f(mrun - mnew);
      mrun = mnew;
      float ps = 0.f;
#pragma unroll
      for (int e = 0; e < 16; ++e) { S[e] = __builtin_amdgcn_exp2f(S[e] - mnew); ps += S[e]; }
      lrun = lrun * alpha + ps;
#pragma unroll
      for (int dt = 0; dt < 4; ++dt)
#pragma unroll
        for (int e = 0; e < 16; ++e) O[dt][e] *= alpha;
#pragma unroll
      for (int s = 0; s < 2; ++s) {
        const bf16x8 pf = pack8(S, s);
#pragma unroll
        for (int dt = 0; dt < 4; ++dt) {
          const u16* vq = vp + (size_t)(dt * 32) * nkeys + kt + 16 * s;
          const s16x4 lo = *(const s16x4*)vq, hi = *(const s16x4*)(vq + 8);
          O[dt] = MFMA32(cat4(lo, hi), pf, O[dt]);
        }
      }
    }
    lrun += __shfl_xor(lrun, 32);
    const float inv = 1.f / lrun;
#pragma unroll
    for (int dt = 0; dt < 4; ++dt)
#pragma unroll
      for (int g = 0; g < 4; ++g) {
        const size_t o = (size_t)(T0 + r) * 2048 + head * 128 + dt * 32 + 8 * g + 4 * h;
        const u32x2 sg = *(const u32x2*)(SG + o);
        st_bf4(OG + o, O[dt][4 * g] * inv * bflo(sg.x), O[dt][4 * g + 1] * inv * bfhi(sg.x), O[dt][4 * g + 2] * inv * bflo(sg.y), O[dt][4 * g + 3] * inv * bfhi(sg.y));
      }
  }
}

DI void gemm_out(const Params& p, const u16* A, const u16* Wt, char* smem) {
  float* OP = (float*)(p.ws + WS_OP);
  auto epi = [&](int tm, int tn, const f32x16& acc, int r, int h) {
    const size_t m = tm + r;
#pragma unroll
    for (int g = 0; g < 4; ++g) { f32x4 o = {acc[4 * g], acc[4 * g + 1], acc[4 * g + 2], acc[4 * g + 3]}; *(f32x4*)(OP + m * 2048 + tn + 8 * g + 4 * h) = o; }
  };
  for_tiles(96, 16, [&](int mt, int nt) { gemm_tile<true>(A, 2048, Wt, 2048, 2048, mt * 128, nt * 128, epi, smem); });
}

DI void s5_g1(const Params& p, char* smem) {
  char* ws = p.ws;
  const u16* H = (const u16*)(ws + WS_H); const u16* Wt = (const u16*)(ws + WS_WT_S5_IN);
  float* U = (float*)(ws + B_U); u16* SG = (u16*)(ws + B_SGATE);
  auto epi = [&](int tm, int tn, const f32x16& acc, int r, int h) {
    const size_t m = tm + r;
    if (tn < 2048) {
#pragma unroll
      for (int g = 0; g < 4; ++g) { f32x4 o = {acc[4 * g], acc[4 * g + 1], acc[4 * g + 2], acc[4 * g + 3]}; *(f32x4*)(U + m * 2048 + tn + 8 * g + 4 * h) = o; }
    } else {
#pragma unroll
      for (int g = 0; g < 4; ++g) st_bf4(SG + m * 2048 + (tn - 2048) + 8 * g + 4 * h, siluf(acc[4 * g]), siluf(acc[4 * g + 1]), siluf(acc[4 * g + 2]), siluf(acc[4 * g + 3]));
    }
  };
  for_tiles(96, 32, [&](int mt, int nt) { gemm_tile<true>(H, 2048, Wt, 2048, 2048, mt * 128, nt * 128, epi, smem); });
}

DI void s5_scan(const Params& p) {
  char* ws = p.ws;
  const float* U = (const float*)(ws + B_U);
  float* YF = (float*)(ws + WS_OP); float* YB = (float*)(ws + B_YB);
  const int lane = threadIdx.x & 63;
  const int w = __builtin_amdgcn_readfirstlane(threadIdx.x >> 6);
  const bool b5 = lane & 32, b4 = lane & 16, b3 = lane & 8, b2 = lane & 4;
  const int pout = (b5 ? 8 : 0) + (b4 ? 4 : 0) + (b3 ? 2 : 0) + (b2 ? 1 : 0);
  for (int it = blockIdx.x * 4 + w; it < 6144; it += gridDim.x * 4) {
    const int dir = it & 1; int rest = it >> 1;
    const bool lat = rest < 1024;
    int b, g, L, T0;
    if (lat) { b = rest >> 7; g = rest & 127; L = 1024; T0 = NCTX + b * 1024; }
    else { rest -= 1024; b = rest >> 7; g = rest & 127; L = 256; T0 = b * 256; }
    const int n = lane;
    const int pidx = (dir * 128 + g) * 64 + n;
    const float are = p.s5_a_re[pidx], aim = p.s5_a_im[pidx];
    const float dt = __expf(p.s5_log_dt[dir * 128 + g]);
    const float mag = __expf(are * dt), rev = (aim * dt) * 0.15915494309189533577f;
    const float abr = mag * __builtin_amdgcn_cosf(rev), abi = mag * __builtin_amdgcn_sinf(rev);
    const float nr = abr - 1.f, ni = abi, den = 1.f / (are * are + aim * aim);
    const float cr = (nr * are + ni * aim) * den, ci = (ni * are - nr * aim) * den;
    float bre[16], bim[16], cre[16], cim[16];
    {
      const float* br = p.s5_b_re + (size_t)pidx * 16; const float* bi = p.s5_b_im + (size_t)pidx * 16;
#pragma unroll
      for (int q = 0; q < 4; ++q) {
        const f32x4 x = *(const f32x4*)(br + 4 * q), y = *(const f32x4*)(bi + 4 * q);
#pragma unroll
        for (int e = 0; e < 4; ++e) { bre[4 * q + e] = cr * x[e] - ci * y[e]; bim[4 * q + e] = cr * y[e] + ci * x[e]; }
      }
      const float* c1 = p.s5_c_re + (size_t)(dir * 128 + g) * 16 * 64 + n; const float* c2 = p.s5_c_im + (size_t)(dir * 128 + g) * 16 * 64 + n;
#pragma unroll
      for (int q = 0; q < 16; ++q) { cre[q] = c1[q * 64]; cim[q] = c2[q * 64]; }
    }
    float hr = 0.f, hi = 0.f;
    if (lat) { const float* s0 = p.state_s5 + ((size_t)((b * 2 + dir) * 128 + g) * 64 + n) * 2; hr = s0[0]; hi = s0[1]; }
    float* Y = dir ? YB : YF;
    const float* ub = U + (size_t)T0 * 2048 + g * 16;
    const int t0 = dir ? L - 1 : 0, tstep = dir ? -1 : 1;
    f32x4 un[4];
#pragma unroll
    for (int q = 0; q < 4; ++q) un[q] = *(const f32x4*)(ub + (size_t)t0 * 2048 + 4 * q);
    int t = t0;
    for (int s = 0; s < L; ++s) {
      f32x4 u[4];
#pragma unroll
      for (int q = 0; q < 4; ++q) u[q] = un[q];
      const int tn = (s + 1 < L) ? t + tstep : t;
#pragma unroll
      for (int q = 0; q < 4; ++q) un[q] = *(const f32x4*)(ub + (size_t)tn * 2048 + 4 * q);
      float br_ = 0.f, bi_ = 0.f;
#pragma unroll
      for (int q = 0; q < 16; ++q) { br_ += bre[q] * u[q >> 2][q & 3]; bi_ += bim[q] * u[q >> 2][q & 3]; }
      const float nhr = abr * hr - abi * hi + br_, nhi = abr * hi + abi * hr + bi_;
      hr = nhr; hi = nhi;
      if (!lat && s == 0) { float* so = p.out + OUT_S5 + ((size_t)((b * 2 + dir) * 128 + g) * 64 + n) * 2; so[0] = hr; so[1] = hi; }
      float v[16];
#pragma unroll
      for (int q = 0; q < 16; ++q) v[q] = cre[q] * hr - cim[q] * hi;
      float w8[8], w4[4], w2[2];
#pragma unroll
      for (int q = 0; q < 8; ++q) { const float keep = b5 ? v[q + 8] : v[q], send = b5 ? v[q] : v[q + 8]; w8[q] = keep + __shfl_xor(send, 32); }
#pragma unroll
      for (int q = 0; q < 4; ++q) { const float keep = b4 ? w8[q + 4] : w8[q], send = b4 ? w8[q] : w8[q + 4]; w4[q] = keep + __shfl_xor(send, 16); }
#pragma unroll
      for (int q = 0; q < 2; ++q) { const float keep = b3 ? w4[q + 2] : w4[q], send = b3 ? w4[q] : w4[q + 2]; w2[q] = keep + __shfl_xor(send, 8); }
      float w1;
      { const float keep = b2 ? w2[1] : w2[0], send = b2 ? w2[0] : w2[1]; w1 = keep + __shfl_xor(send, 4); }
      w1 += __shfl_xor(w1, 2);
      w1 += __shfl_xor(w1, 1);
      if ((lane & 3) == 0) Y[(size_t)(T0 + t) * 2048 + g * 16 + pout] = w1;
      t = tn;
    }
  }
}

DI float gelu_tanh(float x) {
  const float t = 0.7978845608028654f * (x + 0.044715f * x * x * x);
  const float e = __expf(2.f * t);
  const float th = 1.f - 2.f / (e + 1.f);
  return 0.5f * x * (1.f + th);
}

DI void s5_combine(const Params& p) {
  char* ws = p.ws;
  const float* U = (const float*)(ws + B_U); const float* YF = (const float*)(ws + WS_OP); const float* YB = (const float*)(ws + B_YB);
  u16* YG = (u16*)(ws + WS_H);
  const size_t n4 = (size_t)NTOK * 2048 / 4;
  for (size_t i = (size_t)blockIdx.x * 256 + threadIdx.x; i < n4; i += (size_t)gridDim.x * 256) {
    const int col = (int)((i * 4) & 2047);
    const f32x4 u = *(const f32x4*)(U + i * 4), a = *(const f32x4*)(YF + i * 4), b = *(const f32x4*)(YB + i * 4), d = *(const f32x4*)(p.s5_d + col);
    const f32x4 y = d * u + a + b;
    st_bf4(YG + i * 4, gelu_tanh(y[0]), gelu_tanh(y[1]), gelu_tanh(y[2]), gelu_tanh(y[3]));
  }
}

DI void s5_g2(const Params& p, char* smem) {
  char* ws = p.ws;
  const u16* YG = (const u16*)(ws + WS_H); const u16* Wt = (const u16*)(ws + WS_WT_S5_GLU); const u16* SG = (const u16*)(ws + B_SGATE);
  u16* Z = (u16*)(ws + B_Z);
  auto epi = [&](int tm, int tn, const f32x16& acc, int r, int h) {
    const size_t m = tm + r;
#pragma unroll
    for (int g = 0; g < 4; ++g) {
      const int n = tn + 8 * g + 4 * h;
      const f32x4 bg = *(const f32x4*)(p.s5_b_glu + n);
      const u32x2 yv = *(const u32x2*)(YG + m * 2048 + n), sg = *(const u32x2*)(SG + m * 2048 + n);
      st_bf4(Z + m * 2048 + n, bflo(yv.x) * sigmf(acc[4 * g] + bg[0]) * bflo(sg.x), bfhi(yv.x) * sigmf(acc[4 * g + 1] + bg[1]) * bfhi(sg.x),
             bflo(yv.y) * sigmf(acc[4 * g + 2] + bg[2]) * bflo(sg.y), bfhi(yv.y) * sigmf(acc[4 * g + 3] + bg[3]) * bfhi(sg.y));
    }
  };
  for_tiles(96, 16, [&](int mt, int nt) { gemm_tile<true>(YG, 2048, Wt, 2048, 2048, mt * 128, nt * 128, epi, smem); });
}

DI void gla_g1(const Params& p, char* smem) {
  char* ws = p.ws;
  const u16* H = (const u16*)(ws + WS_H); const u16* Wt = (const u16*)(ws + WS_WT_GLA_IN);
  u16* QG = (u16*)(ws + C_QG); u16* KG = (u16*)(ws + C_KG); u16* VT = (u16*)(ws + C_VT); u16* SG = (u16*)(ws + C_SGATE); float* GLR = (float*)(ws + C_GLR);
  auto epi = [&](int tm, int tn, const f32x16& acc, int r, int h) {
    const size_t m = tm + r;
    if (tn < 1024) {
#pragma unroll
      for (int g = 0; g < 4; ++g) st_bf4(QG + m * 1024 + tn + 8 * g + 4 * h, acc[4 * g] * 0.0625f, acc[4 * g + 1] * 0.0625f, acc[4 * g + 2] * 0.0625f, acc[4 * g + 3] * 0.0625f);
    } else if (tn < 2048) {
#pragma unroll
      for (int g = 0; g < 4; ++g) st_bf4(KG + m * 1024 + (tn - 1024) + 8 * g + 4 * h, acc[4 * g], acc[4 * g + 1], acc[4 * g + 2], acc[4 * g + 3]);
    } else if (tn >= 4096 && tn < 6144) {
#pragma unroll
      for (int g = 0; g < 4; ++g) st_bf4(SG + m * 2048 + (tn - 4096) + 8 * g + 4 * h, siluf(acc[4 * g]), siluf(acc[4 * g + 1]), siluf(acc[4 * g + 2]), siluf(acc[4 * g + 3]));
    } else if (tn == 6144) {
#pragma unroll
      for (int g = 0; g < 4; ++g) { f32x4 o = {acc[4 * g], acc[4 * g + 1], acc[4 * g + 2], acc[4 * g + 3]}; *(f32x4*)(GLR + m * 32 + 8 * g + 4 * h) = o; }
    }
  };
  auto epiV = [&](int tm, int tn, const f32x16& acc, int r, int h) {
    const int dv = tn - 2048 + r;
    u16* dst = VT + ((size_t)(tm >> 6) * 2048 + dv) * 64 + (tm & 63);
#pragma unroll
    for (int g = 0; g < 4; ++g) st_bf4(dst + 8 * g + 4 * h, acc[4 * g], acc[4 * g + 1], acc[4 * g + 2], acc[4 * g + 3]);
  };
  for_tiles(96, 49, [&](int mt, int nt) {
    if (nt >= 16 && nt < 32) gemm_tile<false>(H, 2048, Wt, 2048, 2048, mt * 128, nt * 128, epiV, smem);
    else gemm_tile<true>(H, 2048, Wt, 2048, 2048, mt * 128, nt * 128, epi, smem);
  });
}

DI float logsigf(float z) { return fminf(z, 0.f) - __logf(1.f + __expf(-fabsf(z))); }

DI void gla_gate(const Params& p, float* smem) {
  char* ws = p.ws;
  const u16* QG = (const u16*)(ws + C_QG); const u16* KG = (const u16*)(ws + C_KG); const float* GLR = (const float*)(ws + C_GLR);
  u16* QT = (u16*)(ws + C_QT); u16* KT = (u16*)(ws + C_KT); u16* KDT = (u16*)(ws + C_KDT); float* DN = (float*)(ws + C_DN);
  const int tid = threadIdx.x;
  for (int it = blockIdx.x; it < 1536; it += gridDim.x) {
    const int dir = it & 1, hd = (it >> 1) & 3, c = it >> 3;
    const int ch = hd * 256 + tid;
    __syncthreads();
    for (int i = tid; i < 1024; i += 256) smem[i] = GLR[(size_t)(c * 64 + (i >> 4)) * 32 + dir * 16 + (i & 15)];
    __syncthreads();
    float wg[16];
#pragma unroll
    for (int q = 0; q < 16; ++q) wg[q] = p.gla_w_g2[(size_t)(dir * 16 + q) * 1024 + ch];
    const float bg = p.gla_b_g[dir * 1024 + ch];
    float tot = 0.f;
    for (int i = 0; i < 64; ++i) {
      float z = bg;
#pragma unroll
      for (int q = 0; q < 16; ++q) z += smem[i * 16 + q] * wg[q];
      tot += logsigf(z) * 0.0625f;
    }
    DN[(size_t)(dir * 192 + c) * 1024 + ch] = __expf(tot);
    float run = 0.f;
    u16* kdrow = KDT + ((size_t)((dir * 192 + c) * 4 + hd) * 256 + tid) * 64;
    for (int i8 = 0; i8 < 8; ++i8) {
      float kdv[8];
#pragma unroll
      for (int e = 0; e < 8; ++e) {
        const int ii = i8 * 8 + e;
        const int i = dir ? 63 - ii : ii;
        float z = bg;
#pragma unroll
        for (int q = 0; q < 16; ++q) z += smem[i * 16 + q] * wg[q];
        run += logsigf(z) * 0.0625f;
        const size_t T = (size_t)c * 64 + i;
        const float q_ = bf2f(QG[T * 1024 + ch]), k_ = bf2f(KG[T * 1024 + ch]);
        QT[((size_t)dir * NTOK + T) * 1024 + ch] = f2bf(q_ * __expf(run));
        KT[((size_t)dir * NTOK + T) * 1024 + ch] = f2bf(k_ * __expf(-run));
        kdv[e] = k_ * __expf(tot - run);
      }
      u32x4 pk;
      if (dir) { pk.x = pk2(kdv[7], kdv[6]); pk.y = pk2(kdv[5], kdv[4]); pk.z = pk2(kdv[3], kdv[2]); pk.w = pk2(kdv[1], kdv[0]); }
      else { pk.x = pk2(kdv[0], kdv[1]); pk.y = pk2(kdv[2], kdv[3]); pk.z = pk2(kdv[4], kdv[5]); pk.w = pk2(kdv[6], kdv[7]); }
      const int tb = dir ? 56 - i8 * 8 : i8 * 8;
      *(u32x4*)(kdrow + tb) = pk;
    }
  }
  __syncthreads();
}

DI void gla_main(const Params& p, char* smem) {
  char* ws = p.ws;
  const u16* QT = (const u16*)(ws + C_QT); const u16* KT = (const u16*)(ws + C_KT); const u16* KDT = (const u16*)(ws + C_KDT); const u16* VT = (const u16*)(ws + C_VT);
  const float* DN = (const float*)(ws + C_DN);
  float* OF = (float*)(ws + WS_OP); float* OB = (float*)(ws + C_OB);
  u16* att = (u16*)smem;
  const int lane = threadIdx.x & 63, w = threadIdx.x >> 6, r = lane & 31, h = lane >> 5;
  for (int it = blockIdx.x; it < 768; it += gridDim.x) {
    const bool lat = it < 256;
    const int i2 = lat ? it : it - 256;
    const int bs = i2 >> 5, hd = (i2 >> 3) & 3, dir = (i2 >> 2) & 1, sl = i2 & 3;
    const int nc = lat ? 16 : 4, T0 = lat ? NCTX + bs * 1024 : bs * 256;
    const int vcol0 = hd * 512 + sl * 128 + w * 32;
    f32x16 S[8];
    if (lat) {
      const float* s0 = p.state_gla + ((size_t)((bs * 2 + dir) * 4 + hd) * 256) * 512 + (sl * 128 + w * 32 + r);
#pragma unroll
      for (int mt = 0; mt < 8; ++mt)
#pragma unroll
        for (int e = 0; e < 16; ++e) S[mt][e] = s0[(size_t)(32 * mt + crow(e, h)) * 512];
    } else {
#pragma unroll
      for (int mt = 0; mt < 8; ++mt)
#pragma unroll
        for (int e = 0; e < 16; ++e) S[mt][e] = 0.f;
    }
    float* OD = dir ? OB : OF;
    for (int cc = 0; cc < nc; ++cc) {
      const int c = dir ? nc - 1 - cc : cc;
      const int Tc = T0 + c * 64, cgx = Tc >> 6;
      const u16* qt = QT + ((size_t)dir * NTOK + Tc) * 1024 + hd * 256;
      const u16* kt = KT + ((size_t)dir * NTOK + Tc) * 1024 + hd * 256;
      const u16* kdT = KDT + ((size_t)((dir * 192 + cgx) * 4 + hd) * 256) * 64;
      const u16* vT = VT + ((size_t)cgx * 2048 + vcol0 + r) * 64;
      const float* dn = DN + (size_t)(dir * 192 + cgx) * 1024 + hd * 256;
      {
        f32x16 a;
#pragma unroll
        for (int e = 0; e < 16; ++e) a[e] = 0.f;
        const int ci = w >> 1, si = w & 1;
        const u16* qa = qt + (size_t)(32 * ci + r) * 1024 + 8 * h; const u16* kb = kt + (size_t)(32 * si + r) * 1024 + 8 * h;
#pragma unroll
        for (int ks = 0; ks < 16; ++ks) a = MFMA32(*(const bf16x8*)(qa + ks * 16), *(const bf16x8*)(kb + ks * 16), a);
#pragma unroll
        for (int e = 0; e < 16; ++e) {
          const int cr_ = 32 * ci + crow(e, h), sc_ = 32 * si + r;
          const bool keep = dir ? (sc_ >= cr_) : (sc_ <= cr_);
          att[cr_ * 72 + sc_] = keep ? f2bf(a[e]) : (u16)0;
        }
      }
      __syncthreads();
      f32x16 o[2];
#pragma unroll
      for (int q = 0; q < 2; ++q)
#pragma unroll
        for (int e = 0; e < 16; ++e) o[q][e] = 0.f;
#pragma unroll
      for (int mt = 0; mt < 8; ++mt)
#pragma unroll
        for (int s = 0; s < 2; ++s) {
          const bf16x8 sf = pack8(S[mt], s);
#pragma unroll
          for (int q = 0; q < 2; ++q) {
            const u16* qa = qt + (size_t)(32 * q + r) * 1024 + 32 * mt + 16 * s + 4 * h;
            const s16x4 lo = *(const s16x4*)qa, hi = *(const s16x4*)(qa + 8);
            o[q] = MFMA32(cat4(lo, hi), sf, o[q]);
          }
        }
      bf16x8 vf[4];
#pragma unroll
      for (int ks = 0; ks < 4; ++ks) vf[ks] = *(const bf16x8*)(vT + ks * 16 + 8 * h);
#pragma unroll
      for (int q = 0; q < 2; ++q)
#pragma unroll
        for (int ks = 0; ks < 4; ++ks) { const bf16x8 af = *(const bf16x8*)(att + (32 * q + r) * 72 + ks * 16 + 8 * h); o[q] = MFMA32(af, vf[ks], o[q]); }
#pragma unroll
      for (int q = 0; q < 2; ++q)
#pragma unroll
        for (int e = 0; e < 16; ++e) OD[(size_t)(Tc + 32 * q + crow(e, h)) * 2048 + vcol0 + r] = o[q][e];
#pragma unroll
      for (int mt = 0; mt < 8; ++mt) {
#pragma unroll
        for (int g = 0; g < 4; ++g) {
          const f32x4 d4 = *(const f32x4*)(dn + 32 * mt + 8 * g + 4 * h);
#pragma unroll
          for (int e = 0; e < 4; ++e) S[mt][4 * g + e] *= d4[e];
        }
#pragma unroll
        for (int ks = 0; ks < 4; ++ks) { const bf16x8 af = *(const bf16x8*)(kdT + (size_t)(32 * mt + r) * 64 + ks * 16 + 8 * h); S[mt] = MFMA32(af, vf[ks], S[mt]); }
      }
      __syncthreads();
    }
    if (!lat) {
      float* so = p.out + OUT_GLA + ((size_t)((bs * 2 + dir) * 4 + hd) * 256) * 512 + (sl * 128 + w * 32 + r);
#pragma unroll
      for (int mt = 0; mt < 8; ++mt)
#pragma unroll
        for (int e = 0; e < 16; ++e) so[(size_t)(32 * mt + crow(e, h)) * 512] = S[mt][e];
    }
  }
}

DI void gla_norm(const Params& p) {
  char* ws = p.ws;
  const float* OF = (const float*)(ws + WS_OP); const float* OB = (const float*)(ws + C_OB); const u16* SG = (const u16*)(ws + C_SGATE);
  u16* OG = (u16*)(ws + WS_H);
  const int lane = threadIdx.x & 63, wv = threadIdx.x >> 6;
  for (int T = blockIdx.x * 4 + wv; T < NTOK; T += gridDim.x * 4) {
    f32x4 x[8];
    float ss[4] = {0.f, 0.f, 0.f, 0.f};
#pragma unroll
    for (int j = 0; j < 8; ++j) {
      const size_t o = (size_t)T * 2048 + (j * 64 + lane) * 4;
      x[j] = *(const f32x4*)(OF + o) + *(const f32x4*)(OB + o);
      ss[j >> 1] += x[j][0] * x[j][0] + x[j][1] * x[j][1] + x[j][2] * x[j][2] + x[j][3] * x[j][3];
    }
#pragma unroll
    for (int q = 0; q < 4; ++q) ss[q] = rsqrtf(wave_sum(ss[q]) * (1.f / 512.f) + EPS);
#pragma unroll
    for (int j = 0; j < 8; ++j) {
      const int col = (j * 64 + lane) * 4;
      const size_t o = (size_t)T * 2048 + col;
      const f32x4 ng = *(const f32x4*)(p.gla_norm + (col & 511));
      const u32x2 sg = *(const u32x2*)(SG + o);
      const f32x4 y = x[j] * ss[j >> 1] * ng;
      st_bf4(OG + o, y[0] * bflo(sg.x), y[1] * bfhi(sg.x), y[2] * bflo(sg.y), y[3] * bfhi(sg.y));
    }
  }
}

#define XB_TMO      128
#define XB_XCNT(j)  (256  + 64 * (j))
#define XB_XSUB(j)  (1280 + 64 * (j))
#define XB_XGEN(j)  (2304 + 64 * (j))
#define XB_TOP      3328
#define XB_TOPGEN   3392
#define XCD_BAR_WORDS 3456
#define XB_SPIN_CAP (1u << 18)
#define LAS __attribute__((address_space(3)))
DI unsigned xb_ld(unsigned* p) { return __hip_atomic_load(p, __ATOMIC_RELAXED, __HIP_MEMORY_SCOPE_AGENT); }
DI unsigned xb_add(unsigned* p, unsigned v) { return __hip_atomic_fetch_add(p, v, __ATOMIC_RELAXED, __HIP_MEMORY_SCOPE_AGENT); }
DI unsigned xb_xcc_id() { return (unsigned)__builtin_amdgcn_s_getreg((3 << 11) | 20) & 0xFu; }
#define XB_SPIN(cond, bar) do { unsigned _sp = 0; while (cond) { __builtin_amdgcn_s_sleep(1); \
    if ((++_sp & 255u) == 0u) { if (xb_ld(&(bar)[XB_TMO])) break; if (_sp > XB_SPIN_CAP) { atomicAdd(&(bar)[XB_TMO], 1u); break; } } } } while (0)
struct XcdBarrier { unsigned* bar; unsigned x; volatile LAS unsigned* st; };
DI XcdBarrier xcd_barrier_post(unsigned* bar, volatile LAS unsigned* st) {
  XcdBarrier b; b.bar = bar; b.x = xb_xcc_id(); b.st = st;
  if (threadIdx.x == 0) (void)xb_add(&bar[XB_XCNT(b.x)], 1u);
  return b;
}
DI void xcd_barrier_complete(unsigned* bar, unsigned x, unsigned& nloc, unsigned& nx) {
  const unsigned G = gridDim.x * gridDim.y * gridDim.z;
  unsigned sum, cnt, mine, sp = 0u;
  for (;;) {
    sum = 0u; cnt = 0u; mine = 0u;
#pragma unroll
    for (unsigned j = 0; j < 16; ++j) { const unsigned c = xb_ld(&bar[XB_XCNT(j)]); sum += c; cnt += (c > 0u) ? 1u : 0u; mine = (j == x) ? c : mine; }
    if (sum == G) break;
    __builtin_amdgcn_s_sleep(1);
    if ((++sp & 255u) == 0u) { if (xb_ld(&bar[XB_TMO])) break; if (sp > XB_SPIN_CAP) { atomicAdd(&bar[XB_TMO], 1u); break; } }
  }
  nloc = mine > 0u ? mine : 1u; nx = cnt > 0u ? cnt : 1u;
}
DI void xcd_barrier(const XcdBarrier& b) {
  asm volatile("s_waitcnt vmcnt(0)" ::: "memory");
  __syncthreads();
  if (threadIdx.x == 0) {
    unsigned* bar = b.bar;
    __builtin_amdgcn_s_waitcnt(0);
    unsigned nloc = b.st[0], nx = b.st[1];
    if (nloc == 0u) { xcd_barrier_complete(bar, b.x, nloc, nx); b.st[0] = nloc; b.st[1] = nx; }
    const unsigned old = xb_add(&bar[XB_XSUB(b.x)], 1u);
    const unsigned gen = old / nloc;
    if (old + 1u == (gen + 1u) * nloc) {
      __builtin_amdgcn_fence(__ATOMIC_RELEASE, "agent");
      asm volatile("s_waitcnt vmcnt(0)" ::: "memory");
      const unsigned og = xb_add(&bar[XB_TOP], 1u);
      const unsigned tg = og / nx;
      if (og + 1u == (tg + 1u) * nx) xb_add(&bar[XB_TOPGEN], 1u);
      else XB_SPIN(xb_ld(&bar[XB_TOPGEN]) == tg, bar);
      __builtin_amdgcn_fence(__ATOMIC_ACQUIRE, "agent");
      xb_add(&bar[XB_XGEN(b.x)], 1u);
      asm volatile("s_waitcnt vmcnt(0)" ::: "memory");
    } else {
      XB_SPIN(xb_ld(&bar[XB_XGEN(b.x)]) == gen, bar);
      __builtin_amdgcn_fence(__ATOMIC_ACQUIRE, "agent");
      asm volatile("s_waitcnt vmcnt(0)" ::: "memory");
    }
  }
  __syncthreads();
}

constexpr int NPHASE = 26;
#ifndef DUPMASK
#define DUPMASK 0u
#endif
template <int PH>
DI void run_phase(const Params& p, char* smem) {
  char* ws = p.ws;
  if constexpr (PH == 0) phase0(p, smem);
  else if constexpr (PH == 1) norm_phase(p, 0, true);
  else if constexpr (PH == 2) mla_g1(p, 0, smem);
  else if constexpr (PH == 3) mla_a2(p, 0);
  else if constexpr (PH == 4) mla_g2(p, 0, smem);
  else if constexpr (PH == 5) mla_attn(p);
  else if constexpr (PH == 6) gemm_out(p, (const u16*)(ws + WS_H), (const u16*)(ws + WS_WT_MLA_OUT), smem);
  else if constexpr (PH == 7) norm_phase(p, 1, false);
  else if constexpr (PH == 8) s5_g1(p, smem);
  else if constexpr (PH == 9) s5_scan(p);
  else if constexpr (PH == 10) s5_combine(p);
  else if constexpr (PH == 11) s5_g2(p, smem);
  else if constexpr (PH == 12) gemm_out(p, (const u16*)(ws + B_Z), (const u16*)(ws + WS_WT_S5_OUT), smem);
  else if constexpr (PH == 13) norm_phase(p, 2, false);
  else if constexpr (PH == 14) gla_g1(p, smem);
  else if constexpr (PH == 15) gla_gate(p, (float*)smem);
  else if constexpr (PH == 16) gla_main(p, smem);
  else if constexpr (PH == 17) gla_norm(p);
  else if constexpr (PH == 18) gemm_out(p, (const u16*)(ws + WS_H), (const u16*)(ws + WS_WT_GLA_OUT), smem);
  else if constexpr (PH == 19) norm_phase(p, 3, false);
  else if constexpr (PH == 20) mla_g1(p, 1, smem);
  else if constexpr (PH == 21) mla_a2(p, 1);
  else if constexpr (PH == 22) mla_g2(p, 1, smem);
  else if constexpr (PH == 23) mla_attn(p);
  else if constexpr (PH == 24) gemm_out(p, (const u16*)(ws + WS_H), (const u16*)(ws + WS_WT_MLA_OUT) + (size_t)2048 * 2048, smem);
  else if constexpr (PH == 25) norm_phase(p, 4, false);
}

template <int PH>
DI void run_from(const Params& p, char* smem, const XcdBarrier& xb) {
  run_phase<PH>(p, smem);
  if constexpr ((DUPMASK >> PH) & 1u) { __syncthreads(); run_phase<PH>(p, smem); }
  if constexpr (PH + 1 < NPHASE) { xcd_barrier(xb); run_from<PH + 1>(p, smem, xb); }
}

#if COOP
__global__ void __launch_bounds__(256, 2) mega(Params p) {
  __shared__ __attribute__((aligned(16))) char smem[73728];
  __shared__ uint4 xb_words;
  cg::grid_group grid = cg::this_grid();
  if (p.out == nullptr) grid.sync();
  if (threadIdx.x == 0) xb_words = make_uint4(0u, 0u, 0u, 0u);
  __syncthreads();
  const XcdBarrier xb = xcd_barrier_post((unsigned*)(p.ws + WS_BAR), (volatile LAS unsigned*)&xb_words);
  run_from<0>(p, smem, xb);
}
#else
template <int PH>
__global__ void __launch_bounds__(256, 2) phase_k(Params p) {
  __shared__ __attribute__((aligned(16))) char smem[73728];
  run_phase<PH>(p, smem);
}
template <int PH>
static void launch_from(const Params& p, int grid, hipStream_t stream) {
  hipLaunchKernelGGL(phase_k<PH>, dim3(grid), dim3(256), 0, stream, p);
  if constexpr (PH + 1 < NPHASE) launch_from<PH + 1>(p, grid, stream);
}
#endif

extern "C" void kernel_launch(void* const* d_in, const int* in_sizes, int n_in, void* d_out, int out_size, void* d_ws, size_t ws_size, hipStream_t stream) {
  static int grid_blocks = 0;
  if (!grid_blocks) {
    int dev = 0, cus = 0, per_cu = 0;
    (void)hipGetDevice(&dev);
    (void)hipDeviceGetAttribute(&cus, hipDeviceAttributeMultiprocessorCount, dev);
#if COOP
    (void)hipOccupancyMaxActiveBlocksPerMultiprocessor(&per_cu, mega, 256, 0);
#else
    per_cu = 2;
#endif
    if (per_cu < 1) per_cu = 1;
    if (per_cu > 2) per_cu = 2;
    grid_blocks = cus * per_cu;
  }
  Params p{};
  const float** pp = (const float**)&p;
  for (int i = 0; i < 33; ++i) pp[i] = (const float*)d_in[i];
  p.out = (float*)d_out;
  p.ws = (char*)d_ws;
#if COOP
  (void)hipMemsetAsync(d_ws, 0, XCD_BAR_WORDS * 4, stream);
  void* args[] = {&p};
  hipError_t e = hipLaunchCooperativeKernel((void*)mega, dim3(grid_blocks), dim3(256), args, 0, stream);
  if (e != hipSuccess) fprintf(stderr, "cooperative launch failed: %s (grid %d)\n", hipGetErrorString(e), grid_blocks);
#else
  launch_from<0>(p, grid_blocks, stream);
#endif
}
```

```cpp
#include <hip/hip_runtime.h>
#include <hip/hip_cooperative_groups.h>
#include <stdint.h>
#include <cstdio>
namespace cg = cooperative_groups;

#ifndef COOP
#define COOP 1
#endif

typedef unsigned short u16;
typedef short bf16x8 __attribute__((ext_vector_type(8)));
typedef short s16x4 __attribute__((ext_vector_type(4)));
typedef float f32x16 __attribute__((ext_vector_type(16)));
typedef float f32x4 __attribute__((ext_vector_type(4)));
typedef float f32x2 __attribute__((ext_vector_type(2)));
typedef unsigned u32x4 __attribute__((ext_vector_type(4)));
typedef unsigned u32x2 __attribute__((ext_vector_type(2)));
typedef __bf16 bfv2 __attribute__((ext_vector_type(2)));
#define DI __device__ __forceinline__
#define MFMA32(a, b, c) __builtin_amdgcn_mfma_f32_32x32x16_bf16((a), (b), (c), 0, 0, 0)

constexpr int D = 2048, NTOK = 12288, NCTX = 4096;
constexpr float EPS = 1e-6f;
constexpr size_t OUT_CKV = 25165824, OUT_KROPE = 29360128, OUT_S5 = 29884416, OUT_GLA = 30408704;
constexpr size_t WS_BAR = 0;
constexpr size_t WS_WT_MLA_IN = 16384;
constexpr size_t WS_WT_MLA_UKV = WS_WT_MLA_IN + 2ull * 5760 * 2048 * 2;
constexpr size_t WS_WT_MLA_OUT = WS_WT_MLA_UKV + 2ull * 4096 * 512 * 2;
constexpr size_t WS_WT_S5_IN = WS_WT_MLA_OUT + 2ull * 2048 * 2048 * 2;
constexpr size_t WS_WT_S5_GLU = WS_WT_S5_IN + 4096ull * 2048 * 2;
constexpr size_t WS_WT_S5_OUT = WS_WT_S5_GLU + 2048ull * 2048 * 2;
constexpr size_t WS_WT_GLA_IN = WS_WT_S5_OUT + 2048ull * 2048 * 2;
constexpr size_t WS_WT_GLA_OUT = WS_WT_GLA_IN + 6272ull * 2048 * 2;
constexpr size_t WS_MOD = WS_WT_GLA_OUT + 2048ull * 2048 * 2;
constexpr size_t WS_H = WS_MOD + 4ull * 9 * 6144 * 4;
constexpr size_t WS_OP = WS_H + 12288ull * 2048 * 2;
constexpr size_t WS_SCR = WS_OP + 12288ull * 2048 * 4;
constexpr size_t A_QB = WS_SCR;
constexpr size_t A_CKVRAW = A_QB + 12288ull * 3072 * 2;
constexpr size_t A_CKVALL = A_CKVRAW + 12288ull * 512 * 4;
constexpr size_t A_SGATE = A_CKVALL + 14336ull * 512 * 2;
constexpr size_t A_KB = A_SGATE + 12288ull * 2048 * 2;
constexpr size_t A_VT = A_KB + 14336ull * 16 * 192 * 2;
constexpr size_t B_U = WS_SCR;
constexpr size_t B_SGATE = B_U + 12288ull * 2048 * 4;
constexpr size_t B_YB = B_SGATE + 12288ull * 2048 * 2;
constexpr size_t B_Z = B_YB + 12288ull * 2048 * 4;
constexpr size_t C_QG = WS_SCR;
constexpr size_t C_KG = C_QG + 12288ull * 1024 * 2;
constexpr size_t C_VT = C_KG + 12288ull * 1024 * 2;
constexpr size_t C_SGATE = C_VT + 12288ull * 2048 * 2;
constexpr size_t C_GLR = C_SGATE + 12288ull * 2048 * 2;
constexpr size_t C_QT = C_GLR + 12288ull * 32 * 4;
constexpr size_t C_KT = C_QT + 2ull * 12288 * 1024 * 2;
constexpr size_t C_KDT = C_KT + 2ull * 12288 * 1024 * 2;
constexpr size_t C_DN = C_KDT + 2ull * 12288 * 1024 * 2;
constexpr size_t C_OB = C_DN + 2ull * 192 * 1024 * 4;

struct Params {
  const float *x_prompt, *x_sample, *cache_ckv, *cache_krope, *state_s5, *state_gla, *c, *c_ctx;
  const float *ada_w, *ada_b, *norm_pre, *norm_post;
  const float *mla_w_in, *mla_kv_norm, *mla_w_ukv, *mla_w_out;
  const float *s5_w_in, *s5_a_re, *s5_a_im, *s5_log_dt, *s5_b_re, *s5_b_im, *s5_c_re, *s5_c_im, *s5_d, *s5_w_glu, *s5_b_glu, *s5_w_out;
  const float *gla_w_in, *gla_w_g2, *gla_b_g, *gla_norm, *gla_w_out;
  float* out;
  char* ws;
};

DI unsigned pk2(float a, float b) { f32x2 v; v.x = a; v.y = b; bfv2 r = __builtin_convertvector(v, bfv2); return __builtin_bit_cast(unsigned, r); }
DI u16 f2bf(float a) { return (u16)(pk2(a, 0.f) & 0xffffu); }
DI float bf2f(u16 v) { return __uint_as_float(((unsigned)v) << 16); }
DI float bflo(unsigned v) { return __uint_as_float(v << 16); }
DI float bfhi(unsigned v) { return __uint_as_float(v & 0xffff0000u); }
DI float siluf(float x) { return x / (1.f + __expf(-x)); }
DI float sigmf(float x) { return 1.f / (1.f + __expf(-x)); }
DI int crow(int reg, int h) { return (reg & 3) + 8 * (reg >> 2) + 4 * h; }
DI void st_bf4(u16* p, float a, float b, float c, float d) { u32x2 v; v.x = pk2(a, b); v.y = pk2(c, d); *(u32x2*)p = v; }
DI bf16x8 pack8(const f32x16& x, int s) {
  u32x4 p;
  p.x = pk2(x[8 * s + 0], x[8 * s + 1]); p.y = pk2(x[8 * s + 2], x[8 * s + 3]);
  p.z = pk2(x[8 * s + 4], x[8 * s + 5]); p.w = pk2(x[8 * s + 6], x[8 * s + 7]);
  return __builtin_bit_cast(bf16x8, p);
}
DI bf16x8 cat4(s16x4 lo, s16x4 hi) { return __builtin_shufflevector(lo, hi, 0, 1, 2, 3, 4, 5, 6, 7); }
DI float wave_sum(float v) {
#pragma unroll
  for (int o = 32; o >= 1; o >>= 1) v += __shfl_xor(v, o);
  return v;
}
DI int tid_() { int t = threadIdx.x; asm volatile("" : "+v"(t)); return t; }
DI int cond_of(int T) { return T < NCTX ? 8 : ((T - NCTX) >> 10); }
DI int kvrow_of(int T) { return T < NCTX ? T : NCTX + ((T - NCTX) >> 10) * 1280 + ((T - NCTX) & 1023); }

DI void ada_phase(const Params& p, float* smem) {
  const int tid = tid_();
  float* mod = (float*)(p.ws + WS_MOD);
  for (int it = blockIdx.x; it < 384; it += gridDim.x) {
    const int l = it / 96, n0 = (it % 96) * 64;
    __syncthreads();
    for (int i = tid; i < 9 * 2048; i += 256) { const int cd = i >> 11, k = i & 2047; const float v = cd < 8 ? p.c[cd * 2048 + k] : p.c_ctx[k]; smem[i] = siluf(v); }
    __syncthreads();
    const int c4 = tid & 15, ks = tid >> 4;
    const float* w = p.ada_w + (size_t)l * 2048 * 6144 + n0 + c4 * 4;
    float acc[9][4];
#pragma unroll
    for (int cd = 0; cd < 9; ++cd)
#pragma unroll
      for (int e = 0; e < 4; ++e) acc[cd][e] = 0.f;
#pragma unroll 4
    for (int kk = 0; kk < 128; ++kk) {
      const int k = ks * 128 + kk;
      const f32x4 wv = __builtin_nontemporal_load((const f32x4*)(w + (size_t)k * 6144));
#pragma unroll
      for (int cd = 0; cd < 9; ++cd) {
        const float s = smem[cd * 2048 + k];
#pragma unroll
        for (int e = 0; e < 4; ++e) acc[cd][e] += s * wv[e];
      }
    }
    __syncthreads();
#pragma unroll
    for (int cd = 0; cd < 9; ++cd)
#pragma unroll
      for (int e = 0; e < 4; ++e) smem[(ks * 9 + cd) * 64 + c4 * 4 + e] = acc[cd][e];
    __syncthreads();
    for (int o = tid; o < 576; o += 256) {
      const int cd = o >> 6, col = o & 63;
      float s = 0.f;
#pragma unroll
      for (int k2 = 0; k2 < 16; ++k2) s += smem[(k2 * 9 + cd) * 64 + col];
      mod[(size_t)(l * 9 + cd) * 6144 + n0 + col] = s + p.ada_b[l * 6144 + n0 + col];
    }
  }
  __syncthreads();
}

DI void transpose_job(const float* __restrict__ src, u16* __restrict__ dst, int K, int N, int Npad, float* tile) {
  const int tid = tid_();
  const int nkt = K / 64, total = nkt * (Npad / 64);
  for (int t = blockIdx.x; t < total; t += gridDim.x) {
    const int k0 = (t % nkt) * 64, n0 = (t / nkt) * 64;
    const int c = tid & 63, r0 = tid >> 6;
#pragma unroll
    for (int i = 0; i < 16; ++i) { const int r = r0 + 4 * i; tile[r * 65 + c] = (n0 + c < N) ? src[(size_t)(k0 + r) * N + n0 + c] : 0.f; }
    __syncthreads();
    const int n = tid >> 2, ks = (tid & 3) * 16;
    u32x4 v0, v1;
    v0.x = pk2(tile[(ks + 0) * 65 + n], tile[(ks + 1) * 65 + n]); v0.y = pk2(tile[(ks + 2) * 65 + n], tile[(ks + 3) * 65 + n]);
    v0.z = pk2(tile[(ks + 4) * 65 + n], tile[(ks + 5) * 65 + n]); v0.w = pk2(tile[(ks + 6) * 65 + n], tile[(ks + 7) * 65 + n]);
    v1.x = pk2(tile[(ks + 8) * 65 + n], tile[(ks + 9) * 65 + n]); v1.y = pk2(tile[(ks + 10) * 65 + n], tile[(ks + 11) * 65 + n]);
    v1.z = pk2(tile[(ks + 12) * 65 + n], tile[(ks + 13) * 65 + n]); v1.w = pk2(tile[(ks + 14) * 65 + n], tile[(ks + 15) * 65 + n]);
    u16* d = dst + (size_t)(n0 + n) * K + k0 + ks;
    *(u32x4*)d = v0; *(u32x4*)(d + 8) = v1;
    __syncthreads();
  }
}

DI void phase0(const Params& p, char* smem) {
  ada_phase(p, (float*)smem);
  float* tile = (float*)smem;
  char* ws = p.ws;
  for (int j = 0; j < 2; ++j) {
    transpose_job(p.mla_w_in + (size_t)j * 2048 * 5696, (u16*)(ws + WS_WT_MLA_IN) + (size_t)j * 5760 * 2048, 2048, 5696, 5760, tile);
    transpose_job(p.mla_w_ukv + (size_t)j * 512 * 4096, (u16*)(ws + WS_WT_MLA_UKV) + (size_t)j * 4096 * 512, 512, 4096, 4096, tile);
    transpose_job(p.mla_w_out + (size_t)j * 2048 * 2048, (u16*)(ws + WS_WT_MLA_OUT) + (size_t)j * 2048 * 2048, 2048, 2048, 2048, tile);
  }
  transpose_job(p.s5_w_in, (u16*)(ws + WS_WT_S5_IN), 2048, 4096, 4096, tile);
  transpose_job(p.s5_w_glu, (u16*)(ws + WS_WT_S5_GLU), 2048, 2048, 2048, tile);
  transpose_job(p.s5_w_out, (u16*)(ws + WS_WT_S5_OUT), 2048, 2048, 2048, tile);
  transpose_job(p.gla_w_in, (u16*)(ws + WS_WT_GLA_IN), 2048, 6176, 6272, tile);
  transpose_job(p.gla_w_out, (u16*)(ws + WS_WT_GLA_OUT), 2048, 2048, 2048, tile);
}

DI void norm_phase(const Params& p, int l, bool first) {
  const int lane = tid_() & 63, wv = tid_() >> 6;
  const float* mod = (const float*)(p.ws + WS_MOD);
  const float* OP = (const float*)(p.ws + WS_OP);
  u16* H = (u16*)(p.ws + WS_H);
  for (int T = blockIdx.x * 4 + wv; T < NTOK; T += gridDim.x * 4) {
    const int cd = cond_of(T);
    const float* xin = T < NCTX ? p.x_prompt + (size_t)T * D : p.x_sample + (size_t)(T - NCTX) * D;
    float* xrow = p.out + (size_t)T * D;
    f32x4 x[8];
    if (first) {
#pragma unroll
      for (int j = 0; j < 8; ++j) x[j] = *(const f32x4*)(xin + (j * 64 + lane) * 4);
    } else {
      const float* xold = (l == 1) ? xin : xrow;
      const float* op = OP + (size_t)T * D;
      f32x4 o[8];
      float ss = 0.f;
#pragma unroll
      for (int j = 0; j < 8; ++j) { o[j] = *(const f32x4*)(op + (j * 64 + lane) * 4); ss += o[j][0] * o[j][0] + o[j][1] * o[j][1] + o[j][2] * o[j][2] + o[j][3] * o[j][3]; }
      ss = wave_sum(ss);
      const float rstd = rsqrtf(ss * (1.f / D) + EPS);
      const float* npost = p.norm_post + (l - 1) * D;
      const float* gate = mod + (size_t)((l - 1) * 9 + cd) * 6144 + 4096;
#pragma unroll
      for (int j = 0; j < 8; ++j) {
        const int col = (j * 64 + lane) * 4;
        const f32x4 xo = *(const f32x4*)(xold + col), np = *(const f32x4*)(npost + col), g = *(const f32x4*)(gate + col);
        x[j] = xo + g * (o[j] * rstd * np);
        *(f32x4*)(xrow + col) = x[j];
      }
    }
    if (l < 4) {
      float ss = 0.f;
#pragma unroll
      for (int j = 0; j < 8; ++j) ss += x[j][0] * x[j][0] + x[j][1] * x[j][1] + x[j][2] * x[j][2] + x[j][3] * x[j][3];
      ss = wave_sum(ss);
      const float rstd = rsqrtf(ss * (1.f / D) + EPS);
      const float* npre = p.norm_pre + l * D;
      const float* sh = mod + (size_t)(l * 9 + cd) * 6144;
      u16* hrow = H + (size_t)T * D;
#pragma unroll
      for (int j = 0; j < 8; ++j) {
        const int col = (j * 64 + lane) * 4;
        const f32x4 np = *(const f32x4*)(npre + col), s1 = *(const f32x4*)(sh + col), sc = *(const f32x4*)(sh + 2048 + col);
        const f32x4 hv = x[j] * rstd * np * (1.f + sc) + s1;
        st_bf4(hrow + col, hv[0], hv[1], hv[2], hv[3]);
      }
    }
  }
}

template <bool SWAP, class Epi>
DI void gemm_tile(const int w, const u16* __restrict__ A, int lda, const u16* __restrict__ Bt, int ldb, int K, int m0, int n0, const Epi& epi, char* smem) {
  u16* As = (u16*)smem;
  u16* Bs = As + 256 * 72;
  const int tid = tid_(), lane = tid & 63, r = lane & 31, h = lane >> 5;
  const int wm = w >> 1, wn = w & 1;
  const int lrow = tid >> 3, lseg = tid & 7;
  const __amdgpu_buffer_rsrc_t Ars = __builtin_amdgcn_make_buffer_rsrc((void*)(A + (size_t)m0 * lda), 0, 0x7fffffff, 0x00020000);
  const __amdgpu_buffer_rsrc_t Brs = __builtin_amdgcn_make_buffer_rsrc((void*)(Bt + (size_t)n0 * ldb), 0, 0x7fffffff, 0x00020000);
  const int aoff = (lrow * lda + lseg * 8) * 2, boff = (lrow * ldb + lseg * 8) * 2;
  u32x4 ra[8], rb[4];
  f32x16 acc[4][2];
#pragma unroll
  for (int i = 0; i < 4; ++i)
#pragma unroll
    for (int j = 0; j < 2; ++j)
#pragma unroll
      for (int e = 0; e < 16; ++e) acc[i][j][e] = 0.f;
#define GT_GL(K0) { _Pragma("unroll") for (int q = 0; q < 8; ++q) ra[q] = __builtin_bit_cast(u32x4, __builtin_amdgcn_raw_buffer_load_b128(Ars, aoff, (32 * q * lda + (K0)) * 2, 0)); \
                    _Pragma("unroll") for (int q = 0; q < 4; ++q) rb[q] = __builtin_bit_cast(u32x4, __builtin_amdgcn_raw_buffer_load_b128(Brs, boff, (32 * q * ldb + (K0)) * 2, 0)); }
#define GT_LS() { _Pragma("unroll") for (int q = 0; q < 8; ++q) *(u32x4*)(As + (lrow + 32 * q) * 72 + lseg * 8) = ra[q]; \
                  _Pragma("unroll") for (int q = 0; q < 4; ++q) *(u32x4*)(Bs + (lrow + 32 * q) * 72 + lseg * 8) = rb[q]; }
  const int nk = K >> 6;
  GT_GL(0);
  __syncthreads();
  GT_LS();
  __syncthreads();
  const u16* as = As + (wm * 128 + r) * 72 + h * 8;
  const u16* bs = Bs + (wn * 64 + r) * 72 + h * 8;
  for (int kt = 0; kt < nk; ++kt) {
    { const int k1 = (kt + 1 < nk ? kt + 1 : kt) << 6; GT_GL(k1); }
    __builtin_amdgcn_sched_barrier(0);
#pragma unroll
    for (int ks = 0; ks < 4; ++ks) {
      bf16x8 b[2];
#pragma unroll
      for (int j = 0; j < 2; ++j) b[j] = *(const bf16x8*)(bs + j * 32 * 72 + ks * 16);
#pragma unroll
      for (int i = 0; i < 4; ++i) {
        const bf16x8 a = *(const bf16x8*)(as + i * 32 * 72 + ks * 16);
#pragma unroll
        for (int j = 0; j < 2; ++j) acc[i][j] = SWAP ? MFMA32(b[j], a, acc[i][j]) : MFMA32(a, b[j], acc[i][j]);
      }
    }
    __syncthreads();
    GT_LS();
    __syncthreads();
  }
#undef GT_GL
#undef GT_LS
  int lane2;
  asm volatile("v_mbcnt_lo_u32_b32 %0, -1, 0\n\tv_mbcnt_hi_u32_b32 %0, -1, %0" : "=v"(lane2));
  const int r2 = lane2 & 31, h2 = lane2 >> 5;
#pragma unroll
  for (int i = 0; i < 4; ++i)
#pragma unroll
    for (int j = 0; j < 2; ++j) epi(m0 + wm * 128 + i * 32, n0 + wn * 64 + j * 32, acc[i][j], r2, h2);
}

template <class F>
DI void for_tiles(int MT, int NT, const F& f) {
  const int G = gridDim.x;
  if ((G & 7) == 0 && (MT & 7) == 0) {
    const int G8 = G >> 3, xcd = blockIdx.x & 7, loc = blockIdx.x >> 3;
    const int SM = MT >> 3, SN = (NT + 7) >> 3, total = SM * SN * 64;
    for (int i = 0;; ++i) {
      const int u = (i * 8 + xcd) * G8 + loc;
      if (u >= total) break;
      const int sup = u >> 6, win = u & 63;
      const int mt = (sup % SM) * 8 + (win & 7), nt = (sup / SM) * 8 + (win >> 3);
      if (nt < NT) f(mt, nt);
    }
  } else {
    for (int t = blockIdx.x; t < MT * NT; t += G) f(t % MT, t / MT);
  }
}

DI void rope16(f32x16& v, int pos, int h) {
#pragma unroll
  for (int g = 0; g < 2; ++g)
#pragma unroll
    for (int e = 0; e < 4; ++e) {
      const int f = 8 * g + 4 * h + e;
      const float invf = exp2f(-(float)f * 0.83048202372184058696f);
      const float rev = ((float)pos * invf) * 0.15915494309189533577f;
      const float sn = __builtin_amdgcn_sinf(rev), cs = __builtin_amdgcn_cosf(rev);
      const float x1 = v[4 * g + e], x2 = v[4 * (g + 2) + e];
      v[4 * g + e] = x1 * cs - x2 * sn;
      v[4 * (g + 2) + e] = x1 * sn + x2 * cs;
    }
}

DI void mla_g1(const Params& p, int j, char* smem) {
  char* ws = p.ws;
  const u16* H = (const u16*)(ws + WS_H);
  const u16* Wt = (const u16*)(ws + WS_WT_MLA_IN) + (size_t)j * 5760 * 2048;
  auto epi = [&](int tm, int tn, const f32x16& acc, int r, int h) {
    char* ws2 = p.ws;
    u16* QB = (u16*)(ws2 + A_QB); float* CKVRAW = (float*)(ws2 + A_CKVRAW); u16* SG = (u16*)(ws2 + A_SGATE); u16* KB = (u16*)(ws2 + A_KB);
    float* okr = p.out + OUT_KROPE;
    const int m = tm + r;
    if (tn < 3072) {
      const int within = tn % 192;
      f32x16 v = acc;
      if (within >= 128 && m >= NCTX) { const int tl = (m - NCTX) & 1023; rope16(v, within < 160 ? (tl >> 6) : (tl & 63), h); }
#pragma unroll
      for (int g = 0; g < 4; ++g) st_bf4(QB + (size_t)m * 3072 + tn + 8 * g + 4 * h, v[4 * g], v[4 * g + 1], v[4 * g + 2], v[4 * g + 3]);
    } else if (tn < 3584) {
#pragma unroll
      for (int g = 0; g < 4; ++g) { f32x4 o = {acc[4 * g], acc[4 * g + 1], acc[4 * g + 2], acc[4 * g + 3]}; *(f32x4*)(CKVRAW + (size_t)m * 512 + (tn - 3072) + 8 * g + 4 * h) = o; }
    } else if (tn < 3648) {
      f32x16 v = acc;
      const int c0 = tn - 3584;
      if (m >= NCTX) { const int tl = (m - NCTX) & 1023; rope16(v, c0 == 0 ? (tl >> 6) : (tl & 63), h); }
      else {
        const int b = m >> 8, t = m & 255;
#pragma unroll
        for (int g = 0; g < 4; ++g) { f32x4 o = {v[4 * g], v[4 * g + 1], v[4 * g + 2], v[4 * g + 3]}; *(f32x4*)(okr + ((size_t)(b * 2 + j) * 256 + t) * 64 + c0 + 8 * g + 4 * h) = o; }
      }
      const size_t R = kvrow_of(m);
      for (int hd = 0; hd < 16; ++hd)
#pragma unroll
        for (int g = 0; g < 4; ++g) st_bf4(KB + (R * 16 + hd) * 192 + 128 + c0 + 8 * g + 4 * h, v[4 * g], v[4 * g + 1], v[4 * g + 2], v[4 * g + 3]);
    } else if (tn < 5696) {
#pragma unroll
      for (int g = 0; g < 4; ++g) st_bf4(SG + (size_t)m * 2048 + (tn - 3648) + 8 * g + 4 * h, siluf(acc[4 * g]), siluf(acc[4 * g + 1]), siluf(acc[4 * g + 2]), siluf(acc[4 * g + 3]));
    }
  };
  const int wv_ = __builtin_amdgcn_readfirstlane(tid_() >> 6);
  for_tiles(48, 45, [&](int mt, int nt) { gemm_tile<true>(wv_, H, 2048, Wt, 2048, 2048, mt * 256, nt * 128, epi, smem); });
}

DI void mla_a2(const Params& p, int j) {
  char* ws = p.ws;
  const int lane = tid_() & 63, wv = tid_() >> 6;
  const float* CKVRAW = (const float*)(ws + A_CKVRAW); u16* CKVALL = (u16*)(ws + A_CKVALL); u16* KB = (u16*)(ws + A_KB);
  const float* kvn = p.mla_kv_norm + j * 512;
  float* ockv = p.out + OUT_CKV;
  for (int R = blockIdx.x * 4 + wv; R < 14336; R += gridDim.x * 4) {
    int T = -1, cb = 0, ct = 0;
    if (R < NCTX) T = R;
    else { const int r2 = R - NCTX; cb = r2 / 1280; const int tp = r2 - cb * 1280; if (tp < 1024) T = NCTX + cb * 1024 + tp; else ct = tp - 1024; }
    u16* dst = CKVALL + (size_t)R * 512;
    if (T >= 0) {
      const float* src = CKVRAW + (size_t)T * 512;
      const f32x4 a = *(const f32x4*)(src + lane * 4), b = *(const f32x4*)(src + 256 + lane * 4);
      float ss = a[0] * a[0] + a[1] * a[1] + a[2] * a[2] + a[3] * a[3] + b[0] * b[0] + b[1] * b[1] + b[2] * b[2] + b[3] * b[3];
      ss = wave_sum(ss);
      const float rstd = rsqrtf(ss * (1.f / 512.f) + EPS);
      const f32x4 g0 = *(const f32x4*)(kvn + lane * 4), g1 = *(const f32x4*)(kvn + 256 + lane * 4);
      const f32x4 y0 = a * rstd * g0, y1 = b * rstd * g1;
      st_bf4(dst + lane * 4, y0[0], y0[1], y0[2], y0[3]);
      st_bf4(dst + 256 + lane * 4, y1[0], y1[1], y1[2], y1[3]);
      if (T < NCTX) {
        float* o = ockv + ((size_t)((T >> 8) * 2 + j) * 256 + (T & 255)) * 512;
        *(f32x4*)(o + lane * 4) = y0; *(f32x4*)(o + 256 + lane * 4) = y1;
      }
    } else {
      const float* src = p.cache_ckv + ((size_t)(cb * 2 + j) * 256 + ct) * 512;
      const f32x4 a = *(const f32x4*)(src + lane * 4), b = *(const f32x4*)(src + 256 + lane * 4);
      st_bf4(dst + lane * 4, a[0], a[1], a[2], a[3]);
      st_bf4(dst + 256 + lane * 4, b[0], b[1], b[2], b[3]);
      const float kr = p.cache_krope[((size_t)(cb * 2 + j) * 256 + ct) * 64 + lane];
      const u16 kb = f2bf(kr);
      for (int hd = 0; hd < 16; ++hd) KB[((size_t)R * 16 + hd) * 192 + 128 + lane] = kb;
    }
  }
}

DI void mla_g2(const Params& p, int j, char* smem) {
  char* ws = p.ws;
  const u16* CKVALL = (const u16*)(ws + A_CKVALL);
  const u16* Wt = (const u16*)(ws + WS_WT_MLA_UKV) + (size_t)j * 4096 * 512;
  u16* KB = (u16*)(ws + A_KB); u16* VT = (u16*)(ws + A_VT);
  auto epiK = [&](int tm, int tn, const f32x16& acc, int r, int h) {
    const size_t R = tm + r; const int hd = tn >> 8, wi = tn & 255;
#pragma unroll
    for (int g = 0; g < 4; ++g) st_bf4(KB + (R * 16 + hd) * 192 + wi + 8 * g + 4 * h, acc[4 * g], acc[4 * g + 1], acc[4 * g + 2], acc[4 * g + 3]);
  };
  auto epiV = [&](int tm, int tn, const f32x16& acc, int r, int h) {
    const int n = tn + r; const int hd = n >> 8, d = (n & 255) - 128;
    size_t base; int nkeys, key0;
    if (tm < NCTX) { base = (size_t)(tm >> 8) * 256 * 2048; nkeys = 256; key0 = tm & 255; }
    else { const int r2 = tm - NCTX; const int b = r2 / 1280; base = (size_t)NCTX * 2048 + (size_t)b * 1280 * 2048; nkeys = 1280; key0 = r2 - b * 1280; }
    u16* dst = VT + base + (size_t)(hd * 128 + d) * nkeys + key0;
#pragma unroll
    for (int g = 0; g < 4; ++g) st_bf4(dst + 8 * g + 4 * h, acc[4 * g], acc[4 * g + 1], acc[4 * g + 2], acc[4 * g + 3]);
  };
  const int wv_ = __builtin_amdgcn_readfirstlane(tid_() >> 6);
  for_tiles(56, 32, [&](int mt, int nt) {
    if ((nt & 1) == 0) gemm_tile<true>(wv_, CKVALL, 512, Wt, 512, 512, mt * 256, nt * 128, epiK, smem);
    else gemm_tile<false>(wv_, CKVALL, 512, Wt, 512, 512, mt * 256, nt * 128, epiV, smem);
  });
}

DI void mla_attn(const Params& p, char* smem) {
  char* ws = p.ws;
  const u16* QB = (const u16*)(ws + A_QB); const u16* KB = (const u16*)(ws + A_KB); const u16* VT = (const u16*)(ws + A_VT); const u16* SG = (const u16*)(ws + A_SGATE);
  u16* OG = (u16*)(ws + WS_H);
  char* Ks = smem;
  char* Vs = smem + 25600;
  const int tid = tid_();
  const int lane = tid & 63, w = tid >> 6, r = lane & 31, h = lane >> 5;
  const float SC = 0.07216878364870322f * 1.4426950408889634f;
  for (int it = blockIdx.x; it < 1536; it += gridDim.x) {
    int head, T0, R0, nkeys; size_t vbase;
    if (it < 1024) { const int b = it >> 7; head = (it >> 3) & 15; T0 = NCTX + b * 1024 + (it & 7) * 128; R0 = NCTX + b * 1280; nkeys = 1280; vbase = (size_t)NCTX * 2048 + (size_t)b * 1280 * 2048; }
    else { const int i2 = it - 1024; const int b = i2 >> 5; head = (i2 >> 1) & 15; T0 = b * 256 + (i2 & 1) * 128; R0 = b * 256; nkeys = 256; vbase = (size_t)b * 256 * 2048; }
    T0 += w * 32;
    bf16x8 qf[12];
    const u16* qp = QB + (size_t)(T0 + r) * 3072 + head * 192 + 8 * h;
#pragma unroll
    for (int ks = 0; ks < 12; ++ks) qf[ks] = *(const bf16x8*)(qp + ks * 16);
    f32x16 O[4];
#pragma unroll
    for (int dt = 0; dt < 4; ++dt)
#pragma unroll
      for (int e = 0; e < 16; ++e) O[dt][e] = 0.f;
    float mrun = -INFINITY, lrun = 0.f;
    const u16* kg = KB + ((size_t)R0 * 16 + head) * 192;
    const u16* vg = VT + vbase + (size_t)(head * 128) * nkeys;
    u32x4 rk[6], rv[4];
    const __amdgpu_buffer_rsrc_t Krs = __builtin_amdgcn_make_buffer_rsrc((void*)kg, 0, 0x7fffffff, 0x00020000);
    const __amdgpu_buffer_rsrc_t Vrs = __builtin_amdgcn_make_buffer_rsrc((void*)vg, 0, 0x7fffffff, 0x00020000);
    const int kvo = (tid >> 2) * 6144 + (tid & 3) * 16;
    const int vvo = (tid >> 3) * nkeys * 2 + (tid & 7) * 16;
#define AT_LOAD(KT0) { _Pragma("unroll") for (int i = 0; i < 6; ++i) rk[i] = __builtin_bit_cast(u32x4, __builtin_amdgcn_raw_buffer_load_b128(Krs, kvo + 64 * i, (KT0) * 6144, 0)); \
                       _Pragma("unroll") for (int i = 0; i < 4; ++i) rv[i] = __builtin_bit_cast(u32x4, __builtin_amdgcn_raw_buffer_load_b128(Vrs, vvo, (32 * i * nkeys + (KT0)) * 2, 0)); }
#define AT_STORE() { _Pragma("unroll") for (int i = 0; i < 6; ++i) *(u32x4*)(Ks + (tid >> 2) * 400 + ((tid & 3) + 4 * i) * 16) = rk[i]; \
                     _Pragma("unroll") for (int i = 0; i < 4; ++i) { const int sg = tid & 7; char* d = Vs + ((tid >> 3) + 32 * i) * 144 + (sg >> 1) * 32 + (sg & 1) * 8; \
                       u32x2 lo, hi; lo.x = rv[i].x; lo.y = rv[i].y; hi.x = rv[i].z; hi.y = rv[i].w; *(u32x2*)d = lo; *(u32x2*)(d + 16) = hi; } }
    AT_LOAD(0);
    __syncthreads();
    AT_STORE();
    __syncthreads();
    for (int kt0 = 0; kt0 < nkeys; kt0 += 64) {
      { const int kn = kt0 + 64 < nkeys ? kt0 + 64 : kt0; AT_LOAD(kn); }
#pragma unroll
      for (int sub = 0; sub < 2; ++sub) {
        f32x16 S;
#pragma unroll
        for (int e = 0; e < 16; ++e) S[e] = 0.f;
#pragma unroll
        for (int ks = 0; ks < 12; ++ks) { const bf16x8 kf = *(const bf16x8*)(Ks + (sub * 32 + r) * 400 + ks * 32 + h * 16); S = MFMA32(kf, qf[ks], S); }
        float mx = -INFINITY;
#pragma unroll
        for (int e = 0; e < 16; ++e) { S[e] *= SC; mx = fmaxf(mx, S[e]); }
        mx = fmaxf(mx, __shfl_xor(mx, 32));
        const float mnew = fmaxf(mrun, mx);
        const float alpha = __builtin_amdgcn_exp2f(mrun - mnew);
        mrun = mnew;
        float ps = 0.f;
#pragma unroll
        for (int e = 0; e < 16; ++e) { S[e] = __builtin_amdgcn_exp2f(S[e] - mnew); ps += S[e]; }
        lrun = lrun * alpha + ps;
#pragma unroll
        for (int dt = 0; dt < 4; ++dt)
#pragma unroll
          for (int e = 0; e < 16; ++e) O[dt][e] *= alpha;
#pragma unroll
        for (int s = 0; s < 2; ++s) {
          const bf16x8 pf = pack8(S, s);
#pragma unroll
          for (int dt = 0; dt < 4; ++dt) {
            const bf16x8 vf = *(const bf16x8*)(Vs + (dt * 32 + r) * 144 + (sub * 2 + s) * 32 + h * 16);
            O[dt] = MFMA32(vf, pf, O[dt]);
          }
        }
      }
      __syncthreads();
      AT_STORE();
      __syncthreads();
    }
#undef AT_LOAD
#undef AT_STORE
    lrun += __shfl_xor(lrun, 32);
    const float inv = 1.f / lrun;
#pragma unroll
    for (int dt = 0; dt < 4; ++dt)
#pragma unroll
      for (int g = 0; g < 4; ++g) {
        const size_t o = (size_t)(T0 + r) * 2048 + head * 128 + dt * 32 + 8 * g + 4 * h;
        const u32x2 sg = *(const u32x2*)(SG + o);
        st_bf4(OG + o, O[dt][4 * g] * inv * bflo(sg.x), O[dt][4 * g + 1] * inv * bfhi(sg.x), O[dt][4 * g + 2] * inv * bflo(sg.y), O[dt][4 * g + 3] * inv * bfhi(sg.y));
      }
  }
}

DI void gemm_out(const Params& p, const u16* A, const u16* Wt, char* smem) {
  float* OP = (float*)(p.ws + WS_OP);
  auto epi = [&](int tm, int tn, const f32x16& acc, int r, int h) {
    const size_t m = tm + r;
#pragma unroll
    for (int g = 0; g < 4; ++g) { f32x4 o = {acc[4 * g], acc[4 * g + 1], acc[4 * g + 2], acc[4 * g + 3]}; *(f32x4*)(OP + m * 2048 + tn + 8 * g + 4 * h) = o; }
  };
  const int wv_ = __builtin_amdgcn_readfirstlane(tid_() >> 6);
  for_tiles(48, 16, [&](int mt, int nt) { gemm_tile<true>(wv_, A, 2048, Wt, 2048, 2048, mt * 256, nt * 128, epi, smem); });
}

DI void s5_g1(const Params& p, char* smem) {
  char* ws = p.ws;
  const u16* H = (const u16*)(ws + WS_H); const u16* Wt = (const u16*)(ws + WS_WT_S5_IN);
  float* U = (float*)(ws + B_U); u16* SG = (u16*)(ws + B_SGATE);
  auto epi = [&](int tm, int tn, const f32x16& acc, int r, int h) {
    const size_t m = tm + r;
    if (tn < 2048) {
#pragma unroll
      for (int g = 0; g < 4; ++g) { f32x4 o = {acc[4 * g], acc[4 * g + 1], acc[4 * g + 2], acc[4 * g + 3]}; *(f32x4*)(U + m * 2048 + tn + 8 * g + 4 * h) = o; }
    } else {
#pragma unroll
      for (int g = 0; g < 4; ++g) st_bf4(SG + m * 2048 + (tn - 2048) + 8 * g + 4 * h, siluf(acc[4 * g]), siluf(acc[4 * g + 1]), siluf(acc[4 * g + 2]), siluf(acc[4 * g + 3]));
    }
  };
  const int wv_ = __builtin_amdgcn_readfirstlane(tid_() >> 6);
  for_tiles(48, 32, [&](int mt, int nt) { gemm_tile<true>(wv_, H, 2048, Wt, 2048, 2048, mt * 256, nt * 128, epi, smem); });
}

DI void s5_scan(const Params& p, char* smem) {
  char* ws = p.ws;
  const float* U = (const float*)(ws + B_U);
  float* YF = (float*)(ws + WS_OP); float* YB = (float*)(ws + B_YB);
  const int tid = tid_();
  const int lane = tid & 63;
  const int w = __builtin_amdgcn_readfirstlane(tid >> 6);
  char* Hs = smem + w * 4352;
  const int pcol = lane & 15, quad = lane >> 4;
  for (int it = blockIdx.x * 4 + w; it < 6144; it += gridDim.x * 4) {
    const int dir = it & 1; int rest = it >> 1;
    const bool lat = rest < 1024;
    int b, g, L, T0;
    if (lat) { b = rest >> 7; g = rest & 127; L = 1024; T0 = NCTX + b * 1024; }
    else { rest -= 1024; b = rest >> 7; g = rest & 127; L = 256; T0 = b * 256; }
    const int n = lane;
    const int pidx = (dir * 128 + g) * 64 + n;
    const float are = p.s5_a_re[pidx], aim = p.s5_a_im[pidx];
    const float dt = __expf(p.s5_log_dt[dir * 128 + g]);
    const float mag = __expf(are * dt), rev = (aim * dt) * 0.15915494309189533577f;
    const float abr = mag * __builtin_amdgcn_cosf(rev), abi = mag * __builtin_amdgcn_sinf(rev);
    const float nr = abr - 1.f, ni = abi, den = 1.f / (are * are + aim * aim);
    const float cr = (nr * are + ni * aim) * den, ci = (ni * are - nr * aim) * den;
    float bre[16], bim[16];
    {
      const float* br = p.s5_b_re + (size_t)pidx * 16; const float* bi = p.s5_b_im + (size_t)pidx * 16;
#pragma unroll
      for (int q = 0; q < 4; ++q) {
        const f32x4 x = *(const f32x4*)(br + 4 * q), y = *(const f32x4*)(bi + 4 * q);
#pragma unroll
        for (int e = 0; e < 4; ++e) { bre[4 * q + e] = cr * x[e] - ci * y[e]; bim[4 * q + e] = cr * y[e] + ci * x[e]; }
      }
    }
    bf16x8 cf[4];
    {
      const float* c1 = p.s5_c_re + ((size_t)(dir * 128 + g) * 16 + pcol) * 64; const float* c2 = p.s5_c_im + ((size_t)(dir * 128 + g) * 16 + pcol) * 64;
#pragma unroll
      for (int s = 0; s < 4; ++s) {
        const f32x4 x = *(const f32x4*)(c1 + 16 * s + 4 * quad), y = *(const f32x4*)(c2 + 16 * s + 4 * quad);
        u32x4 pk; pk.x = pk2(x[0], -y[0]); pk.y = pk2(x[1], -y[1]); pk.z = pk2(x[2], -y[2]); pk.w = pk2(x[3], -y[3]);
        cf[s] = __builtin_bit_cast(bf16x8, pk);
      }
    }
    float hr = 0.f, hi = 0.f;
    if (lat) { const float* s0 = p.state_s5 + ((size_t)((b * 2 + dir) * 128 + g) * 64 + n) * 2; hr = s0[0]; hi = s0[1]; }
    float* Y = dir ? YB : YF;
    const float* ub = U + (size_t)T0 * 2048 + g * 16;
    const int t0 = dir ? L - 1 : 0, tstep = dir ? -1 : 1;
    f32x4 un[4];
#pragma unroll
    for (int q = 0; q < 4; ++q) un[q] = *(const f32x4*)(ub + (size_t)t0 * 2048 + 4 * q);
    int t = t0;
    for (int s0_ = 0; s0_ < L; s0_ += 16) {
      const int tchunk = t;
#pragma unroll 4
      for (int row = 0; row < 16; ++row) {
        f32x4 u[4];
#pragma unroll
        for (int q = 0; q < 4; ++q) u[q] = un[q];
        const int tn = (s0_ + row + 1 < L) ? t + tstep : t;
#pragma unroll
        for (int q = 0; q < 4; ++q) un[q] = *(const f32x4*)(ub + (size_t)tn * 2048 + 4 * q);
        float br_ = 0.f, bi_ = 0.f;
#pragma unroll
        for (int q = 0; q < 16; ++q) { br_ += bre[q] * u[q >> 2][q & 3]; bi_ += bim[q] * u[q >> 2][q & 3]; }
        const float nhr = abr * hr - abi * hi + br_, nhi = abr * hi + abi * hr + bi_;
        hr = nhr; hi = nhi;
        if (!lat && s0_ == 0 && row == 0) { float* so = p.out + OUT_S5 + ((size_t)((b * 2 + dir) * 128 + g) * 64 + n) * 2; so[0] = hr; so[1] = hi; }
        *(unsigned*)(Hs + row * 272 + n * 4) = pk2(hr, hi);
        t = tn;
      }
      f32x4 yacc = {0.f, 0.f, 0.f, 0.f};
#pragma unroll
      for (int s = 0; s < 4; ++s) {
        const bf16x8 af = *(const bf16x8*)(Hs + pcol * 272 + s * 64 + quad * 16);
        yacc = __builtin_amdgcn_mfma_f32_16x16x32_bf16(af, cf[s], yacc, 0, 0, 0);
      }
#pragma unroll
      for (int i = 0; i < 4; ++i) { const int tok = tchunk + tstep * (4 * quad + i); Y[(size_t)(T0 + tok) * 2048 + g * 16 + pcol] = yacc[i]; }
    }
  }
}

DI float gelu_tanh(float x) {
  const float t = 0.7978845608028654f * (x + 0.044715f * x * x * x);
  const float e = __expf(2.f * t);
  const float th = 1.f - 2.f / (e + 1.f);
  return 0.5f * x * (1.f + th);
}

DI void s5_combine(const Params& p) {
  char* ws = p.ws;
  const float* U = (const float*)(ws + B_U); const float* YF = (const float*)(ws + WS_OP); const float* YB = (const float*)(ws + B_YB);
  u16* YG = (u16*)(ws + WS_H);
  const size_t n4 = (size_t)NTOK * 2048 / 4;
  for (size_t i = (size_t)blockIdx.x * 256 + tid_(); i < n4; i += (size_t)gridDim.x * 256) {
    const int col = (int)((i * 4) & 2047);
    const f32x4 u = *(const f32x4*)(U + i * 4), a = *(const f32x4*)(YF + i * 4), b = *(const f32x4*)(YB + i * 4), d = *(const f32x4*)(p.s5_d + col);
    const f32x4 y = d * u + a + b;
    st_bf4(YG + i * 4, gelu_tanh(y[0]), gelu_tanh(y[1]), gelu_tanh(y[2]), gelu_tanh(y[3]));
  }
}

DI void s5_g2(const Params& p, char* smem) {
  char* ws = p.ws;
  const u16* YG = (const u16*)(ws + WS_H); const u16* Wt = (const u16*)(ws + WS_WT_S5_GLU); const u16* SG = (const u16*)(ws + B_SGATE);
  u16* Z = (u16*)(ws + B_Z);
  auto epi = [&](int tm, int tn, const f32x16& acc, int r, int h) {
    const size_t m = tm + r;
#pragma unroll
    for (int g = 0; g < 4; ++g) {
      const int n = tn + 8 * g + 4 * h;
      const f32x4 bg = *(const f32x4*)(p.s5_b_glu + n);
      const u32x2 yv = *(const u32x2*)(YG + m * 2048 + n), sg = *(const u32x2*)(SG + m * 2048 + n);
      st_bf4(Z + m * 2048 + n, bflo(yv.x) * sigmf(acc[4 * g] + bg[0]) * bflo(sg.x), bfhi(yv.x) * sigmf(acc[4 * g + 1] + bg[1]) * bfhi(sg.x),
             bflo(yv.y) * sigmf(acc[4 * g + 2] + bg[2]) * bflo(sg.y), bfhi(yv.y) * sigmf(acc[4 * g + 3] + bg[3]) * bfhi(sg.y));
    }
  };
  const int wv_ = __builtin_amdgcn_readfirstlane(tid_() >> 6);
  for_tiles(48, 16, [&](int mt, int nt) { gemm_tile<true>(wv_, YG, 2048, Wt, 2048, 2048, mt * 256, nt * 128, epi, smem); });
}

DI void gla_g1(const Params& p, char* smem) {
  char* ws = p.ws;
  const u16* H = (const u16*)(ws + WS_H); const u16* Wt = (const u16*)(ws + WS_WT_GLA_IN);
  u16* VT = (u16*)(ws + C_VT);
  auto epi = [&](int tm, int tn, const f32x16& acc, int r, int h) {
    char* ws2 = p.ws;
    u16* QG = (u16*)(ws2 + C_QG); u16* KG = (u16*)(ws2 + C_KG); u16* SG = (u16*)(ws2 + C_SGATE); float* GLR = (float*)(ws2 + C_GLR);
    const size_t m = tm + r;
    if (tn < 1024) {
#pragma unroll
      for (int g = 0; g < 4; ++g) st_bf4(QG + m * 1024 + tn + 8 * g + 4 * h, acc[4 * g] * 0.0625f, acc[4 * g + 1] * 0.0625f, acc[4 * g + 2] * 0.0625f, acc[4 * g + 3] * 0.0625f);
    } else if (tn < 2048) {
#pragma unroll
      for (int g = 0; g < 4; ++g) st_bf4(KG + m * 1024 + (tn - 1024) + 8 * g + 4 * h, acc[4 * g], acc[4 * g + 1], acc[4 * g + 2], acc[4 * g + 3]);
    } else if (tn >= 4096 && tn < 6144) {
#pragma unroll
      for (int g = 0; g < 4; ++g) st_bf4(SG + m * 2048 + (tn - 4096) + 8 * g + 4 * h, siluf(acc[4 * g]), siluf(acc[4 * g + 1]), siluf(acc[4 * g + 2]), siluf(acc[4 * g + 3]));
    } else if (tn == 6144) {
#pragma unroll
      for (int g = 0; g < 4; ++g) { f32x4 o = {acc[4 * g], acc[4 * g + 1], acc[4 * g + 2], acc[4 * g + 3]}; *(f32x4*)(GLR + m * 32 + 8 * g + 4 * h) = o; }
    }
  };
  auto epiV = [&](int tm, int tn, const f32x16& acc, int r, int h) {
    const int dv = tn - 2048 + r;
    u16* dst = VT + ((size_t)(tm >> 6) * 2048 + dv) * 64 + (tm & 63);
#pragma unroll
    for (int g = 0; g < 4; ++g) st_bf4(dst + 8 * g + 4 * h, acc[4 * g], acc[4 * g + 1], acc[4 * g + 2], acc[4 * g + 3]);
  };
  const int wv_ = __builtin_amdgcn_readfirstlane(tid_() >> 6);
  for_tiles(48, 49, [&](int mt, int nt) {
    if (nt >= 16 && nt < 32) gemm_tile<false>(wv_, H, 2048, Wt, 2048, 2048, mt * 256, nt * 128, epiV, smem);
    else gemm_tile<true>(wv_, H, 2048, Wt, 2048, 2048, mt * 256, nt * 128, epi, smem);
  });
}

DI float logsigf(float z) { return fminf(z, 0.f) - __logf(1.f + __expf(-fabsf(z))); }

DI void gla_gate(const Params& p, float* smem) {
  char* ws = p.ws;
  const u16* QG = (const u16*)(ws + C_QG); const u16* KG = (const u16*)(ws + C_KG); const float* GLR = (const float*)(ws + C_GLR);
  u16* QT = (u16*)(ws + C_QT); u16* KT = (u16*)(ws + C_KT); u16* KDT = (u16*)(ws + C_KDT); float* DN = (float*)(ws + C_DN);
  const int tid = tid_();
  for (int it = blockIdx.x; it < 1536; it += gridDim.x) {
    const int dir = it & 1, hd = (it >> 1) & 3, c = it >> 3;
    const int ch = hd * 256 + tid;
    __syncthreads();
    for (int i = tid; i < 1024; i += 256) smem[i] = GLR[(size_t)(c * 64 + (i >> 4)) * 32 + dir * 16 + (i & 15)];
    __syncthreads();
    float wg[16];
#pragma unroll
    for (int q = 0; q < 16; ++q) wg[q] = p.gla_w_g2[(size_t)(dir * 16 + q) * 1024 + ch];
    const float bg = p.gla_b_g[dir * 1024 + ch];
    float tot = 0.f;
    for (int i = 0; i < 64; ++i) {
      float z = bg;
#pragma unroll
      for (int q = 0; q < 16; ++q) z += smem[i * 16 + q] * wg[q];
      tot += logsigf(z) * 0.0625f;
    }
    DN[(size_t)(dir * 192 + c) * 1024 + ch] = __expf(tot);
    float run = 0.f;
    u16* kdrow = KDT + ((size_t)((dir * 192 + c) * 4 + hd) * 256 + tid) * 64;
    for (int i8 = 0; i8 < 8; ++i8) {
      float kdv[8];
#pragma unroll
      for (int e = 0; e < 8; ++e) {
        const int ii = i8 * 8 + e;
        const int i = dir ? 63 - ii : ii;
        float z = bg;
#pragma unroll
        for (int q = 0; q < 16; ++q) z += smem[i * 16 + q] * wg[q];
        run += logsigf(z) * 0.0625f;
        const size_t T = (size_t)c * 64 + i;
        const float q_ = bf2f(QG[T * 1024 + ch]), k_ = bf2f(KG[T * 1024 + ch]);
        QT[((size_t)dir * NTOK + T) * 1024 + ch] = f2bf(q_ * __expf(run));
        KT[((size_t)dir * NTOK + T) * 1024 + ch] = f2bf(k_ * __expf(-run));
        kdv[e] = k_ * __expf(tot - run);
      }
      u32x4 pk;
      if (dir) { pk.x = pk2(kdv[7], kdv[6]); pk.y = pk2(kdv[5], kdv[4]); pk.z = pk2(kdv[3], kdv[2]); pk.w = pk2(kdv[1], kdv[0]); }
      else { pk.x = pk2(kdv[0], kdv[1]); pk.y = pk2(kdv[2], kdv[3]); pk.z = pk2(kdv[4], kdv[5]); pk.w = pk2(kdv[6], kdv[7]); }
      const int tb = dir ? 56 - i8 * 8 : i8 * 8;
      *(u32x4*)(kdrow + tb) = pk;
    }
  }
  __syncthreads();
}

DI void gla_main(const Params& p, char* smem) {
  char* ws = p.ws;
  const u16* QT = (const u16*)(ws + C_QT); const u16* KT = (const u16*)(ws + C_KT); const u16* KDT = (const u16*)(ws + C_KDT); const u16* VT = (const u16*)(ws + C_VT);
  const float* DN = (const float*)(ws + C_DN);
  float* OF = (float*)(ws + WS_OP); float* OB = (float*)(ws + C_OB);
  u16* att = (u16*)smem;
  const int lane = tid_() & 63, w = tid_() >> 6, r = lane & 31, h = lane >> 5;
  for (int it = blockIdx.x; it < 768; it += gridDim.x) {
    const bool lat = it < 256;
    const int i2 = lat ? it : it - 256;
    const int bs = i2 >> 5, hd = (i2 >> 3) & 3, dir = (i2 >> 2) & 1, sl = i2 & 3;
    const int nc = lat ? 16 : 4, T0 = lat ? NCTX + bs * 1024 : bs * 256;
    const int vcol0 = hd * 512 + sl * 128 + w * 32;
    f32x16 S[8];
    if (lat) {
      const float* s0 = p.state_gla + ((size_t)((bs * 2 + dir) * 4 + hd) * 256) * 512 + (sl * 128 + w * 32 + r);
#pragma unroll
      for (int mt = 0; mt < 8; ++mt)
#pragma unroll
        for (int e = 0; e < 16; ++e) S[mt][e] = s0[(size_t)(32 * mt + crow(e, h)) * 512];
    } else {
#pragma unroll
      for (int mt = 0; mt < 8; ++mt)
#pragma unroll
        for (int e = 0; e < 16; ++e) S[mt][e] = 0.f;
    }
    float* OD = dir ? OB : OF;
    for (int cc = 0; cc < nc; ++cc) {
      const int c = dir ? nc - 1 - cc : cc;
      const int Tc = T0 + c * 64, cgx = Tc >> 6;
      const u16* qt = QT + ((size_t)dir * NTOK + Tc) * 1024 + hd * 256;
      const u16* kt = KT + ((size_t)dir * NTOK + Tc) * 1024 + hd * 256;
      const u16* kdT = KDT + ((size_t)((dir * 192 + cgx) * 4 + hd) * 256) * 64;
      const u16* vT = VT + ((size_t)cgx * 2048 + vcol0 + r) * 64;
      const float* dn = DN + (size_t)(dir * 192 + cgx) * 1024 + hd * 256;
      {
        f32x16 a;
#pragma unroll
        for (int e = 0; e < 16; ++e) a[e] = 0.f;
        const int ci = w >> 1, si = w & 1;
        const u16* qa = qt + (size_t)(32 * ci + r) * 1024 + 8 * h; const u16* kb = kt + (size_t)(32 * si + r) * 1024 + 8 * h;
#pragma unroll
        for (int ks = 0; ks < 16; ++ks) a = MFMA32(*(const bf16x8*)(qa + ks * 16), *(const bf16x8*)(kb + ks * 16), a);
#pragma unroll
        for (int e = 0; e < 16; ++e) {
          const int cr_ = 32 * ci + crow(e, h), sc_ = 32 * si + r;
          const bool keep = dir ? (sc_ >= cr_) : (sc_ <= cr_);
          att[cr_ * 72 + sc_] = keep ? f2bf(a[e]) : (u16)0;
        }
      }
      __syncthreads();
      f32x16 o[2];
#pragma unroll
      for (int q = 0; q < 2; ++q)
#pragma unroll
        for (int e = 0; e < 16; ++e) o[q][e] = 0.f;
#pragma unroll
      for (int mt = 0; mt < 8; ++mt)
#pragma unroll
        for (int s = 0; s < 2; ++s) {
          const bf16x8 sf = pack8(S[mt], s);
#pragma unroll
          for (int q = 0; q < 2; ++q) {
            const u16* qa = qt + (size_t)(32 * q + r) * 1024 + 32 * mt + 16 * s + 4 * h;
            const s16x4 lo = *(const s16x4*)qa, hi = *(const s16x4*)(qa + 8);
            o[q] = MFMA32(cat4(lo, hi), sf, o[q]);
          }
        }
      bf16x8 vf[4];
#pragma unroll
      for (int ks = 0; ks < 4; ++ks) vf[ks] = *(const bf16x8*)(vT + ks * 16 + 8 * h);
#pragma unroll
      for (int q = 0; q < 2; ++q)
#pragma unroll
        for (int ks = 0; ks < 4; ++ks) { const bf16x8 af = *(const bf16x8*)(att + (32 * q + r) * 72 + ks * 16 + 8 * h); o[q] = MFMA32(af, vf[ks], o[q]); }
#pragma unroll
      for (int q = 0; q < 2; ++q)
#pragma unroll
        for (int e = 0; e < 16; ++e) OD[(size_t)(Tc + 32 * q + crow(e, h)) * 2048 + vcol0 + r] = o[q][e];
#pragma unroll
      for (int mt = 0; mt < 8; ++mt) {
#pragma unroll
        for (int g = 0; g < 4; ++g) {
          const f32x4 d4 = *(const f32x4*)(dn + 32 * mt + 8 * g + 4 * h);
#pragma unroll
          for (int e = 0; e < 4; ++e) S[mt][4 * g + e] *= d4[e];
        }
#pragma unroll
        for (int ks = 0; ks < 4; ++ks) { const bf16x8 af = *(const bf16x8*)(kdT + (size_t)(32 * mt + r) * 64 + ks * 16 + 8 * h); S[mt] = MFMA32(af, vf[ks], S[mt]); }
      }
      __syncthreads();
    }
    if (!lat) {
      float* so = p.out + OUT_GLA + ((size_t)((bs * 2 + dir) * 4 + hd) * 256) * 512 + (sl * 128 + w * 32 + r);
#pragma unroll
      for (int mt = 0; mt < 8; ++mt)
#pragma unroll
        for (int e = 0; e < 16; ++e) so[(size_t)(32 * mt + crow(e, h)) * 512] = S[mt][e];
    }
  }
}

DI void gla_norm(const Params& p) {
  char* ws = p.ws;
  const float* OF = (const float*)(ws + WS_OP); const float* OB = (const float*)(ws + C_OB); const u16* SG = (const u16*)(ws + C_SGATE);
  u16* OG = (u16*)(ws + WS_H);
  const int lane = tid_() & 63, wv = tid_() >> 6;
  for (int T = blockIdx.x * 4 + wv; T < NTOK; T += gridDim.x * 4) {
    f32x4 x[8];
    float ss[4] = {0.f, 0.f, 0.f, 0.f};
#pragma unroll
    for (int j = 0; j < 8; ++j) {
      const size_t o = (size_t)T * 2048 + (j * 64 + lane) * 4;
      x[j] = *(const f32x4*)(OF + o) + *(const f32x4*)(OB + o);
      ss[j >> 1] += x[j][0] * x[j][0] + x[j][1] * x[j][1] + x[j][2] * x[j][2] + x[j][3] * x[j][3];
    }
#pragma unroll
    for (int q = 0; q < 4; ++q) ss[q] = rsqrtf(wave_sum(ss[q]) * (1.f / 512.f) + EPS);
#pragma unroll
    for (int j = 0; j < 8; ++j) {
      const int col = (j * 64 + lane) * 4;
      const size_t o = (size_t)T * 2048 + col;
      const f32x4 ng = *(const f32x4*)(p.gla_norm + (col & 511));
      const u32x2 sg = *(const u32x2*)(SG + o);
      const f32x4 y = x[j] * ss[j >> 1] * ng;
      st_bf4(OG + o, y[0] * bflo(sg.x), y[1] * bfhi(sg.x), y[2] * bflo(sg.y), y[3] * bfhi(sg.y));
    }
  }
}

#define XB_TMO      128
#define XB_XCNT(j)  (256  + 64 * (j))
#define XB_XSUB(j)  (1280 + 64 * (j))
#define XB_XGEN(j)  (2304 + 64 * (j))
#define XB_TOP      3328
#define XB_TOPGEN   3392
#define XCD_BAR_WORDS 3456
#define XB_SPIN_CAP (1u << 18)
#define LAS __attribute__((address_space(3)))
DI unsigned xb_ld(unsigned* p) { return __hip_atomic_load(p, __ATOMIC_RELAXED, __HIP_MEMORY_SCOPE_AGENT); }
DI unsigned xb_add(unsigned* p, unsigned v) { return __hip_atomic_fetch_add(p, v, __ATOMIC_RELAXED, __HIP_MEMORY_SCOPE_AGENT); }
DI unsigned xb_xcc_id() { return (unsigned)__builtin_amdgcn_s_getreg((3 << 11) | 20) & 0xFu; }
#define XB_SPIN(cond, bar) do { unsigned _sp = 0; while (cond) { __builtin_amdgcn_s_sleep(1); \
    if ((++_sp & 255u) == 0u) { if (xb_ld(&(bar)[XB_TMO])) break; if (_sp > XB_SPIN_CAP) { atomicAdd(&(bar)[XB_TMO], 1u); break; } } } } while (0)
struct XcdBarrier { unsigned* bar; unsigned x; volatile LAS unsigned* st; };
DI XcdBarrier xcd_barrier_post(unsigned* bar, volatile LAS unsigned* st) {
  XcdBarrier b; b.bar = bar; b.x = xb_xcc_id(); b.st = st;
  if (threadIdx.x == 0) (void)xb_add(&bar[XB_XCNT(b.x)], 1u);
  return b;
}
DI void xcd_barrier_complete(unsigned* bar, unsigned x, unsigned& nloc, unsigned& nx) {
  const unsigned G = gridDim.x * gridDim.y * gridDim.z;
  unsigned sum, cnt, mine, sp = 0u;
  for (;;) {
    sum = 0u; cnt = 0u; mine = 0u;
#pragma unroll
    for (unsigned j = 0; j < 16; ++j) { const unsigned c = xb_ld(&bar[XB_XCNT(j)]); sum += c; cnt += (c > 0u) ? 1u : 0u; mine = (j == x) ? c : mine; }
    if (sum == G) break;
    __builtin_amdgcn_s_sleep(1);
    if ((++sp & 255u) == 0u) { if (xb_ld(&bar[XB_TMO])) break; if (sp > XB_SPIN_CAP) { atomicAdd(&bar[XB_TMO], 1u); break; } }
  }
  nloc = mine > 0u ? mine : 1u; nx = cnt > 0u ? cnt : 1u;
}
DI void xcd_barrier(const XcdBarrier& b) {
  asm volatile("s_waitcnt vmcnt(0)" ::: "memory");
  __syncthreads();
  if (threadIdx.x == 0) {
    unsigned* bar = b.bar;
    __builtin_amdgcn_s_waitcnt(0);
    unsigned nloc = b.st[0], nx = b.st[1];
    if (nloc == 0u) { xcd_barrier_complete(bar, b.x, nloc, nx); b.st[0] = nloc; b.st[1] = nx; }
    const unsigned old = xb_add(&bar[XB_XSUB(b.x)], 1u);
    const unsigned gen = old / nloc;
    if (old + 1u == (gen + 1u) * nloc) {
      __builtin_amdgcn_fence(__ATOMIC_RELEASE, "agent");
      asm volatile("s_waitcnt vmcnt(0)" ::: "memory");
      const unsigned og = xb_add(&bar[XB_TOP], 1u);
      const unsigned tg = og / nx;
      if (og + 1u == (tg + 1u) * nx) xb_add(&bar[XB_TOPGEN], 1u);
      else XB_SPIN(xb_ld(&bar[XB_TOPGEN]) == tg, bar);
      __builtin_amdgcn_fence(__ATOMIC_ACQUIRE, "agent");
      xb_add(&bar[XB_XGEN(b.x)], 1u);
      asm volatile("s_waitcnt vmcnt(0)" ::: "memory");
    } else {
      XB_SPIN(xb_ld(&bar[XB_XGEN(b.x)]) == gen, bar);
      __builtin_amdgcn_fence(__ATOMIC_ACQUIRE, "agent");
      asm volatile("s_waitcnt vmcnt(0)" ::: "memory");
    }
  }
  __syncthreads();
}

constexpr int NPHASE = 26;
#ifndef DUPMASK
#define DUPMASK 0u
#endif
template <int PH>
DI void run_phase(const Params& p, char* smem) {
  char* ws = p.ws;
  if constexpr (PH == 0) phase0(p, smem);
  else if constexpr (PH == 1) norm_phase(p, 0, true);
  else if constexpr (PH == 2) mla_g1(p, 0, smem);
  else if constexpr (PH == 3) mla_a2(p, 0);
  else if constexpr (PH == 4) mla_g2(p, 0, smem);
  else if constexpr (PH == 5) mla_attn(p, smem);
  else if constexpr (PH == 6) gemm_out(p, (const u16*)(ws + WS_H), (const u16*)(ws + WS_WT_MLA_OUT), smem);
  else if constexpr (PH == 7) norm_phase(p, 1, false);
  else if constexpr (PH == 8) s5_g1(p, smem);
  else if constexpr (PH == 9) s5_scan(p, smem);
  else if constexpr (PH == 10) s5_combine(p);
  else if constexpr (PH == 11) s5_g2(p, smem);
  else if constexpr (PH == 12) gemm_out(p, (const u16*)(ws + B_Z), (const u16*)(ws + WS_WT_S5_OUT), smem);
  else if constexpr (PH == 13) norm_phase(p, 2, false);
  else if constexpr (PH == 14) gla_g1(p, smem);
  else if constexpr (PH == 15) gla_gate(p, (float*)smem);
  else if constexpr (PH == 16) gla_main(p, smem);
  else if constexpr (PH == 17) gla_norm(p);
  else if constexpr (PH == 18) gemm_out(p, (const u16*)(ws + WS_H), (const u16*)(ws + WS_WT_GLA_OUT), smem);
  else if constexpr (PH == 19) norm_phase(p, 3, false);
  else if constexpr (PH == 20) mla_g1(p, 1, smem);
  else if constexpr (PH == 21) mla_a2(p, 1);
  else if constexpr (PH == 22) mla_g2(p, 1, smem);
  else if constexpr (PH == 23) mla_attn(p, smem);
  else if constexpr (PH == 24) gemm_out(p, (const u16*)(ws + WS_H), (const u16*)(ws + WS_WT_MLA_OUT) + (size_t)2048 * 2048, smem);
  else if constexpr (PH == 25) norm_phase(p, 4, false);
}

template <int PH>
DI void run_from(const Params& p, char* smem, const XcdBarrier& xb) {
  run_phase<PH>(p, smem);
  if constexpr ((DUPMASK >> PH) & 1u) { __syncthreads(); run_phase<PH>(p, smem); }
  if constexpr (PH + 1 < NPHASE) { xcd_barrier(xb); run_from<PH + 1>(p, smem, xb); }
}

#if COOP
__global__ void __launch_bounds__(256, 2) mega(Params p) {
  __shared__ __attribute__((aligned(16))) char smem[73728];
  __shared__ uint4 xb_words;
  cg::grid_group grid = cg::this_grid();
  if (p.out == nullptr) grid.sync();
  if (threadIdx.x == 0) xb_words = make_uint4(0u, 0u, 0u, 0u);
  __syncthreads();
  const XcdBarrier xb = xcd_barrier_post((unsigned*)(p.ws + WS_BAR), (volatile LAS unsigned*)&xb_words);
  run_from<0>(p, smem, xb);
}
#else
template <int PH>
__global__ void __launch_bounds__(256, 2) phase_k(Params p) {
  __shared__ __attribute__((aligned(16))) char smem[73728];
  run_phase<PH>(p, smem);
}
template <int PH>
static void launch_from(const Params& p, int grid, hipStream_t stream) {
  hipLaunchKernelGGL(phase_k<PH>, dim3(grid), dim3(256), 0, stream, p);
  if constexpr (PH + 1 < NPHASE) launch_from<PH + 1>(p, grid, stream);
}
#endif

extern "C" void kernel_launch(void* const* d_in, const int* in_sizes, int n_in, void* d_out, int out_size, void* d_ws, size_t ws_size, hipStream_t stream) {
  static int grid_blocks = 0;
  if (!grid_blocks) {
    int dev = 0, cus = 0, per_cu = 0;
    (void)hipGetDevice(&dev);
    (void)hipDeviceGetAttribute(&cus, hipDeviceAttributeMultiprocessorCount, dev);
#if COOP
    (void)hipOccupancyMaxActiveBlocksPerMultiprocessor(&per_cu, mega, 256, 0);
#else
    per_cu = 2;
#endif
    if (per_cu < 1) per_cu = 1;
    if (per_cu > 2) per_cu = 2;
    grid_blocks = cus * per_cu;
  }
  Params p{};
  const float** pp = (const float**)&p;
  for (int i = 0; i < 33; ++i) pp[i] = (const float*)d_in[i];
  p.out = (float*)d_out;
  p.ws = (char*)d_ws;
#if COOP
  (void)hipMemsetAsync(d_ws, 0, XCD_BAR_WORDS * 4, stream);
  void* args[] = {&p};
  hipError_t e = hipLaunchCooperativeKernel((void*)mega, dim3(grid_blocks), dim3(256), args, 0, stream);
  if (e != hipSuccess) fprintf(stderr, "cooperative launch failed: %s (grid %d)\n", hipGetErrorString(e), grid_blocks);
#else
  launch_from<0>(p, grid_blocks, stream);
#endif
}
```

```cpp
#include <hip/hip_runtime.h>
#include <hip/hip_cooperative_groups.h>
#include <stdint.h>
#include <cstdio>
namespace cg = cooperative_groups;

#ifndef COOP
#define COOP 1
#endif

typedef unsigned short u16;
typedef short bf16x8 __attribute__((ext_vector_type(8)));
typedef short s16x4 __attribute__((ext_vector_type(4)));
typedef float f32x16 __attribute__((ext_vector_type(16)));
typedef float f32x4 __attribute__((ext_vector_type(4)));
typedef float f32x2 __attribute__((ext_vector_type(2)));
typedef unsigned u32x4 __attribute__((ext_vector_type(4)));
typedef unsigned u32x2 __attribute__((ext_vector_type(2)));
typedef __bf16 bfv2 __attribute__((ext_vector_type(2)));
#define DI __device__ __forceinline__
#define MFMA32(a, b, c) __builtin_amdgcn_mfma_f32_32x32x16_bf16((a), (b), (c), 0, 0, 0)

constexpr int D = 2048, NTOK = 12288, NCTX = 4096;
constexpr float EPS = 1e-6f;
constexpr size_t OUT_CKV = 25165824, OUT_KROPE = 29360128, OUT_S5 = 29884416, OUT_GLA = 30408704;
constexpr size_t WS_BAR = 0;
constexpr size_t WS_WT_MLA_IN = 16384;
constexpr size_t WS_WT_MLA_UKV = WS_WT_MLA_IN + 2ull * 5760 * 2048 * 2;
constexpr size_t WS_WT_MLA_OUT = WS_WT_MLA_UKV + 2ull * 4096 * 512 * 2;
constexpr size_t WS_WT_S5_IN = WS_WT_MLA_OUT + 2ull * 2048 * 2048 * 2;
constexpr size_t WS_WT_S5_GLU = WS_WT_S5_IN + 4096ull * 2048 * 2;
constexpr size_t WS_WT_S5_OUT = WS_WT_S5_GLU + 2048ull * 2048 * 2;
constexpr size_t WS_WT_GLA_IN = WS_WT_S5_OUT + 2048ull * 2048 * 2;
constexpr size_t WS_WT_GLA_OUT = WS_WT_GLA_IN + 6272ull * 2048 * 2;
constexpr size_t WS_MOD = WS_WT_GLA_OUT + 2048ull * 2048 * 2;
constexpr size_t WS_H = WS_MOD + 4ull * 9 * 6144 * 4;
constexpr size_t WS_OP = WS_H + 12288ull * 2048 * 2;
constexpr size_t WS_SCR = WS_OP + 12288ull * 2048 * 4;
constexpr size_t A_QB = WS_SCR;
constexpr size_t A_CKVRAW = A_QB + 12288ull * 3072 * 2;
constexpr size_t A_CKVALL = A_CKVRAW + 12288ull * 512 * 4;
constexpr size_t A_SGATE = A_CKVALL + 14336ull * 512 * 2;
constexpr size_t A_KB = A_SGATE + 12288ull * 2048 * 2;
constexpr size_t A_VT = A_KB + 14336ull * 16 * 192 * 2;
constexpr size_t B_U = WS_SCR;
constexpr size_t B_SGATE = B_U + 12288ull * 2048 * 4;
constexpr size_t B_YB = B_SGATE + 12288ull * 2048 * 2;
constexpr size_t B_Z = B_YB + 12288ull * 2048 * 4;
constexpr size_t C_QG = WS_SCR;
constexpr size_t C_KG = C_QG + 12288ull * 1024 * 2;
constexpr size_t C_VT = C_KG + 12288ull * 1024 * 2;
constexpr size_t C_SGATE = C_VT + 12288ull * 2048 * 2;
constexpr size_t C_GLR = C_SGATE + 12288ull * 2048 * 2;
constexpr size_t C_QT = C_GLR + 12288ull * 32 * 4;
constexpr size_t C_KT = C_QT + 2ull * 12288 * 1024 * 2;
constexpr size_t C_KDT = C_KT + 2ull * 12288 * 1024 * 2;
constexpr size_t C_DN = C_KDT + 2ull * 12288 * 1024 * 2;
constexpr size_t C_OB = C_DN + 2ull * 192 * 1024 * 4;

struct Params {
  const float *x_prompt, *x_sample, *cache_ckv, *cache_krope, *state_s5, *state_gla, *c, *c_ctx;
  const float *ada_w, *ada_b, *norm_pre, *norm_post;
  const float *mla_w_in, *mla_kv_norm, *mla_w_ukv, *mla_w_out;
  const float *s5_w_in, *s5_a_re, *s5_a_im, *s5_log_dt, *s5_b_re, *s5_b_im, *s5_c_re, *s5_c_im, *s5_d, *s5_w_glu, *s5_b_glu, *s5_w_out;
  const float *gla_w_in, *gla_w_g2, *gla_b_g, *gla_norm, *gla_w_out;
  float* out;
  char* ws;
};

DI unsigned pk2(float a, float b) { f32x2 v; v.x = a; v.y = b; bfv2 r = __builtin_convertvector(v, bfv2); return __builtin_bit_cast(unsigned, r); }
DI u16 f2bf(float a) { return (u16)(pk2(a, 0.f) & 0xffffu); }
DI float bf2f(u16 v) { return __uint_as_float(((unsigned)v) << 16); }
DI float bflo(unsigned v) { return __uint_as_float(v << 16); }
DI float bfhi(unsigned v) { return __uint_as_float(v & 0xffff0000u); }
DI float siluf(float x) { return x / (1.f + __expf(-x)); }
DI float sigmf(float x) { return 1.f / (1.f + __expf(-x)); }
DI f32x4 ld_bf4(const u16* p) { const u32x2 v = *(const u32x2*)p; f32x4 o = {bflo(v.x), bfhi(v.x), bflo(v.y), bfhi(v.y)}; return o; }
DI int crow(int reg, int h) { return (reg & 3) + 8 * (reg >> 2) + 4 * h; }
DI void st_bf4(u16* p, float a, float b, float c, float d) { u32x2 v; v.x = pk2(a, b); v.y = pk2(c, d); *(u32x2*)p = v; }
DI bf16x8 pack8(const f32x16& x, int s) {
  u32x4 p;
  p.x = pk2(x[8 * s + 0], x[8 * s + 1]); p.y = pk2(x[8 * s + 2], x[8 * s + 3]);
  p.z = pk2(x[8 * s + 4], x[8 * s + 5]); p.w = pk2(x[8 * s + 6], x[8 * s + 7]);
  return __builtin_bit_cast(bf16x8, p);
}
DI bf16x8 cat4(s16x4 lo, s16x4 hi) { return __builtin_shufflevector(lo, hi, 0, 1, 2, 3, 4, 5, 6, 7); }
DI float wave_sum(float v) {
#pragma unroll
  for (int o = 32; o >= 1; o >>= 1) v += __shfl_xor(v, o);
  return v;
}
DI int tid_() { int t = threadIdx.x; asm volatile("" : "+v"(t)); return t; }
DI int cond_of(int T) { return T < NCTX ? 8 : ((T - NCTX) >> 10); }
DI int kvrow_of(int T) { return T < NCTX ? T : NCTX + ((T - NCTX) >> 10) * 1280 + ((T - NCTX) & 1023); }

DI void ada_phase(const Params& p, float* smem) {
  const int tid = tid_();
  float* mod = (float*)(p.ws + WS_MOD);
  for (int it = blockIdx.x; it < 384; it += gridDim.x) {
    const int l = it / 96, n0 = (it % 96) * 64;
    __syncthreads();
    for (int i = tid; i < 9 * 2048; i += 256) { const int cd = i >> 11, k = i & 2047; const float v = cd < 8 ? p.c[cd * 2048 + k] : p.c_ctx[k]; smem[i] = siluf(v); }
    __syncthreads();
    const int c4 = tid & 15, ks = tid >> 4;
    const float* w = p.ada_w + (size_t)l * 2048 * 6144 + n0 + c4 * 4;
    float acc[9][4];
#pragma unroll
    for (int cd = 0; cd < 9; ++cd)
#pragma unroll
      for (int e = 0; e < 4; ++e) acc[cd][e] = 0.f;
#pragma unroll 4
    for (int kk = 0; kk < 128; ++kk) {
      const int k = ks * 128 + kk;
      const f32x4 wv = __builtin_nontemporal_load((const f32x4*)(w + (size_t)k * 6144));
#pragma unroll
      for (int cd = 0; cd < 9; ++cd) {
        const float s = smem[cd * 2048 + k];
#pragma unroll
        for (int e = 0; e < 4; ++e) acc[cd][e] += s * wv[e];
      }
    }
    __syncthreads();
#pragma unroll
    for (int cd = 0; cd < 9; ++cd)
#pragma unroll
      for (int e = 0; e < 4; ++e) smem[(ks * 9 + cd) * 64 + c4 * 4 + e] = acc[cd][e];
    __syncthreads();
    for (int o = tid; o < 576; o += 256) {
      const int cd = o >> 6, col = o & 63;
      float s = 0.f;
#pragma unroll
      for (int k2 = 0; k2 < 16; ++k2) s += smem[(k2 * 9 + cd) * 64 + col];
      mod[(size_t)(l * 9 + cd) * 6144 + n0 + col] = s + p.ada_b[l * 6144 + n0 + col];
    }
  }
  __syncthreads();
}

DI void transpose_job(const float* __restrict__ src, u16* __restrict__ dst, int K, int N, int Npad, float* tile) {
  const int tid = tid_();
  const int nkt = K / 64, total = nkt * (Npad / 64);
  for (int t = blockIdx.x; t < total; t += gridDim.x) {
    const int k0 = (t % nkt) * 64, n0 = (t / nkt) * 64;
    const int c = tid & 63, r0 = tid >> 6;
#pragma unroll
    for (int i = 0; i < 16; ++i) { const int r = r0 + 4 * i; tile[r * 65 + c] = (n0 + c < N) ? src[(size_t)(k0 + r) * N + n0 + c] : 0.f; }
    __syncthreads();
    const int n = tid >> 2, ks = (tid & 3) * 16;
    u32x4 v0, v1;
    v0.x = pk2(tile[(ks + 0) * 65 + n], tile[(ks + 1) * 65 + n]); v0.y = pk2(tile[(ks + 2) * 65 + n], tile[(ks + 3) * 65 + n]);
    v0.z = pk2(tile[(ks + 4) * 65 + n], tile[(ks + 5) * 65 + n]); v0.w = pk2(tile[(ks + 6) * 65 + n], tile[(ks + 7) * 65 + n]);
    v1.x = pk2(tile[(ks + 8) * 65 + n], tile[(ks + 9) * 65 + n]); v1.y = pk2(tile[(ks + 10) * 65 + n], tile[(ks + 11) * 65 + n]);
    v1.z = pk2(tile[(ks + 12) * 65 + n], tile[(ks + 13) * 65 + n]); v1.w = pk2(tile[(ks + 14) * 65 + n], tile[(ks + 15) * 65 + n]);
    u16* d = dst + (size_t)(n0 + n) * K + k0 + ks;
    *(u32x4*)d = v0; *(u32x4*)(d + 8) = v1;
    __syncthreads();
  }
}

DI void phase0(const Params& p, char* smem) {
  ada_phase(p, (float*)smem);
  float* tile = (float*)smem;
  char* ws = p.ws;
  for (int j = 0; j < 2; ++j) {
    transpose_job(p.mla_w_in + (size_t)j * 2048 * 5696, (u16*)(ws + WS_WT_MLA_IN) + (size_t)j * 5760 * 2048, 2048, 5696, 5760, tile);
    transpose_job(p.mla_w_ukv + (size_t)j * 512 * 4096, (u16*)(ws + WS_WT_MLA_UKV) + (size_t)j * 4096 * 512, 512, 4096, 4096, tile);
    transpose_job(p.mla_w_out + (size_t)j * 2048 * 2048, (u16*)(ws + WS_WT_MLA_OUT) + (size_t)j * 2048 * 2048, 2048, 2048, 2048, tile);
  }
  transpose_job(p.s5_w_in, (u16*)(ws + WS_WT_S5_IN), 2048, 4096, 4096, tile);
  transpose_job(p.s5_w_glu, (u16*)(ws + WS_WT_S5_GLU), 2048, 2048, 2048, tile);
  transpose_job(p.s5_w_out, (u16*)(ws + WS_WT_S5_OUT), 2048, 2048, 2048, tile);
  transpose_job(p.gla_w_in, (u16*)(ws + WS_WT_GLA_IN), 2048, 6176, 6272, tile);
  transpose_job(p.gla_w_out, (u16*)(ws + WS_WT_GLA_OUT), 2048, 2048, 2048, tile);
}

DI void norm_phase(const Params& p, int l, bool first) {
  const int lane = tid_() & 63, wv = tid_() >> 6;
  const float* mod = (const float*)(p.ws + WS_MOD);
  const u16* OP = (const u16*)(p.ws + WS_OP);
  u16* H = (u16*)(p.ws + WS_H);
  for (int T = blockIdx.x * 4 + wv; T < NTOK; T += gridDim.x * 4) {
    const int cd = cond_of(T);
    const float* xin = T < NCTX ? p.x_prompt + (size_t)T * D : p.x_sample + (size_t)(T - NCTX) * D;
    float* xrow = p.out + (size_t)T * D;
    f32x4 x[8];
    if (first) {
#pragma unroll
      for (int j = 0; j < 8; ++j) x[j] = *(const f32x4*)(xin + (j * 64 + lane) * 4);
    } else {
      const float* xold = (l == 1) ? xin : xrow;
      const u16* op = OP + (size_t)T * D;
      f32x4 o[8];
      float ss = 0.f;
#pragma unroll
      for (int j = 0; j < 8; ++j) { o[j] = ld_bf4(op + (j * 64 + lane) * 4); ss += o[j][0] * o[j][0] + o[j][1] * o[j][1] + o[j][2] * o[j][2] + o[j][3] * o[j][3]; }
      ss = wave_sum(ss);
      const float rstd = rsqrtf(ss * (1.f / D) + EPS);
      const float* npost = p.norm_post + (l - 1) * D;
      const float* gate = mod + (size_t)((l - 1) * 9 + cd) * 6144 + 4096;
#pragma unroll
      for (int j = 0; j < 8; ++j) {
        const int col = (j * 64 + lane) * 4;
        const f32x4 xo = *(const f32x4*)(xold + col), np = *(const f32x4*)(npost + col), g = *(const f32x4*)(gate + col);
        x[j] = xo + g * (o[j] * rstd * np);
        *(f32x4*)(xrow + col) = x[j];
      }
    }
    if (l < 4) {
      float ss = 0.f;
#pragma unroll
      for (int j = 0; j < 8; ++j) ss += x[j][0] * x[j][0] + x[j][1] * x[j][1] + x[j][2] * x[j][2] + x[j][3] * x[j][3];
      ss = wave_sum(ss);
      const float rstd = rsqrtf(ss * (1.f / D) + EPS);
      const float* npre = p.norm_pre + l * D;
      const float* sh = mod + (size_t)(l * 9 + cd) * 6144;
      u16* hrow = H + (size_t)T * D;
#pragma unroll
      for (int j = 0; j < 8; ++j) {
        const int col = (j * 64 + lane) * 4;
        const f32x4 np = *(const f32x4*)(npre + col), s1 = *(const f32x4*)(sh + col), sc = *(const f32x4*)(sh + 2048 + col);
        const f32x4 hv = x[j] * rstd * np * (1.f + sc) + s1;
        st_bf4(hrow + col, hv[0], hv[1], hv[2], hv[3]);
      }
    }
  }
}

template <bool SWAP, class Epi>
DI void gemm_tile(const int w, const u16* __restrict__ A, int lda, const u16* __restrict__ Bt, int ldb, int K, int m0, int n0, const Epi& epi, char* smem) {
  u16* As = (u16*)smem;
  u16* Bs = As + 256 * 72;
  const int tid = tid_(), lane = tid & 63, r = lane & 31, h = lane >> 5;
  const int wm = w >> 1, wn = w & 1;
  const int lrow = tid >> 3, lseg = tid & 7;
  const __amdgpu_buffer_rsrc_t Ars = __builtin_amdgcn_make_buffer_rsrc((void*)(A + (size_t)m0 * lda), 0, 0x7fffffff, 0x00020000);
  const __amdgpu_buffer_rsrc_t Brs = __builtin_amdgcn_make_buffer_rsrc((void*)(Bt + (size_t)n0 * ldb), 0, 0x7fffffff, 0x00020000);
  const int aoff = (lrow * lda + lseg * 8) * 2, boff = (lrow * ldb + lseg * 8) * 2;
  u32x4 ra[8], rb[4];
  f32x16 acc[4][2];
#pragma unroll
  for (int i = 0; i < 4; ++i)
#pragma unroll
    for (int j = 0; j < 2; ++j)
#pragma unroll
      for (int e = 0; e < 16; ++e) acc[i][j][e] = 0.f;
#define GT_GL(K0) { _Pragma("unroll") for (int q = 0; q < 8; ++q) ra[q] = __builtin_bit_cast(u32x4, __builtin_amdgcn_raw_buffer_load_b128(Ars, aoff, (32 * q * lda + (K0)) * 2, 0)); \
                    _Pragma("unroll") for (int q = 0; q < 4; ++q) rb[q] = __builtin_bit_cast(u32x4, __builtin_amdgcn_raw_buffer_load_b128(Brs, boff, (32 * q * ldb + (K0)) * 2, 0)); }
#define GT_LS() { _Pragma("unroll") for (int q = 0; q < 8; ++q) *(u32x4*)(As + (lrow + 32 * q) * 72 + lseg * 8) = ra[q]; \
                  _Pragma("unroll") for (int q = 0; q < 4; ++q) *(u32x4*)(Bs + (lrow + 32 * q) * 72 + lseg * 8) = rb[q]; }
  const int nk = K >> 6;
  GT_GL(0);
  __syncthreads();
  GT_LS();
  __syncthreads();
  const u16* as = As + (wm * 128 + r) * 72 + h * 8;
  const u16* bs = Bs + (wn * 64 + r) * 72 + h * 8;
  for (int kt = 0; kt < nk; ++kt) {
    { const int k1 = (kt + 1 < nk ? kt + 1 : kt) << 6; GT_GL(k1); }
    __builtin_amdgcn_sched_barrier(0);
#pragma unroll
    for (int ks = 0; ks < 4; ++ks) {
      bf16x8 b[2];
#pragma unroll
      for (int j = 0; j < 2; ++j) b[j] = *(const bf16x8*)(bs + j * 32 * 72 + ks * 16);
#pragma unroll
      for (int i = 0; i < 4; ++i) {
        const bf16x8 a = *(const bf16x8*)(as + i * 32 * 72 + ks * 16);
#pragma unroll
        for (int j = 0; j < 2; ++j) acc[i][j] = SWAP ? MFMA32(b[j], a, acc[i][j]) : MFMA32(a, b[j], acc[i][j]);
      }
    }
    __syncthreads();
    GT_LS();
    __syncthreads();
  }
#undef GT_GL
#undef GT_LS
  int lane2;
  asm volatile("v_mbcnt_lo_u32_b32 %0, -1, 0\n\tv_mbcnt_hi_u32_b32 %0, -1, %0" : "=v"(lane2));
  const int r2 = lane2 & 31, h2 = lane2 >> 5;
#pragma unroll
  for (int i = 0; i < 4; ++i)
#pragma unroll
    for (int j = 0; j < 2; ++j) epi(m0 + wm * 128 + i * 32, n0 + wn * 64 + j * 32, acc[i][j], r2, h2);
}

template <class F>
DI void for_tiles(int MT, int NT, const F& f) {
  const int G = gridDim.x;
  if ((G & 7) == 0 && (MT & 7) == 0) {
    const int G8 = G >> 3, xcd = blockIdx.x & 7, loc = blockIdx.x >> 3;
    const int SM = MT >> 3, SN = (NT + 7) >> 3, total = SM * SN * 64;
    for (int i = 0;; ++i) {
      const int u = (i * 8 + xcd) * G8 + loc;
      if (u >= total) break;
      const int sup = u >> 6, win = u & 63;
      const int mt = (sup % SM) * 8 + (win & 7), nt = (sup / SM) * 8 + (win >> 3);
      if (nt < NT) f(mt, nt);
    }
  } else {
    for (int t = blockIdx.x; t < MT * NT; t += G) f(t % MT, t / MT);
  }
}

DI void rope16(f32x16& v, int pos, int h) {
#pragma unroll
  for (int g = 0; g < 2; ++g)
#pragma unroll
    for (int e = 0; e < 4; ++e) {
      const int f = 8 * g + 4 * h + e;
      const float invf = exp2f(-(float)f * 0.83048202372184058696f);
      const float rev = ((float)pos * invf) * 0.15915494309189533577f;
      const float sn = __builtin_amdgcn_sinf(rev), cs = __builtin_amdgcn_cosf(rev);
      const float x1 = v[4 * g + e], x2 = v[4 * (g + 2) + e];
      v[4 * g + e] = x1 * cs - x2 * sn;
      v[4 * (g + 2) + e] = x1 * sn + x2 * cs;
    }
}

DI void mla_g1(const Params& p, int j, char* smem) {
  char* ws = p.ws;
  const u16* H = (const u16*)(ws + WS_H);
  const u16* Wt = (const u16*)(ws + WS_WT_MLA_IN) + (size_t)j * 5760 * 2048;
  auto epi = [&](int tm, int tn, const f32x16& acc, int r, int h) {
    char* ws2 = p.ws;
    u16* QB = (u16*)(ws2 + A_QB); float* CKVRAW = (float*)(ws2 + A_CKVRAW); u16* SG = (u16*)(ws2 + A_SGATE); u16* KB = (u16*)(ws2 + A_KB);
    float* okr = p.out + OUT_KROPE;
    const int m = tm + r;
    if (tn < 3072) {
      const int within = tn % 192;
      f32x16 v = acc;
      if (within >= 128 && m >= NCTX) { const int tl = (m - NCTX) & 1023; rope16(v, within < 160 ? (tl >> 6) : (tl & 63), h); }
#pragma unroll
      for (int g = 0; g < 4; ++g) st_bf4(QB + (size_t)m * 3072 + tn + 8 * g + 4 * h, v[4 * g], v[4 * g + 1], v[4 * g + 2], v[4 * g + 3]);
    } else if (tn < 3584) {
#pragma unroll
      for (int g = 0; g < 4; ++g) { f32x4 o = {acc[4 * g], acc[4 * g + 1], acc[4 * g + 2], acc[4 * g + 3]}; *(f32x4*)(CKVRAW + (size_t)m * 512 + (tn - 3072) + 8 * g + 4 * h) = o; }
    } else if (tn < 3648) {
      f32x16 v = acc;
      const int c0 = tn - 3584;
      if (m >= NCTX) { const int tl = (m - NCTX) & 1023; rope16(v, c0 == 0 ? (tl >> 6) : (tl & 63), h); }
      else {
        const int b = m >> 8, t = m & 255;
#pragma unroll
        for (int g = 0; g < 4; ++g) { f32x4 o = {v[4 * g], v[4 * g + 1], v[4 * g + 2], v[4 * g + 3]}; *(f32x4*)(okr + ((size_t)(b * 2 + j) * 256 + t) * 64 + c0 + 8 * g + 4 * h) = o; }
      }
      const size_t R = kvrow_of(m);
      for (int hd = 0; hd < 16; ++hd)
#pragma unroll
        for (int g = 0; g < 4; ++g) st_bf4(KB + (R * 16 + hd) * 192 + 128 + c0 + 8 * g + 4 * h, v[4 * g], v[4 * g + 1], v[4 * g + 2], v[4 * g + 3]);
    } else if (tn < 5696) {
#pragma unroll
      for (int g = 0; g < 4; ++g) st_bf4(SG + (size_t)m * 2048 + (tn - 3648) + 8 * g + 4 * h, siluf(acc[4 * g]), siluf(acc[4 * g + 1]), siluf(acc[4 * g + 2]), siluf(acc[4 * g + 3]));
    }
  };
  const int wv_ = __builtin_amdgcn_readfirstlane(tid_() >> 6);
  for_tiles(48, 45, [&](int mt, int nt) { gemm_tile<true>(wv_, H, 2048, Wt, 2048, 2048, mt * 256, nt * 128, epi, smem); });
}

DI void mla_a2(const Params& p, int j) {
  char* ws = p.ws;
  const int lane = tid_() & 63, wv = tid_() >> 6;
  const float* CKVRAW = (const float*)(ws + A_CKVRAW); u16* CKVALL = (u16*)(ws + A_CKVALL); u16* KB = (u16*)(ws + A_KB);
  const float* kvn = p.mla_kv_norm + j * 512;
  float* ockv = p.out + OUT_CKV;
  for (int R = blockIdx.x * 4 + wv; R < 14336; R += gridDim.x * 4) {
    int T = -1, cb = 0, ct = 0;
    if (R < NCTX) T = R;
    else { const int r2 = R - NCTX; cb = r2 / 1280; const int tp = r2 - cb * 1280; if (tp < 1024) T = NCTX + cb * 1024 + tp; else ct = tp - 1024; }
    u16* dst = CKVALL + (size_t)R * 512;
    if (T >= 0) {
      const float* src = CKVRAW + (size_t)T * 512;
      const f32x4 a = *(const f32x4*)(src + lane * 4), b = *(const f32x4*)(src + 256 + lane * 4);
      float ss = a[0] * a[0] + a[1] * a[1] + a[2] * a[2] + a[3] * a[3] + b[0] * b[0] + b[1] * b[1] + b[2] * b[2] + b[3] * b[3];
      ss = wave_sum(ss);
      const float rstd = rsqrtf(ss * (1.f / 512.f) + EPS);
      const f32x4 g0 = *(const f32x4*)(kvn + lane * 4), g1 = *(const f32x4*)(kvn + 256 + lane * 4);
      const f32x4 y0 = a * rstd * g0, y1 = b * rstd * g1;
      st_bf4(dst + lane * 4, y0[0], y0[1], y0[2], y0[3]);
      st_bf4(dst + 256 + lane * 4, y1[0], y1[1], y1[2], y1[3]);
      if (T < NCTX) {
        float* o = ockv + ((size_t)((T >> 8) * 2 + j) * 256 + (T & 255)) * 512;
        *(f32x4*)(o + lane * 4) = y0; *(f32x4*)(o + 256 + lane * 4) = y1;
      }
    } else {
      const float* src = p.cache_ckv + ((size_t)(cb * 2 + j) * 256 + ct) * 512;
      const f32x4 a = *(const f32x4*)(src + lane * 4), b = *(const f32x4*)(src + 256 + lane * 4);
      st_bf4(dst + lane * 4, a[0], a[1], a[2], a[3]);
      st_bf4(dst + 256 + lane * 4, b[0], b[1], b[2], b[3]);
      const float kr = p.cache_krope[((size_t)(cb * 2 + j) * 256 + ct) * 64 + lane];
      const u16 kb = f2bf(kr);
      for (int hd = 0; hd < 16; ++hd) KB[((size_t)R * 16 + hd) * 192 + 128 + lane] = kb;
    }
  }
}

DI void mla_g2(const Params& p, int j, char* smem) {
  char* ws = p.ws;
  const u16* CKVALL = (const u16*)(ws + A_CKVALL);
  const u16* Wt = (const u16*)(ws + WS_WT_MLA_UKV) + (size_t)j * 4096 * 512;
  u16* KB = (u16*)(ws + A_KB); u16* VT = (u16*)(ws + A_VT);
  auto epiK = [&](int tm, int tn, const f32x16& acc, int r, int h) {
    const size_t R = tm + r; const int hd = tn >> 8, wi = tn & 255;
#pragma unroll
    for (int g = 0; g < 4; ++g) st_bf4(KB + (R * 16 + hd) * 192 + wi + 8 * g + 4 * h, acc[4 * g], acc[4 * g + 1], acc[4 * g + 2], acc[4 * g + 3]);
  };
  auto epiV = [&](int tm, int tn, const f32x16& acc, int r, int h) {
    const int n = tn + r; const int hd = n >> 8, d = (n & 255) - 128;
    size_t base; int nkeys, key0;
    if (tm < NCTX) { base = (size_t)(tm >> 8) * 256 * 2048; nkeys = 256; key0 = tm & 255; }
    else { const int r2 = tm - NCTX; const int b = r2 / 1280; base = (size_t)NCTX * 2048 + (size_t)b * 1280 * 2048; nkeys = 1280; key0 = r2 - b * 1280; }
    u16* dst = VT + base + (size_t)(hd * 128 + d) * nkeys + key0;
#pragma unroll
    for (int g = 0; g < 4; ++g) st_bf4(dst + 8 * g + 4 * h, acc[4 * g], acc[4 * g + 1], acc[4 * g + 2], acc[4 * g + 3]);
  };
  const int wv_ = __builtin_amdgcn_readfirstlane(tid_() >> 6);
  for_tiles(56, 32, [&](int mt, int nt) {
    if ((nt & 1) == 0) gemm_tile<true>(wv_, CKVALL, 512, Wt, 512, 512, mt * 256, nt * 128, epiK, smem);
    else gemm_tile<false>(wv_, CKVALL, 512, Wt, 512, 512, mt * 256, nt * 128, epiV, smem);
  });
}

DI void mla_attn(const Params& p, char* smem) {
  char* ws = p.ws;
  const u16* QB = (const u16*)(ws + A_QB); const u16* KB = (const u16*)(ws + A_KB); const u16* VT = (const u16*)(ws + A_VT); const u16* SG = (const u16*)(ws + A_SGATE);
  u16* OG = (u16*)(ws + WS_H);
  char* Ks = smem;
  char* Vs = smem + 25600;
  const int tid = tid_();
  const int lane = tid & 63, w = tid >> 6, r = lane & 31, h = lane >> 5;
  const float SC = 0.07216878364870322f * 1.4426950408889634f;
  for (int it = blockIdx.x; it < 1536; it += gridDim.x) {
    int head, T0, R0, nkeys; size_t vbase;
    if (it < 1024) { const int b = it >> 7; head = (it >> 3) & 15; T0 = NCTX + b * 1024 + (it & 7) * 128; R0 = NCTX + b * 1280; nkeys = 1280; vbase = (size_t)NCTX * 2048 + (size_t)b * 1280 * 2048; }
    else { const int i2 = it - 1024; const int b = i2 >> 5; head = (i2 >> 1) & 15; T0 = b * 256 + (i2 & 1) * 128; R0 = b * 256; nkeys = 256; vbase = (size_t)b * 256 * 2048; }
    T0 += w * 32;
    bf16x8 qf[12];
    const u16* qp = QB + (size_t)(T0 + r) * 3072 + head * 192 + 8 * h;
#pragma unroll
    for (int ks = 0; ks < 12; ++ks) qf[ks] = *(const bf16x8*)(qp + ks * 16);
    f32x16 O[4];
#pragma unroll
    for (int dt = 0; dt < 4; ++dt)
#pragma unroll
      for (int e = 0; e < 16; ++e) O[dt][e] = 0.f;
    float mrun = -INFINITY, lrun = 0.f;
    const u16* kg = KB + ((size_t)R0 * 16 + head) * 192;
    const u16* vg = VT + vbase + (size_t)(head * 128) * nkeys;
    u32x4 rk[6], rv[4];
    const __amdgpu_buffer_rsrc_t Krs = __builtin_amdgcn_make_buffer_rsrc((void*)kg, 0, 0x7fffffff, 0x00020000);
    const __amdgpu_buffer_rsrc_t Vrs = __builtin_amdgcn_make_buffer_rsrc((void*)vg, 0, 0x7fffffff, 0x00020000);
    const int kvo = (tid >> 2) * 6144 + (tid & 3) * 16;
    const int vvo = (tid >> 3) * nkeys * 2 + (tid & 7) * 16;
#define AT_LOAD(KT0) { _Pragma("unroll") for (int i = 0; i < 6; ++i) rk[i] = __builtin_bit_cast(u32x4, __builtin_amdgcn_raw_buffer_load_b128(Krs, kvo + 64 * i, (KT0) * 6144, 0)); \
                       _Pragma("unroll") for (int i = 0; i < 4; ++i) rv[i] = __builtin_bit_cast(u32x4, __builtin_amdgcn_raw_buffer_load_b128(Vrs, vvo, (32 * i * nkeys + (KT0)) * 2, 0)); }
#define AT_STORE() { _Pragma("unroll") for (int i = 0; i < 6; ++i) *(u32x4*)(Ks + (tid >> 2) * 400 + ((tid & 3) + 4 * i) * 16) = rk[i]; \
                     _Pragma("unroll") for (int i = 0; i < 4; ++i) { const int sg = tid & 7; char* d = Vs + ((tid >> 3) + 32 * i) * 144 + (sg >> 1) * 32 + (sg & 1) * 8; \
                       u32x2 lo, hi; lo.x = rv[i].x; lo.y = rv[i].y; hi.x = rv[i].z; hi.y = rv[i].w; *(u32x2*)d = lo; *(u32x2*)(d + 16) = hi; } }
    AT_LOAD(0);
    __syncthreads();
    AT_STORE();
    __syncthreads();
    for (int kt0 = 0; kt0 < nkeys; kt0 += 64) {
      { const int kn = kt0 + 64 < nkeys ? kt0 + 64 : kt0; AT_LOAD(kn); }
#pragma unroll
      for (int sub = 0; sub < 2; ++sub) {
        f32x16 S;
#pragma unroll
        for (int e = 0; e < 16; ++e) S[e] = 0.f;
#pragma unroll
        for (int ks = 0; ks < 12; ++ks) { const bf16x8 kf = *(const bf16x8*)(Ks + (sub * 32 + r) * 400 + ks * 32 + h * 16); S = MFMA32(kf, qf[ks], S); }
        float mx = -INFINITY;
#pragma unroll
        for (int e = 0; e < 16; ++e) { S[e] *= SC; mx = fmaxf(mx, S[e]); }
        mx = fmaxf(mx, __shfl_xor(mx, 32));
        const float mnew = fmaxf(mrun, mx);
        const float alpha = __builtin_amdgcn_exp2f(mrun - mnew);
        mrun = mnew;
        float ps = 0.f;
#pragma unroll
        for (int e = 0; e < 16; ++e) { S[e] = __builtin_amdgcn_exp2f(S[e] - mnew); ps += S[e]; }
        lrun = lrun * alpha + ps;
#pragma unroll
        for (int dt = 0; dt < 4; ++dt)
#pragma unroll
          for (int e = 0; e < 16; ++e) O[dt][e] *= alpha;
#pragma unroll
        for (int s = 0; s < 2; ++s) {
          const bf16x8 pf = pack8(S, s);
#pragma unroll
          for (int dt = 0; dt < 4; ++dt) {
            const bf16x8 vf = *(const bf16x8*)(Vs + (dt * 32 + r) * 144 + (sub * 2 + s) * 32 + h * 16);
            O[dt] = MFMA32(vf, pf, O[dt]);
          }
        }
      }
      __syncthreads();
      AT_STORE();
      __syncthreads();
    }
#undef AT_LOAD
#undef AT_STORE
    lrun += __shfl_xor(lrun, 32);
    const float inv = 1.f / lrun;
#pragma unroll
    for (int dt = 0; dt < 4; ++dt)
#pragma unroll
      for (int g = 0; g < 4; ++g) {
        const size_t o = (size_t)(T0 + r) * 2048 + head * 128 + dt * 32 + 8 * g + 4 * h;
        const u32x2 sg = *(const u32x2*)(SG + o);
        st_bf4(OG + o, O[dt][4 * g] * inv * bflo(sg.x), O[dt][4 * g + 1] * inv * bfhi(sg.x), O[dt][4 * g + 2] * inv * bflo(sg.y), O[dt][4 * g + 3] * inv * bfhi(sg.y));
      }
  }
}

DI void gemm_out(const Params& p, const u16* A, const u16* Wt, char* smem) {
  u16* OP = (u16*)(p.ws + WS_OP);
  auto epi = [&](int tm, int tn, const f32x16& acc, int r, int h) {
    const size_t m = tm + r;
#pragma unroll
    for (int g = 0; g < 4; ++g) st_bf4(OP + m * 2048 + tn + 8 * g + 4 * h, acc[4 * g], acc[4 * g + 1], acc[4 * g + 2], acc[4 * g + 3]);
  };
  const int wv_ = __builtin_amdgcn_readfirstlane(tid_() >> 6);
  for_tiles(48, 16, [&](int mt, int nt) { gemm_tile<true>(wv_, A, 2048, Wt, 2048, 2048, mt * 256, nt * 128, epi, smem); });
}

DI void s5_g1(const Params& p, char* smem) {
  char* ws = p.ws;
  const u16* H = (const u16*)(ws + WS_H); const u16* Wt = (const u16*)(ws + WS_WT_S5_IN);
  u16* U = (u16*)(ws + B_U); u16* SG = (u16*)(ws + B_SGATE);
  auto epi = [&](int tm, int tn, const f32x16& acc, int r, int h) {
    const size_t m = tm + r;
    if (tn < 2048) {
#pragma unroll
      for (int g = 0; g < 4; ++g) st_bf4(U + m * 2048 + tn + 8 * g + 4 * h, acc[4 * g], acc[4 * g + 1], acc[4 * g + 2], acc[4 * g + 3]);
    } else {
#pragma unroll
      for (int g = 0; g < 4; ++g) st_bf4(SG + m * 2048 + (tn - 2048) + 8 * g + 4 * h, siluf(acc[4 * g]), siluf(acc[4 * g + 1]), siluf(acc[4 * g + 2]), siluf(acc[4 * g + 3]));
    }
  };
  const int wv_ = __builtin_amdgcn_readfirstlane(tid_() >> 6);
  for_tiles(48, 32, [&](int mt, int nt) { gemm_tile<true>(wv_, H, 2048, Wt, 2048, 2048, mt * 256, nt * 128, epi, smem); });
}

DI void s5_scan(const Params& p, char* smem) {
  char* ws = p.ws;
  const u16* U = (const u16*)(ws + B_U);
  u16* YF = (u16*)(ws + WS_OP); u16* YB = (u16*)(ws + B_YB);
  const int tid = tid_();
  const int lane = tid & 63;
  const int w = __builtin_amdgcn_readfirstlane(tid >> 6);
  char* Hs = smem + w * 12800;
  char* BUs = Hs + 4352;
  const int pcol = lane & 15, quad = lane >> 4;
  for (int it = blockIdx.x * 4 + w; it < 6144; it += gridDim.x * 4) {
    const int dir = it & 1; int rest = it >> 1;
    const bool lat = rest < 1024;
    int b, g, L, T0;
    if (lat) { b = rest >> 7; g = rest & 127; L = 1024; T0 = NCTX + b * 1024; }
    else { rest -= 1024; b = rest >> 7; g = rest & 127; L = 256; T0 = b * 256; }
    const int n = lane;
    const int pidx = (dir * 128 + g) * 64 + n;
    const float are = p.s5_a_re[pidx], aim = p.s5_a_im[pidx];
    const float dt = __expf(p.s5_log_dt[dir * 128 + g]);
    const float mag = __expf(are * dt), rev = (aim * dt) * 0.15915494309189533577f;
    const float abr = mag * __builtin_amdgcn_cosf(rev), abi = mag * __builtin_amdgcn_sinf(rev);
    const float nr = abr - 1.f, ni = abi, den = 1.f / (are * are + aim * aim);
    const float cr = (nr * are + ni * aim) * den, ci = (ni * are - nr * aim) * den;
    {
      const float* br = p.s5_b_re + (size_t)pidx * 16; const float* bi = p.s5_b_im + (size_t)pidx * 16;
      u32x4 re0, re1, im0, im1;
      {
        const f32x4 x0 = *(const f32x4*)(br), x1 = *(const f32x4*)(br + 4), x2 = *(const f32x4*)(br + 8), x3 = *(const f32x4*)(br + 12);
        const f32x4 y0 = *(const f32x4*)(bi), y1 = *(const f32x4*)(bi + 4), y2 = *(const f32x4*)(bi + 8), y3 = *(const f32x4*)(bi + 12);
        const f32x4 r0 = cr * x0 - ci * y0, r1 = cr * x1 - ci * y1, r2 = cr * x2 - ci * y2, r3 = cr * x3 - ci * y3;
        const f32x4 i0 = cr * y0 + ci * x0, i1 = cr * y1 + ci * x1, i2 = cr * y2 + ci * x2, i3 = cr * y3 + ci * x3;
        re0.x = pk2(r0[0], r0[1]); re0.y = pk2(r0[2], r0[3]); re0.z = pk2(r1[0], r1[1]); re0.w = pk2(r1[2], r1[3]);
        re1.x = pk2(r2[0], r2[1]); re1.y = pk2(r2[2], r2[3]); re1.z = pk2(r3[0], r3[1]); re1.w = pk2(r3[2], r3[3]);
        im0.x = pk2(i0[0], i0[1]); im0.y = pk2(i0[2], i0[3]); im0.z = pk2(i1[0], i1[1]); im0.w = pk2(i1[2], i1[3]);
        im1.x = pk2(i2[0], i2[1]); im1.y = pk2(i2[2], i2[3]); im1.z = pk2(i3[0], i3[1]); im1.w = pk2(i3[2], i3[3]);
      }
      char* d = BUs + n * 64;
      *(u32x4*)(d) = re0; *(u32x4*)(d + 16) = re1; *(u32x4*)(d + 32) = im0; *(u32x4*)(d + 48) = im1;
    }
    bf16x8 bfr[8];
#pragma unroll
    for (int nt = 0; nt < 8; ++nt) {
      u32x4 v = {0u, 0u, 0u, 0u};
      if (quad < 2) v = *(const u32x4*)(BUs + (16 * nt + pcol) * 32 + quad * 16);
      bfr[nt] = __builtin_bit_cast(bf16x8, v);
    }
    bf16x8 cf[4];
    {
      const float* c1 = p.s5_c_re + ((size_t)(dir * 128 + g) * 16 + pcol) * 64; const float* c2 = p.s5_c_im + ((size_t)(dir * 128 + g) * 16 + pcol) * 64;
#pragma unroll
      for (int s = 0; s < 4; ++s) {
        const f32x4 x = *(const f32x4*)(c1 + 16 * s + 4 * quad), y = *(const f32x4*)(c2 + 16 * s + 4 * quad);
        u32x4 pk; pk.x = pk2(x[0], -y[0]); pk.y = pk2(x[1], -y[1]); pk.z = pk2(x[2], -y[2]); pk.w = pk2(x[3], -y[3]);
        cf[s] = __builtin_bit_cast(bf16x8, pk);
      }
    }
    float hr = 0.f, hi = 0.f;
    if (lat) { const float* s0 = p.state_s5 + ((size_t)((b * 2 + dir) * 128 + g) * 64 + n) * 2; hr = s0[0]; hi = s0[1]; }
    u16* Y = dir ? YB : YF;
    const int t0 = dir ? L - 1 : 0, tstep = dir ? -1 : 1;
    const u16* ub = U + (size_t)T0 * 2048 + g * 16 + (quad & 1) * 8;
    u32x4 ua = {0u, 0u, 0u, 0u};
    if (quad < 2) ua = *(const u32x4*)(ub + (size_t)(t0 + tstep * pcol) * 2048);
    for (int s0_ = 0; s0_ < L; s0_ += 16) {
      const int tchunk = t0 + tstep * s0_;
      const bf16x8 af = __builtin_bit_cast(bf16x8, ua);
      if (s0_ + 16 < L && quad < 2) ua = *(const u32x4*)(ub + (size_t)(tchunk + tstep * (16 + pcol)) * 2048);
#pragma unroll
      for (int nt = 0; nt < 8; ++nt) {
        f32x4 z = {0.f, 0.f, 0.f, 0.f};
        z = __builtin_amdgcn_mfma_f32_16x16x32_bf16(af, bfr[nt], z, 0, 0, 0);
#pragma unroll
        for (int i = 0; i < 4; ++i) *(float*)(BUs + (4 * quad + i) * 528 + (16 * nt + pcol) * 4) = z[i];
      }
#pragma unroll 4
      for (int row = 0; row < 16; ++row) {
        const f32x2 bu = *(const f32x2*)(BUs + row * 528 + n * 8);
        const float nhr = abr * hr - abi * hi + bu.x, nhi = abr * hi + abi * hr + bu.y;
        hr = nhr; hi = nhi;
        if (!lat && s0_ == 0 && row == 0) { float* so = p.out + OUT_S5 + ((size_t)((b * 2 + dir) * 128 + g) * 64 + n) * 2; so[0] = hr; so[1] = hi; }
        *(unsigned*)(Hs + row * 272 + n * 4) = pk2(hr, hi);
      }
      f32x4 yacc = {0.f, 0.f, 0.f, 0.f};
#pragma unroll
      for (int s = 0; s < 4; ++s) {
        const bf16x8 hf = *(const bf16x8*)(Hs + pcol * 272 + s * 64 + quad * 16);
        yacc = __builtin_amdgcn_mfma_f32_16x16x32_bf16(hf, cf[s], yacc, 0, 0, 0);
      }
#pragma unroll
      for (int i = 0; i < 4; ++i) { const int tok = tchunk + tstep * (4 * quad + i); Y[(size_t)(T0 + tok) * 2048 + g * 16 + pcol] = f2bf(yacc[i]); }
    }
  }
}

DI float gelu_tanh(float x) {
  const float t = 0.7978845608028654f * (x + 0.044715f * x * x * x);
  const float e = __expf(2.f * t);
  const float th = 1.f - 2.f / (e + 1.f);
  return 0.5f * x * (1.f + th);
}

DI void s5_combine(const Params& p) {
  char* ws = p.ws;
  const u16* U = (const u16*)(ws + B_U); const u16* YF = (const u16*)(ws + WS_OP); const u16* YB = (const u16*)(ws + B_YB);
  u16* YG = (u16*)(ws + WS_H);
  const size_t n4 = (size_t)NTOK * 2048 / 4;
  for (size_t i = (size_t)blockIdx.x * 256 + tid_(); i < n4; i += (size_t)gridDim.x * 256) {
    const int col = (int)((i * 4) & 2047);
    const f32x4 u = ld_bf4(U + i * 4), a = ld_bf4(YF + i * 4), b = ld_bf4(YB + i * 4), d = *(const f32x4*)(p.s5_d + col);
    const f32x4 y = d * u + a + b;
    st_bf4(YG + i * 4, gelu_tanh(y[0]), gelu_tanh(y[1]), gelu_tanh(y[2]), gelu_tanh(y[3]));
  }
}

DI void s5_g2(const Params& p, char* smem) {
  char* ws = p.ws;
  const u16* YG = (const u16*)(ws + WS_H); const u16* Wt = (const u16*)(ws + WS_WT_S5_GLU); const u16* SG = (const u16*)(ws + B_SGATE);
  u16* Z = (u16*)(ws + B_Z);
  auto epi = [&](int tm, int tn, const f32x16& acc, int r, int h) {
    const size_t m = tm + r;
#pragma unroll
    for (int g = 0; g < 4; ++g) {
      const int n = tn + 8 * g + 4 * h;
      const f32x4 bg = *(const f32x4*)(p.s5_b_glu + n);
      const u32x2 yv = *(const u32x2*)(YG + m * 2048 + n), sg = *(const u32x2*)(SG + m * 2048 + n);
      st_bf4(Z + m * 2048 + n, bflo(yv.x) * sigmf(acc[4 * g] + bg[0]) * bflo(sg.x), bfhi(yv.x) * sigmf(acc[4 * g + 1] + bg[1]) * bfhi(sg.x),
             bflo(yv.y) * sigmf(acc[4 * g + 2] + bg[2]) * bflo(sg.y), bfhi(yv.y) * sigmf(acc[4 * g + 3] + bg[3]) * bfhi(sg.y));
    }
  };
  const int wv_ = __builtin_amdgcn_readfirstlane(tid_() >> 6);
  for_tiles(48, 16, [&](int mt, int nt) { gemm_tile<true>(wv_, YG, 2048, Wt, 2048, 2048, mt * 256, nt * 128, epi, smem); });
}

DI void gla_g1(const Params& p, char* smem) {
  char* ws = p.ws;
  const u16* H = (const u16*)(ws + WS_H); const u16* Wt = (const u16*)(ws + WS_WT_GLA_IN);
  u16* VT = (u16*)(ws + C_VT);
  auto epi = [&](int tm, int tn, const f32x16& acc, int r, int h) {
    char* ws2 = p.ws;
    u16* QG = (u16*)(ws2 + C_QG); u16* KG = (u16*)(ws2 + C_KG); u16* SG = (u16*)(ws2 + C_SGATE); float* GLR = (float*)(ws2 + C_GLR);
    const size_t m = tm + r;
    if (tn < 1024) {
#pragma unroll
      for (int g = 0; g < 4; ++g) st_bf4(QG + m * 1024 + tn + 8 * g + 4 * h, acc[4 * g] * 0.0625f, acc[4 * g + 1] * 0.0625f, acc[4 * g + 2] * 0.0625f, acc[4 * g + 3] * 0.0625f);
    } else if (tn < 2048) {
#pragma unroll
      for (int g = 0; g < 4; ++g) st_bf4(KG + m * 1024 + (tn - 1024) + 8 * g + 4 * h, acc[4 * g], acc[4 * g + 1], acc[4 * g + 2], acc[4 * g + 3]);
    } else if (tn >= 4096 && tn < 6144) {
#pragma unroll
      for (int g = 0; g < 4; ++g) st_bf4(SG + m * 2048 + (tn - 4096) + 8 * g + 4 * h, siluf(acc[4 * g]), siluf(acc[4 * g + 1]), siluf(acc[4 * g + 2]), siluf(acc[4 * g + 3]));
    } else if (tn == 6144) {
#pragma unroll
      for (int g = 0; g < 4; ++g) { f32x4 o = {acc[4 * g], acc[4 * g + 1], acc[4 * g + 2], acc[4 * g + 3]}; *(f32x4*)(GLR + m * 32 + 8 * g + 4 * h) = o; }
    }
  };
  auto epiV = [&](int tm, int tn, const f32x16& acc, int r, int h) {
    const int dv = tn - 2048 + r;
    u16* dst = VT + ((size_t)(tm >> 6) * 2048 + dv) * 64 + (tm & 63);
#pragma unroll
    for (int g = 0; g < 4; ++g) st_bf4(dst + 8 * g + 4 * h, acc[4 * g], acc[4 * g + 1], acc[4 * g + 2], acc[4 * g + 3]);
  };
  const int wv_ = __builtin_amdgcn_readfirstlane(tid_() >> 6);
  for_tiles(48, 49, [&](int mt, int nt) {
    if (nt >= 16 && nt < 32) gemm_tile<false>(wv_, H, 2048, Wt, 2048, 2048, mt * 256, nt * 128, epiV, smem);
    else gemm_tile<true>(wv_, H, 2048, Wt, 2048, 2048, mt * 256, nt * 128, epi, smem);
  });
}

DI float logsigf(float z) { return fminf(z, 0.f) - __logf(1.f + __expf(-fabsf(z))); }

DI void gla_gate(const Params& p, float* smem) {
  char* ws = p.ws;
  const u16* QG = (const u16*)(ws + C_QG); const u16* KG = (const u16*)(ws + C_KG); const float* GLR = (const float*)(ws + C_GLR);
  u16* QT = (u16*)(ws + C_QT); u16* KT = (u16*)(ws + C_KT); u16* KDT = (u16*)(ws + C_KDT); float* DN = (float*)(ws + C_DN);
  const int tid = tid_();
  for (int it = blockIdx.x; it < 1536; it += gridDim.x) {
    const int dir = it & 1, hd = (it >> 1) & 3, c = it >> 3;
    const int ch = hd * 256 + tid;
    __syncthreads();
    for (int i = tid; i < 1024; i += 256) smem[i] = GLR[(size_t)(c * 64 + (i >> 4)) * 32 + dir * 16 + (i & 15)];
    __syncthreads();
    float wg[16];
#pragma unroll
    for (int q = 0; q < 16; ++q) wg[q] = p.gla_w_g2[(size_t)(dir * 16 + q) * 1024 + ch];
    const float bg = p.gla_b_g[dir * 1024 + ch];
    float tot = 0.f;
    for (int i = 0; i < 64; ++i) {
      float z = bg;
#pragma unroll
      for (int q = 0; q < 16; ++q) z += smem[i * 16 + q] * wg[q];
      tot += logsigf(z) * 0.0625f;
    }
    DN[(size_t)(dir * 192 + c) * 1024 + ch] = __expf(tot);
    float run = 0.f;
    u16* kdrow = KDT + ((size_t)((dir * 192 + c) * 4 + hd) * 256 + tid) * 64;
    for (int i8 = 0; i8 < 8; ++i8) {
      float kdv[8];
#pragma unroll
      for (int e = 0; e < 8; ++e) {
        const int ii = i8 * 8 + e;
        const int i = dir ? 63 - ii : ii;
        float z = bg;
#pragma unroll
        for (int q = 0; q < 16; ++q) z += smem[i * 16 + q] * wg[q];
        run += logsigf(z) * 0.0625f;
        const size_t T = (size_t)c * 64 + i;
        const float q_ = bf2f(QG[T * 1024 + ch]), k_ = bf2f(KG[T * 1024 + ch]);
        QT[((size_t)dir * NTOK + T) * 1024 + ch] = f2bf(q_ * __expf(run));
        KT[((size_t)dir * NTOK + T) * 1024 + ch] = f2bf(k_ * __expf(-run));
        kdv[e] = k_ * __expf(tot - run);
      }
      u32x4 pk;
      if (dir) { pk.x = pk2(kdv[7], kdv[6]); pk.y = pk2(kdv[5], kdv[4]); pk.z = pk2(kdv[3], kdv[2]); pk.w = pk2(kdv[1], kdv[0]); }
      else { pk.x = pk2(kdv[0], kdv[1]); pk.y = pk2(kdv[2], kdv[3]); pk.z = pk2(kdv[4], kdv[5]); pk.w = pk2(kdv[6], kdv[7]); }
      const int tb = dir ? 56 - i8 * 8 : i8 * 8;
      *(u32x4*)(kdrow + tb) = pk;
    }
  }
  __syncthreads();
}

DI void gla_main(const Params& p, char* smem) {
  char* ws = p.ws;
  const u16* QT = (const u16*)(ws + C_QT); const u16* KT = (const u16*)(ws + C_KT); const u16* KDT = (const u16*)(ws + C_KDT); const u16* VT = (const u16*)(ws + C_VT);
  const float* DN = (const float*)(ws + C_DN);
  u16* OF = (u16*)(ws + WS_OP); u16* OB = (u16*)(ws + C_OB);
  u16* att = (u16*)smem;
  const int lane = tid_() & 63, w = tid_() >> 6, r = lane & 31, h = lane >> 5;
  for (int it = blockIdx.x; it < 768; it += gridDim.x) {
    const bool lat = it < 256;
    const int i2 = lat ? it : it - 256;
    const int bs = i2 >> 5, hd = (i2 >> 3) & 3, dir = (i2 >> 2) & 1, sl = i2 & 3;
    const int nc = lat ? 16 : 4, T0 = lat ? NCTX + bs * 1024 : bs * 256;
    const int vcol0 = hd * 512 + sl * 128 + w * 32;
    f32x16 S[8];
    if (lat) {
      const float* s0 = p.state_gla + ((size_t)((bs * 2 + dir) * 4 + hd) * 256) * 512 + (sl * 128 + w * 32 + r);
#pragma unroll
      for (int mt = 0; mt < 8; ++mt)
#pragma unroll
        for (int e = 0; e < 16; ++e) S[mt][e] = s0[(size_t)(32 * mt + crow(e, h)) * 512];
    } else {
#pragma unroll
      for (int mt = 0; mt < 8; ++mt)
#pragma unroll
        for (int e = 0; e < 16; ++e) S[mt][e] = 0.f;
    }
    u16* OD = dir ? OB : OF;
    for (int cc = 0; cc < nc; ++cc) {
      const int c = dir ? nc - 1 - cc : cc;
      const int Tc = T0 + c * 64, cgx = Tc >> 6;
      const u16* qt = QT + ((size_t)dir * NTOK + Tc) * 1024 + hd * 256;
      const u16* kt = KT + ((size_t)dir * NTOK + Tc) * 1024 + hd * 256;
      const u16* kdT = KDT + ((size_t)((dir * 192 + cgx) * 4 + hd) * 256) * 64;
      const u16* vT = VT + ((size_t)cgx * 2048 + vcol0 + r) * 64;
      const float* dn = DN + (size_t)(dir * 192 + cgx) * 1024 + hd * 256;
      {
        f32x16 a;
#pragma unroll
        for (int e = 0; e < 16; ++e) a[e] = 0.f;
        const int ci = w >> 1, si = w & 1;
        const u16* qa = qt + (size_t)(32 * ci + r) * 1024 + 8 * h; const u16* kb = kt + (size_t)(32 * si + r) * 1024 + 8 * h;
#pragma unroll
        for (int ks = 0; ks < 16; ++ks) a = MFMA32(*(const bf16x8*)(qa + ks * 16), *(const bf16x8*)(kb + ks * 16), a);
#pragma unroll
        for (int e = 0; e < 16; ++e) {
          const int cr_ = 32 * ci + crow(e, h), sc_ = 32 * si + r;
          const bool keep = dir ? (sc_ >= cr_) : (sc_ <= cr_);
          att[cr_ * 72 + sc_] = keep ? f2bf(a[e]) : (u16)0;
        }
      }
      __syncthreads();
      f32x16 o[2];
#pragma unroll
      for (int q = 0; q < 2; ++q)
#pragma unroll
        for (int e = 0; e < 16; ++e) o[q][e] = 0.f;
#pragma unroll
      for (int mt = 0; mt < 8; ++mt)
#pragma unroll
        for (int s = 0; s < 2; ++s) {
          const bf16x8 sf = pack8(S[mt], s);
#pragma unroll
          for (int q = 0; q < 2; ++q) {
            const u16* qa = qt + (size_t)(32 * q + r) * 1024 + 32 * mt + 16 * s + 4 * h;
            const s16x4 lo = *(const s16x4*)qa, hi = *(const s16x4*)(qa + 8);
            o[q] = MFMA32(cat4(lo, hi), sf, o[q]);
          }
        }
      bf16x8 vf[4];
#pragma unroll
      for (int ks = 0; ks < 4; ++ks) vf[ks] = *(const bf16x8*)(vT + ks * 16 + 8 * h);
#pragma unroll
      for (int q = 0; q < 2; ++q)
#pragma unroll
        for (int ks = 0; ks < 4; ++ks) { const bf16x8 af = *(const bf16x8*)(att + (32 * q + r) * 72 + ks * 16 + 8 * h); o[q] = MFMA32(af, vf[ks], o[q]); }
#pragma unroll
      for (int q = 0; q < 2; ++q)
#pragma unroll
        for (int e = 0; e < 16; ++e) OD[(size_t)(Tc + 32 * q + crow(e, h)) * 2048 + vcol0 + r] = f2bf(o[q][e]);
#pragma unroll
      for (int mt = 0; mt < 8; ++mt) {
#pragma unroll
        for (int g = 0; g < 4; ++g) {
          const f32x4 d4 = *(const f32x4*)(dn + 32 * mt + 8 * g + 4 * h);
#pragma unroll
          for (int e = 0; e < 4; ++e) S[mt][4 * g + e] *= d4[e];
        }
#pragma unroll
        for (int ks = 0; ks < 4; ++ks) { const bf16x8 af = *(const bf16x8*)(kdT + (size_t)(32 * mt + r) * 64 + ks * 16 + 8 * h); S[mt] = MFMA32(af, vf[ks], S[mt]); }
      }
      __syncthreads();
    }
    if (!lat) {
      float* so = p.out + OUT_GLA + ((size_t)((bs * 2 + dir) * 4 + hd) * 256) * 512 + (sl * 128 + w * 32 + r);
#pragma unroll
      for (int mt = 0; mt < 8; ++mt)
#pragma unroll
        for (int e = 0; e < 16; ++e) so[(size_t)(32 * mt + crow(e, h)) * 512] = S[mt][e];
    }
  }
}

DI void gla_norm(const Params& p) {
  char* ws = p.ws;
  const u16* OF = (const u16*)(ws + WS_OP); const u16* OB = (const u16*)(ws + C_OB); const u16* SG = (const u16*)(ws + C_SGATE);
  u16* OG = (u16*)(ws + WS_H);
  const int lane = tid_() & 63, wv = tid_() >> 6;
  for (int T = blockIdx.x * 4 + wv; T < NTOK; T += gridDim.x * 4) {
    f32x4 x[8];
    float ss[4] = {0.f, 0.f, 0.f, 0.f};
#pragma unroll
    for (int j = 0; j < 8; ++j) {
      const size_t o = (size_t)T * 2048 + (j * 64 + lane) * 4;
      x[j] = ld_bf4(OF + o) + ld_bf4(OB + o);
      ss[j >> 1] += x[j][0] * x[j][0] + x[j][1] * x[j][1] + x[j][2] * x[j][2] + x[j][3] * x[j][3];
    }
#pragma unroll
    for (int q = 0; q < 4; ++q) ss[q] = rsqrtf(wave_sum(ss[q]) * (1.f / 512.f) + EPS);
#pragma unroll
    for (int j = 0; j < 8; ++j) {
      const int col = (j * 64 + lane) * 4;
      const size_t o = (size_t)T * 2048 + col;
      const f32x4 ng = *(const f32x4*)(p.gla_norm + (col & 511));
      const u32x2 sg = *(const u32x2*)(SG + o);
      const f32x4 y = x[j] * ss[j >> 1] * ng;
      st_bf4(OG + o, y[0] * bflo(sg.x), y[1] * bfhi(sg.x), y[2] * bflo(sg.y), y[3] * bfhi(sg.y));
    }
  }
}

#define XB_TMO      128
#define XB_XCNT(j)  (256  + 64 * (j))
#define XB_XSUB(j)  (1280 + 64 * (j))
#define XB_XGEN(j)  (2304 + 64 * (j))
#define XB_TOP      3328
#define XB_TOPGEN   3392
#define XCD_BAR_WORDS 3456
#define XB_SPIN_CAP (1u << 18)
#define LAS __attribute__((address_space(3)))
DI unsigned xb_ld(unsigned* p) { return __hip_atomic_load(p, __ATOMIC_RELAXED, __HIP_MEMORY_SCOPE_AGENT); }
DI unsigned xb_add(unsigned* p, unsigned v) { return __hip_atomic_fetch_add(p, v, __ATOMIC_RELAXED, __HIP_MEMORY_SCOPE_AGENT); }
DI unsigned xb_xcc_id() { return (unsigned)__builtin_amdgcn_s_getreg((3 << 11) | 20) & 0xFu; }
#define XB_SPIN(cond, bar) do { unsigned _sp = 0; while (cond) { __builtin_amdgcn_s_sleep(1); \
    if ((++_sp & 255u) == 0u) { if (xb_ld(&(bar)[XB_TMO])) break; if (_sp > XB_SPIN_CAP) { atomicAdd(&(bar)[XB_TMO], 1u); break; } } } } while (0)
struct XcdBarrier { unsigned* bar; unsigned x; volatile LAS unsigned* st; };
DI XcdBarrier xcd_barrier_post(unsigned* bar, volatile LAS unsigned* st) {
  XcdBarrier b; b.bar = bar; b.x = xb_xcc_id(); b.st = st;
  if (threadIdx.x == 0) (void)xb_add(&bar[XB_XCNT(b.x)], 1u);
  return b;
}
DI void xcd_barrier_complete(unsigned* bar, unsigned x, unsigned& nloc, unsigned& nx) {
  const unsigned G = gridDim.x * gridDim.y * gridDim.z;
  unsigned sum, cnt, mine, sp = 0u;
  for (;;) {
    sum = 0u; cnt = 0u; mine = 0u;
#pragma unroll
    for (unsigned j = 0; j < 16; ++j) { const unsigned c = xb_ld(&bar[XB_XCNT(j)]); sum += c; cnt += (c > 0u) ? 1u : 0u; mine = (j == x) ? c : mine; }
    if (sum == G) break;
    __builtin_amdgcn_s_sleep(1);
    if ((++sp & 255u) == 0u) { if (xb_ld(&bar[XB_TMO])) break; if (sp > XB_SPIN_CAP) { atomicAdd(&bar[XB_TMO], 1u); break; } }
  }
  nloc = mine > 0u ? mine : 1u; nx = cnt > 0u ? cnt : 1u;
}
DI void xcd_barrier(const XcdBarrier& b) {
  asm volatile("s_waitcnt vmcnt(0)" ::: "memory");
  __syncthreads();
  if (threadIdx.x == 0) {
    unsigned* bar = b.bar;
    __builtin_amdgcn_s_waitcnt(0);
    unsigned nloc = b.st[0], nx = b.st[1];
    if (nloc == 0u) { xcd_barrier_complete(bar, b.x, nloc, nx); b.st[0] = nloc; b.st[1] = nx; }
    const unsigned old = xb_add(&bar[XB_XSUB(b.x)], 1u);
    const unsigned gen = old / nloc;
    if (old + 1u == (gen + 1u) * nloc) {
      __builtin_amdgcn_fence(__ATOMIC_RELEASE, "agent");
      asm volatile("s_waitcnt vmcnt(0)" ::: "memory");
      const unsigned og = xb_add(&bar[XB_TOP], 1u);
      const unsigned tg = og / nx;
      if (og + 1u == (tg + 1u) * nx) xb_add(&bar[XB_TOPGEN], 1u);
      else XB_SPIN(xb_ld(&bar[XB_TOPGEN]) == tg, bar);
      __builtin_amdgcn_fence(__ATOMIC_ACQUIRE, "agent");
      xb_add(&bar[XB_XGEN(b.x)], 1u);
      asm volatile("s_waitcnt vmcnt(0)" ::: "memory");
    } else {
      XB_SPIN(xb_ld(&bar[XB_XGEN(b.x)]) == gen, bar);
      __builtin_amdgcn_fence(__ATOMIC_ACQUIRE, "agent");
      asm volatile("s_waitcnt vmcnt(0)" ::: "memory");
    }
  }
  __syncthreads();
}

constexpr int NPHASE = 26;
#ifndef DUPMASK
#define DUPMASK 0u
#endif
template <int PH>
DI void run_phase(const Params& p, char* smem) {
  char* ws = p.ws;
  if constexpr (PH == 0) phase0(p, smem);
  else if constexpr (PH == 1) norm_phase(p, 0, true);
  else if constexpr (PH == 2) mla_g1(p, 0, smem);
  else if constexpr (PH == 3) mla_a2(p, 0);
  else if constexpr (PH == 4) mla_g2(p, 0, smem);
  else if constexpr (PH == 5) mla_attn(p, smem);
  else if constexpr (PH == 6) gemm_out(p, (const u16*)(ws + WS_H), (const u16*)(ws + WS_WT_MLA_OUT), smem);
  else if constexpr (PH == 7) norm_phase(p, 1, false);
  else if constexpr (PH == 8) s5_g1(p, smem);
  else if constexpr (PH == 9) s5_scan(p, smem);
  else if constexpr (PH == 10) s5_combine(p);
  else if constexpr (PH == 11) s5_g2(p, smem);
  else if constexpr (PH == 12) gemm_out(p, (const u16*)(ws + B_Z), (const u16*)(ws + WS_WT_S5_OUT), smem);
  else if constexpr (PH == 13) norm_phase(p, 2, false);
  else if constexpr (PH == 14) gla_g1(p, smem);
  else if constexpr (PH == 15) gla_gate(p, (float*)smem);
  else if constexpr (PH == 16) gla_main(p, smem);
  else if constexpr (PH == 17) gla_norm(p);
  else if constexpr (PH == 18) gemm_out(p, (const u16*)(ws + WS_H), (const u16*)(ws + WS_WT_GLA_OUT), smem);
  else if constexpr (PH == 19) norm_phase(p, 3, false);
  else if constexpr (PH == 20) mla_g1(p, 1, smem);
  else if constexpr (PH == 21) mla_a2(p, 1);
  else if constexpr (PH == 22) mla_g2(p, 1, smem);
  else if constexpr (PH == 23) mla_attn(p, smem);
  else if constexpr (PH == 24) gemm_out(p, (const u16*)(ws + WS_H), (const u16*)(ws + WS_WT_MLA_OUT) + (size_t)2048 * 2048, smem);
  else if constexpr (PH == 25) norm_phase(p, 4, false);
}

template <int PH>
DI void run_from(const Params& p, char* smem, const XcdBarrier& xb) {
  run_phase<PH>(p, smem);
  if constexpr ((DUPMASK >> PH) & 1u) { __syncthreads(); run_phase<PH>(p, smem); }
  if constexpr (PH + 1 < NPHASE) { xcd_barrier(xb); run_from<PH + 1>(p, smem, xb); }
}

#if COOP
__global__ void __launch_bounds__(256, 2) mega(Params p) {
  __shared__ __attribute__((aligned(16))) char smem[73728];
  __shared__ uint4 xb_words;
  cg::grid_group grid = cg::this_grid();
  if (p.out == nullptr) grid.sync();
  if (threadIdx.x == 0) xb_words = make_uint4(0u, 0u, 0u, 0u);
  __syncthreads();
  const XcdBarrier xb = xcd_barrier_post((unsigned*)(p.ws + WS_BAR), (volatile LAS unsigned*)&xb_words);
  run_from<0>(p, smem, xb);
}
#else
template <int PH>
__global__ void __launch_bounds__(256, 2) phase_k(Params p) {
  __shared__ __attribute__((aligned(16))) char smem[73728];
  run_phase<PH>(p, smem);
}
template <int PH>
static void launch_from(const Params& p, int grid, hipStream_t stream) {
  hipLaunchKernelGGL(phase_k<PH>, dim3(grid), dim3(256), 0, stream, p);
  if constexpr (PH + 1 < NPHASE) launch_from<PH + 1>(p, grid, stream);
}
#endif

extern "C" void kernel_launch(void* const* d_in, const int* in_sizes, int n_in, void* d_out, int out_size, void* d_ws, size_t ws_size, hipStream_t stream) {
  static int grid_blocks = 0;
  if (!grid_blocks) {
    int dev = 0, cus = 0, per_cu = 0;
    (void)hipGetDevice(&dev);
    (void)hipDeviceGetAttribute(&cus, hipDeviceAttributeMultiprocessorCount, dev);
#if COOP
    (void)hipOccupancyMaxActiveBlocksPerMultiprocessor(&per_cu, mega, 256, 0);
#else
    per_cu = 2;
#endif
    if (per_cu < 1) per_cu = 1;
    if (per_cu > 2) per_cu = 2;
    grid_blocks = cus * per_cu;
  }
  Params p{};
  const float** pp = (const float**)&p;
  for (int i = 0; i < 33; ++i) pp[i] = (const float*)d_in[i];
  p.out = (float*)d_out;
  p.ws = (char*)d_ws;
#if COOP
  (void)hipMemsetAsync(d_ws, 0, XCD_BAR_WORDS * 4, stream);
  void* args[] = {&p};
  hipError_t e = hipLaunchCooperativeKernel((void*)mega, dim3(grid_blocks), dim3(256), args, 0, stream);
  if (e != hipSuccess) fprintf(stderr, "cooperative launch failed: %s (grid %d)\n", hipGetErrorString(e), grid_blocks);
#else
  launch_from<0>(p, grid_blocks, stream);
#endif
}
```

```cpp
#include <hip/hip_runtime.h>
#include <hip/hip_cooperative_groups.h>
#include <stdint.h>
#include <cstdio>
namespace cg = cooperative_groups;

#ifndef COOP
#define COOP 1
#endif

typedef unsigned short u16;
typedef short bf16x8 __attribute__((ext_vector_type(8)));
typedef short s16x4 __attribute__((ext_vector_type(4)));
typedef float f32x16 __attribute__((ext_vector_type(16)));
typedef float f32x4 __attribute__((ext_vector_type(4)));
typedef float f32x2 __attribute__((ext_vector_type(2)));
typedef unsigned u32x4 __attribute__((ext_vector_type(4)));
typedef unsigned u32x2 __attribute__((ext_vector_type(2)));
typedef __bf16 bfv2 __attribute__((ext_vector_type(2)));
#define DI __device__ __forceinline__
#define MFMA32(a, b, c) __builtin_amdgcn_mfma_f32_32x32x16_bf16((a), (b), (c), 0, 0, 0)

constexpr int D = 2048, NTOK = 12288, NCTX = 4096;
constexpr float EPS = 1e-6f;
constexpr int LDH = 2112, LDW = 2112, LDC = 576, LDKB = 3136, LDQ = 1088;
constexpr size_t OUT_CKV = 25165824, OUT_KROPE = 29360128, OUT_S5 = 29884416, OUT_GLA = 30408704;
constexpr size_t WS_BAR = 0;
constexpr size_t WS_WT_MLA_IN = 16384;
constexpr size_t WS_WT_MLA_UKV = WS_WT_MLA_IN + 2ull * 5760 * LDW * 2;
constexpr size_t WS_WT_MLA_OUT = WS_WT_MLA_UKV + 2ull * 4096 * LDC * 2;
constexpr size_t WS_WT_S5_IN = WS_WT_MLA_OUT + 2ull * 2048 * LDW * 2;
constexpr size_t WS_WT_S5_GLU = WS_WT_S5_IN + 4096ull * LDW * 2;
constexpr size_t WS_WT_S5_OUT = WS_WT_S5_GLU + 2048ull * LDW * 2;
constexpr size_t WS_WT_GLA_IN = WS_WT_S5_OUT + 2048ull * LDW * 2;
constexpr size_t WS_WT_GLA_OUT = WS_WT_GLA_IN + 6272ull * LDW * 2;
constexpr size_t WS_MOD = WS_WT_GLA_OUT + 2048ull * LDW * 2;
constexpr size_t WS_H = WS_MOD + 4ull * 9 * 6144 * 4;
constexpr size_t WS_OP = WS_H + 12288ull * LDH * 2;
constexpr size_t WS_SCR = WS_OP + 12288ull * 2048 * 4;
constexpr size_t A_QB = WS_SCR;
constexpr size_t A_CKVRAW = A_QB + 12288ull * 3072 * 2;
constexpr size_t A_CKVALL = A_CKVRAW + 12288ull * 512 * 4;
constexpr size_t A_SGATE = A_CKVALL + 14336ull * LDC * 2;
constexpr size_t A_KB = A_SGATE + 12288ull * 2048 * 2;
constexpr size_t A_VT = A_KB + 14336ull * LDKB * 2;
constexpr size_t B_U = WS_SCR;
constexpr size_t B_SGATE = B_U + 12288ull * 2048 * 4;
constexpr size_t B_YB = B_SGATE + 12288ull * 2048 * 2;
constexpr size_t B_Z = B_YB + 12288ull * 2048 * 4;
constexpr size_t C_QG = WS_SCR;
constexpr size_t C_KG = C_QG + 12288ull * 1024 * 2;
constexpr size_t C_VT = C_KG + 12288ull * 1024 * 2;
constexpr size_t C_SGATE = C_VT + 12288ull * 2048 * 2;
constexpr size_t C_GLR = C_SGATE + 12288ull * 2048 * 2;
constexpr size_t C_QT = C_GLR + 12288ull * 32 * 4;
constexpr size_t C_KT = C_QT + 2ull * 12288 * LDQ * 2;
constexpr size_t C_KDT = C_KT + 2ull * 12288 * LDQ * 2;
constexpr size_t C_DN = C_KDT + 2ull * 12288 * 1024 * 2;
constexpr size_t C_OB = C_DN + 2ull * 192 * 1024 * 4;

struct Params {
  const float *x_prompt, *x_sample, *cache_ckv, *cache_krope, *state_s5, *state_gla, *c, *c_ctx;
  const float *ada_w, *ada_b, *norm_pre, *norm_post;
  const float *mla_w_in, *mla_kv_norm, *mla_w_ukv, *mla_w_out;
  const float *s5_w_in, *s5_a_re, *s5_a_im, *s5_log_dt, *s5_b_re, *s5_b_im, *s5_c_re, *s5_c_im, *s5_d, *s5_w_glu, *s5_b_glu, *s5_w_out;
  const float *gla_w_in, *gla_w_g2, *gla_b_g, *gla_norm, *gla_w_out;
  float* out;
  char* ws;
};

DI unsigned pk2(float a, float b) { f32x2 v; v.x = a; v.y = b; bfv2 r = __builtin_convertvector(v, bfv2); return __builtin_bit_cast(unsigned, r); }
DI u16 f2bf(float a) { return (u16)(pk2(a, 0.f) & 0xffffu); }
DI float bf2f(u16 v) { return __uint_as_float(((unsigned)v) << 16); }
DI float bflo(unsigned v) { return __uint_as_float(v << 16); }
DI float bfhi(unsigned v) { return __uint_as_float(v & 0xffff0000u); }
DI float siluf(float x) { return x / (1.f + __expf(-x)); }
DI float sigmf(float x) { return 1.f / (1.f + __expf(-x)); }
DI f32x4 ld_bf4(const u16* p) { const u32x2 v = *(const u32x2*)p; f32x4 o = {bflo(v.x), bfhi(v.x), bflo(v.y), bfhi(v.y)}; return o; }
DI int crow(int reg, int h) { return (reg & 3) + 8 * (reg >> 2) + 4 * h; }
DI void st_bf4(u16* p, float a, float b, float c, float d) { u32x2 v; v.x = pk2(a, b); v.y = pk2(c, d); *(u32x2*)p = v; }
DI bf16x8 pack8(const f32x16& x, int s) {
  u32x4 p;
  p.x = pk2(x[8 * s + 0], x[8 * s + 1]); p.y = pk2(x[8 * s + 2], x[8 * s + 3]);
  p.z = pk2(x[8 * s + 4], x[8 * s + 5]); p.w = pk2(x[8 * s + 6], x[8 * s + 7]);
  return __builtin_bit_cast(bf16x8, p);
}
DI bf16x8 cat4(s16x4 lo, s16x4 hi) { return __builtin_shufflevector(lo, hi, 0, 1, 2, 3, 4, 5, 6, 7); }
DI float wave_sum(float v) {
#pragma unroll
  for (int o = 32; o >= 1; o >>= 1) v += __shfl_xor(v, o);
  return v;
}
DI int tid_() { int t = threadIdx.x; asm volatile("" : "+v"(t)); return t; }
DI int cond_of(int T) { return T < NCTX ? 8 : ((T - NCTX) >> 10); }
DI int kvrow_of(int T) { return T < NCTX ? T : NCTX + ((T - NCTX) >> 10) * 1280 + ((T - NCTX) & 1023); }

DI void ada_phase(const Params& p, float* smem) {
  const int tid = tid_();
  float* mod = (float*)(p.ws + WS_MOD);
  for (int it = blockIdx.x; it < 384; it += gridDim.x) {
    const int l = it / 96, n0 = (it % 96) * 64;
    __syncthreads();
    for (int i = tid; i < 9 * 2048; i += 256) { const int cd = i >> 11, k = i & 2047; const float v = cd < 8 ? p.c[cd * 2048 + k] : p.c_ctx[k]; smem[i] = siluf(v); }
    __syncthreads();
    const int c4 = tid & 15, ks = tid >> 4;
    const float* w = p.ada_w + (size_t)l * 2048 * 6144 + n0 + c4 * 4;
    float acc[9][4];
#pragma unroll
    for (int cd = 0; cd < 9; ++cd)
#pragma unroll
      for (int e = 0; e < 4; ++e) acc[cd][e] = 0.f;
#pragma unroll 4
    for (int kk = 0; kk < 128; ++kk) {
      const int k = ks * 128 + kk;
      const f32x4 wv = __builtin_nontemporal_load((const f32x4*)(w + (size_t)k * 6144));
#pragma unroll
      for (int cd = 0; cd < 9; ++cd) {
        const float s = smem[cd * 2048 + k];
#pragma unroll
        for (int e = 0; e < 4; ++e) acc[cd][e] += s * wv[e];
      }
    }
    __syncthreads();
#pragma unroll
    for (int cd = 0; cd < 9; ++cd)
#pragma unroll
      for (int e = 0; e < 4; ++e) smem[(ks * 9 + cd) * 64 + c4 * 4 + e] = acc[cd][e];
    __syncthreads();
    for (int o = tid; o < 576; o += 256) {
      const int cd = o >> 6, col = o & 63;
      float s = 0.f;
#pragma unroll
      for (int k2 = 0; k2 < 16; ++k2) s += smem[(k2 * 9 + cd) * 64 + col];
      mod[(size_t)(l * 9 + cd) * 6144 + n0 + col] = s + p.ada_b[l * 6144 + n0 + col];
    }
  }
  __syncthreads();
}

DI void transpose_job(const float* __restrict__ src, u16* __restrict__ dst, int K, int N, int Npad, int ldw, float* tile) {
  const int tid = tid_();
  const int nkt = K / 64, total = nkt * (Npad / 64);
  for (int t = blockIdx.x; t < total; t += gridDim.x) {
    const int k0 = (t % nkt) * 64, n0 = (t / nkt) * 64;
    const int c = tid & 63, r0 = tid >> 6;
#pragma unroll
    for (int i = 0; i < 16; ++i) { const int r = r0 + 4 * i; tile[r * 65 + c] = (n0 + c < N) ? src[(size_t)(k0 + r) * N + n0 + c] : 0.f; }
    __syncthreads();
    const int n = tid >> 2, ks = (tid & 3) * 16;
    u32x4 v0, v1;
    v0.x = pk2(tile[(ks + 0) * 65 + n], tile[(ks + 1) * 65 + n]); v0.y = pk2(tile[(ks + 2) * 65 + n], tile[(ks + 3) * 65 + n]);
    v0.z = pk2(tile[(ks + 4) * 65 + n], tile[(ks + 5) * 65 + n]); v0.w = pk2(tile[(ks + 6) * 65 + n], tile[(ks + 7) * 65 + n]);
    v1.x = pk2(tile[(ks + 8) * 65 + n], tile[(ks + 9) * 65 + n]); v1.y = pk2(tile[(ks + 10) * 65 + n], tile[(ks + 11) * 65 + n]);
    v1.z = pk2(tile[(ks + 12) * 65 + n], tile[(ks + 13) * 65 + n]); v1.w = pk2(tile[(ks + 14) * 65 + n], tile[(ks + 15) * 65 + n]);
    u16* d = dst + (size_t)(n0 + n) * ldw + k0 + ks;
    *(u32x4*)d = v0; *(u32x4*)(d + 8) = v1;
    __syncthreads();
  }
}

DI void phase0(const Params& p, char* smem) {
  ada_phase(p, (float*)smem);
  float* tile = (float*)smem;
  char* ws = p.ws;
  for (int j = 0; j < 2; ++j) {
    transpose_job(p.mla_w_in + (size_t)j * 2048 * 5696, (u16*)(ws + WS_WT_MLA_IN) + (size_t)j * 5760 * LDW, 2048, 5696, 5760, LDW, tile);
    transpose_job(p.mla_w_ukv + (size_t)j * 512 * 4096, (u16*)(ws + WS_WT_MLA_UKV) + (size_t)j * 4096 * LDC, 512, 4096, 4096, LDC, tile);
    transpose_job(p.mla_w_out + (size_t)j * 2048 * 2048, (u16*)(ws + WS_WT_MLA_OUT) + (size_t)j * 2048 * LDW, 2048, 2048, 2048, LDW, tile);
  }
  transpose_job(p.s5_w_in, (u16*)(ws + WS_WT_S5_IN), 2048, 4096, 4096, LDW, tile);
  transpose_job(p.s5_w_glu, (u16*)(ws + WS_WT_S5_GLU), 2048, 2048, 2048, LDW, tile);
  transpose_job(p.s5_w_out, (u16*)(ws + WS_WT_S5_OUT), 2048, 2048, 2048, LDW, tile);
  transpose_job(p.gla_w_in, (u16*)(ws + WS_WT_GLA_IN), 2048, 6176, 6272, LDW, tile);
  transpose_job(p.gla_w_out, (u16*)(ws + WS_WT_GLA_OUT), 2048, 2048, 2048, LDW, tile);
}

DI void norm_phase(const Params& p, int l, bool first) {
  const int lane = tid_() & 63, wv = tid_() >> 6;
  const float* mod = (const float*)(p.ws + WS_MOD);
  const u16* OP = (const u16*)(p.ws + WS_OP);
  u16* H = (u16*)(p.ws + WS_H);
  for (int T = blockIdx.x * 4 + wv; T < NTOK; T += gridDim.x * 4) {
    const int cd = cond_of(T);
    const float* xin = T < NCTX ? p.x_prompt + (size_t)T * D : p.x_sample + (size_t)(T - NCTX) * D;
    float* xrow = p.out + (size_t)T * D;
    f32x4 x[8];
    if (first) {
#pragma unroll
      for (int j = 0; j < 8; ++j) x[j] = *(const f32x4*)(xin + (j * 64 + lane) * 4);
    } else {
      const float* xold = (l == 1) ? xin : xrow;
      const u16* op = OP + (size_t)T * D;
      f32x4 o[8];
      float ss = 0.f;
#pragma unroll
      for (int j = 0; j < 8; ++j) { o[j] = ld_bf4(op + (j * 64 + lane) * 4); ss += o[j][0] * o[j][0] + o[j][1] * o[j][1] + o[j][2] * o[j][2] + o[j][3] * o[j][3]; }
      ss = wave_sum(ss);
      const float rstd = rsqrtf(ss * (1.f / D) + EPS);
      const float* npost = p.norm_post + (l - 1) * D;
      const float* gate = mod + (size_t)((l - 1) * 9 + cd) * 6144 + 4096;
#pragma unroll
      for (int j = 0; j < 8; ++j) {
        const int col = (j * 64 + lane) * 4;
        const f32x4 xo = *(const f32x4*)(xold + col), np = *(const f32x4*)(npost + col), g = *(const f32x4*)(gate + col);
        x[j] = xo + g * (o[j] * rstd * np);
        *(f32x4*)(xrow + col) = x[j];
      }
    }
    if (l < 4) {
      float ss = 0.f;
#pragma unroll
      for (int j = 0; j < 8; ++j) ss += x[j][0] * x[j][0] + x[j][1] * x[j][1] + x[j][2] * x[j][2] + x[j][3] * x[j][3];
      ss = wave_sum(ss);
      const float rstd = rsqrtf(ss * (1.f / D) + EPS);
      const float* npre = p.norm_pre + l * D;
      const float* sh = mod + (size_t)(l * 9 + cd) * 6144;
      u16* hrow = H + (size_t)T * LDH;
#pragma unroll
      for (int j = 0; j < 8; ++j) {
        const int col = (j * 64 + lane) * 4;
        const f32x4 np = *(const f32x4*)(npre + col), s1 = *(const f32x4*)(sh + col), sc = *(const f32x4*)(sh + 2048 + col);
        const f32x4 hv = x[j] * rstd * np * (1.f + sc) + s1;
        st_bf4(hrow + col, hv[0], hv[1], hv[2], hv[3]);
      }
    }
  }
}

template <bool SWAP, class Epi>
DI void gemm_tile(const int w, const u16* __restrict__ A, int lda, const u16* __restrict__ Bt, int ldb, int K, int m0, int n0, const Epi& epi, char* smem) {
  u16* As = (u16*)smem;
  u16* Bs = As + 256 * 72;
  const int tid = tid_(), lane = tid & 63, r = lane & 31, h = lane >> 5;
  const int wm = w >> 1, wn = w & 1;
  const int lrow = tid >> 3, lseg = tid & 7;
  const __amdgpu_buffer_rsrc_t Ars = __builtin_amdgcn_make_buffer_rsrc((void*)(A + (size_t)m0 * lda), 0, 0x7fffffff, 0x00020000);
  const __amdgpu_buffer_rsrc_t Brs = __builtin_amdgcn_make_buffer_rsrc((void*)(Bt + (size_t)n0 * ldb), 0, 0x7fffffff, 0x00020000);
  const int aoff = (lrow * lda + lseg * 8) * 2, boff = (lrow * ldb + lseg * 8) * 2;
  u32x4 ra[8], rb[4];
  f32x16 acc[4][2];
#pragma unroll
  for (int i = 0; i < 4; ++i)
#pragma unroll
    for (int j = 0; j < 2; ++j)
#pragma unroll
      for (int e = 0; e < 16; ++e) acc[i][j][e] = 0.f;
#define GT_GL(K0) { _Pragma("unroll") for (int q = 0; q < 8; ++q) ra[q] = __builtin_bit_cast(u32x4, __builtin_amdgcn_raw_buffer_load_b128(Ars, aoff, (32 * q * lda + (K0)) * 2, 0)); \
                    _Pragma("unroll") for (int q = 0; q < 4; ++q) rb[q] = __builtin_bit_cast(u32x4, __builtin_amdgcn_raw_buffer_load_b128(Brs, boff, (32 * q * ldb + (K0)) * 2, 0)); }
#define GT_LS() { _Pragma("unroll") for (int q = 0; q < 8; ++q) *(u32x4*)(As + (lrow + 32 * q) * 72 + lseg * 8) = ra[q]; \
                  _Pragma("unroll") for (int q = 0; q < 4; ++q) *(u32x4*)(Bs + (lrow + 32 * q) * 72 + lseg * 8) = rb[q]; }
  const int nk = K >> 6;
  GT_GL(0);
  __syncthreads();
  GT_LS();
  __syncthreads();
  const u16* as = As + (wm * 128 + r) * 72 + h * 8;
  const u16* bs = Bs + (wn * 64 + r) * 72 + h * 8;
  for (int kt = 0; kt < nk; ++kt) {
    { const int k1 = (kt + 1 < nk ? kt + 1 : kt) << 6; GT_GL(k1); }
    __builtin_amdgcn_sched_barrier(0);
#pragma unroll
    for (int ks = 0; ks < 4; ++ks) {
      bf16x8 b[2];
#pragma unroll
      for (int j = 0; j < 2; ++j) b[j] = *(const bf16x8*)(bs + j * 32 * 72 + ks * 16);
#pragma unroll
      for (int i = 0; i < 4; ++i) {
        const bf16x8 a = *(const bf16x8*)(as + i * 32 * 72 + ks * 16);
#pragma unroll
        for (int j = 0; j < 2; ++j) acc[i][j] = SWAP ? MFMA32(b[j], a, acc[i][j]) : MFMA32(a, b[j], acc[i][j]);
      }
    }
    __syncthreads();
    GT_LS();
    __syncthreads();
  }
#undef GT_GL
#undef GT_LS
  int lane2;
  asm volatile("v_mbcnt_lo_u32_b32 %0, -1, 0\n\tv_mbcnt_hi_u32_b32 %0, -1, %0" : "=v"(lane2));
  const int r2 = lane2 & 31, h2 = lane2 >> 5;
#pragma unroll
  for (int i = 0; i < 4; ++i)
#pragma unroll
    for (int j = 0; j < 2; ++j) epi(m0 + wm * 128 + i * 32, n0 + wn * 64 + j * 32, acc[i][j], r2, h2);
}

template <class F>
DI void for_tiles(int MT, int NT, const F& f) {
  const int G = gridDim.x;
  if ((G & 7) == 0 && (MT & 7) == 0) {
    const int G8 = G >> 3, xcd = blockIdx.x & 7, loc = blockIdx.x >> 3;
    const int SM = MT >> 3, SN = (NT + 7) >> 3, total = SM * SN * 64;
    for (int i = 0;; ++i) {
      const int u = (i * 8 + xcd) * G8 + loc;
      if (u >= total) break;
      const int sup = u >> 6, win = u & 63;
      const int mt = (sup % SM) * 8 + (win & 7), nt = (sup / SM) * 8 + (win >> 3);
      if (nt < NT) f(mt, nt);
    }
  } else {
    for (int t = blockIdx.x; t < MT * NT; t += G) f(t % MT, t / MT);
  }
}

DI void rope16(f32x16& v, int pos, int h) {
#pragma unroll
  for (int g = 0; g < 2; ++g)
#pragma unroll
    for (int e = 0; e < 4; ++e) {
      const int f = 8 * g + 4 * h + e;
      const float invf = exp2f(-(float)f * 0.83048202372184058696f);
      const float rev = ((float)pos * invf) * 0.15915494309189533577f;
      const float sn = __builtin_amdgcn_sinf(rev), cs = __builtin_amdgcn_cosf(rev);
      const float x1 = v[4 * g + e], x2 = v[4 * (g + 2) + e];
      v[4 * g + e] = x1 * cs - x2 * sn;
      v[4 * (g + 2) + e] = x1 * sn + x2 * cs;
    }
}

DI void mla_g1(const Params& p, int j, char* smem) {
  char* ws = p.ws;
  const u16* H = (const u16*)(ws + WS_H);
  const u16* Wt = (const u16*)(ws + WS_WT_MLA_IN) + (size_t)j * 5760 * LDW;
  auto epi = [&](int tm, int tn, const f32x16& acc, int r, int h) {
    char* ws2 = p.ws;
    u16* QB = (u16*)(ws2 + A_QB); float* CKVRAW = (float*)(ws2 + A_CKVRAW); u16* SG = (u16*)(ws2 + A_SGATE); u16* KB = (u16*)(ws2 + A_KB);
    float* okr = p.out + OUT_KROPE;
    const int m = tm + r;
    if (tn < 3072) {
      const int within = tn % 192;
      f32x16 v = acc;
      if (within >= 128 && m >= NCTX) { const int tl = (m - NCTX) & 1023; rope16(v, within < 160 ? (tl >> 6) : (tl & 63), h); }
#pragma unroll
      for (int g = 0; g < 4; ++g) st_bf4(QB + (size_t)m * 3072 + tn + 8 * g + 4 * h, v[4 * g], v[4 * g + 1], v[4 * g + 2], v[4 * g + 3]);
    } else if (tn < 3584) {
#pragma unroll
      for (int g = 0; g < 4; ++g) { f32x4 o = {acc[4 * g], acc[4 * g + 1], acc[4 * g + 2], acc[4 * g + 3]}; *(f32x4*)(CKVRAW + (size_t)m * 512 + (tn - 3072) + 8 * g + 4 * h) = o; }
    } else if (tn < 3648) {
      f32x16 v = acc;
      const int c0 = tn - 3584;
      if (m >= NCTX) { const int tl = (m - NCTX) & 1023; rope16(v, c0 == 0 ? (tl >> 6) : (tl & 63), h); }
      else {
        const int b = m >> 8, t = m & 255;
#pragma unroll
        for (int g = 0; g < 4; ++g) { f32x4 o = {v[4 * g], v[4 * g + 1], v[4 * g + 2], v[4 * g + 3]}; *(f32x4*)(okr + ((size_t)(b * 2 + j) * 256 + t) * 64 + c0 + 8 * g + 4 * h) = o; }
      }
      const size_t R = kvrow_of(m);
      for (int hd = 0; hd < 16; ++hd)
#pragma unroll
        for (int g = 0; g < 4; ++g) st_bf4(KB + R * LDKB + hd * 192 + 128 + c0 + 8 * g + 4 * h, v[4 * g], v[4 * g + 1], v[4 * g + 2], v[4 * g + 3]);
    } else if (tn < 5696) {
#pragma unroll
      for (int g = 0; g < 4; ++g) st_bf4(SG + (size_t)m * 2048 + (tn - 3648) + 8 * g + 4 * h, siluf(acc[4 * g]), siluf(acc[4 * g + 1]), siluf(acc[4 * g + 2]), siluf(acc[4 * g + 3]));
    }
  };
  const int wv_ = __builtin_amdgcn_readfirstlane(tid_() >> 6);
  for_tiles(48, 45, [&](int mt, int nt) { gemm_tile<true>(wv_, H, LDH, Wt, LDW, 2048, mt * 256, nt * 128, epi, smem); });
}

DI void mla_a2(const Params& p, int j) {
  char* ws = p.ws;
  const int lane = tid_() & 63, wv = tid_() >> 6;
  const float* CKVRAW = (const float*)(ws + A_CKVRAW); u16* CKVALL = (u16*)(ws + A_CKVALL); u16* KB = (u16*)(ws + A_KB);
  const float* kvn = p.mla_kv_norm + j * 512;
  float* ockv = p.out + OUT_CKV;
  for (int R = blockIdx.x * 4 + wv; R < 14336; R += gridDim.x * 4) {
    int T = -1, cb = 0, ct = 0;
    if (R < NCTX) T = R;
    else { const int r2 = R - NCTX; cb = r2 / 1280; const int tp = r2 - cb * 1280; if (tp < 1024) T = NCTX + cb * 1024 + tp; else ct = tp - 1024; }
    u16* dst = CKVALL + (size_t)R * LDC;
    if (T >= 0) {
      const float* src = CKVRAW + (size_t)T * 512;
      const f32x4 a = *(const f32x4*)(src + lane * 4), b = *(const f32x4*)(src + 256 + lane * 4);
      float ss = a[0] * a[0] + a[1] * a[1] + a[2] * a[2] + a[3] * a[3] + b[0] * b[0] + b[1] * b[1] + b[2] * b[2] + b[3] * b[3];
      ss = wave_sum(ss);
      const float rstd = rsqrtf(ss * (1.f / 512.f) + EPS);
      const f32x4 g0 = *(const f32x4*)(kvn + lane * 4), g1 = *(const f32x4*)(kvn + 256 + lane * 4);
      const f32x4 y0 = a * rstd * g0, y1 = b * rstd * g1;
      st_bf4(dst + lane * 4, y0[0], y0[1], y0[2], y0[3]);
      st_bf4(dst + 256 + lane * 4, y1[0], y1[1], y1[2], y1[3]);
      if (T < NCTX) {
        float* o = ockv + ((size_t)((T >> 8) * 2 + j) * 256 + (T & 255)) * 512;
        *(f32x4*)(o + lane * 4) = y0; *(f32x4*)(o + 256 + lane * 4) = y1;
      }
    } else {
      const float* src = p.cache_ckv + ((size_t)(cb * 2 + j) * 256 + ct) * 512;
      const f32x4 a = *(const f32x4*)(src + lane * 4), b = *(const f32x4*)(src + 256 + lane * 4);
      st_bf4(dst + lane * 4, a[0], a[1], a[2], a[3]);
      st_bf4(dst + 256 + lane * 4, b[0], b[1], b[2], b[3]);
      const float kr = p.cache_krope[((size_t)(cb * 2 + j) * 256 + ct) * 64 + lane];
      const u16 kb = f2bf(kr);
      for (int hd = 0; hd < 16; ++hd) KB[(size_t)R * LDKB + hd * 192 + 128 + lane] = kb;
    }
  }
}

DI void mla_g2(const Params& p, int j, char* smem) {
  char* ws = p.ws;
  const u16* CKVALL = (const u16*)(ws + A_CKVALL);
  const u16* Wt = (const u16*)(ws + WS_WT_MLA_UKV) + (size_t)j * 4096 * LDC;
  u16* KB = (u16*)(ws + A_KB); u16* VT = (u16*)(ws + A_VT);
  auto epiK = [&](int tm, int tn, const f32x16& acc, int r, int h) {
    const size_t R = tm + r; const int hd = tn >> 8, wi = tn & 255;
#pragma unroll
    for (int g = 0; g < 4; ++g) st_bf4(KB + R * LDKB + hd * 192 + wi + 8 * g + 4 * h, acc[4 * g], acc[4 * g + 1], acc[4 * g + 2], acc[4 * g + 3]);
  };
  auto epiV = [&](int tm, int tn, const f32x16& acc, int r, int h) {
    const int n = tn + r; const int hd = n >> 8, d = (n & 255) - 128;
    size_t base; int nkeys, key0;
    if (tm < NCTX) { base = (size_t)(tm >> 8) * 256 * 2048; nkeys = 256; key0 = tm & 255; }
    else { const int r2 = tm - NCTX; const int b = r2 / 1280; base = (size_t)NCTX * 2048 + (size_t)b * 1280 * 2048; nkeys = 1280; key0 = r2 - b * 1280; }
    u16* dst = VT + base + (size_t)(hd * 128 + d) * nkeys + key0;
#pragma unroll
    for (int g = 0; g < 4; ++g) st_bf4(dst + 8 * g + 4 * h, acc[4 * g], acc[4 * g + 1], acc[4 * g + 2], acc[4 * g + 3]);
  };
  const int wv_ = __builtin_amdgcn_readfirstlane(tid_() >> 6);
  for_tiles(56, 32, [&](int mt, int nt) {
    if ((nt & 1) == 0) gemm_tile<true>(wv_, CKVALL, LDC, Wt, LDC, 512, mt * 256, nt * 128, epiK, smem);
    else gemm_tile<false>(wv_, CKVALL, LDC, Wt, LDC, 512, mt * 256, nt * 128, epiV, smem);
  });
}

DI void mla_attn(const Params& p, char* smem) {
  char* ws = p.ws;
  const u16* QB = (const u16*)(ws + A_QB); const u16* KB = (const u16*)(ws + A_KB); const u16* VT = (const u16*)(ws + A_VT); const u16* SG = (const u16*)(ws + A_SGATE);
  u16* OG = (u16*)(ws + WS_H);
  char* Ks = smem;
  char* Vs = smem + 25600;
  const int tid = tid_();
  const int lane = tid & 63, w = tid >> 6, r = lane & 31, h = lane >> 5;
  const float SC = 0.07216878364870322f * 1.4426950408889634f;
  for (int it = blockIdx.x; it < 1536; it += gridDim.x) {
    int head, T0, R0, nkeys; size_t vbase;
    if (it < 1024) { const int b = it >> 7; head = (it >> 3) & 15; T0 = NCTX + b * 1024 + (it & 7) * 128; R0 = NCTX + b * 1280; nkeys = 1280; vbase = (size_t)NCTX * 2048 + (size_t)b * 1280 * 2048; }
    else { const int i2 = it - 1024; const int b = i2 >> 5; head = (i2 >> 1) & 15; T0 = b * 256 + (i2 & 1) * 128; R0 = b * 256; nkeys = 256; vbase = (size_t)b * 256 * 2048; }
    T0 += w * 32;
    bf16x8 qf[12];
    const u16* qp = QB + (size_t)(T0 + r) * 3072 + head * 192 + 8 * h;
#pragma unroll
    for (int ks = 0; ks < 12; ++ks) qf[ks] = *(const bf16x8*)(qp + ks * 16);
    f32x16 O[4];
#pragma unroll
    for (int dt = 0; dt < 4; ++dt)
#pragma unroll
      for (int e = 0; e < 16; ++e) O[dt][e] = 0.f;
    float mrun = -INFINITY, lrun = 0.f;
    const u16* kg = KB + (size_t)R0 * LDKB + head * 192;
    const u16* vg = VT + vbase + (size_t)(head * 128) * nkeys;
    u32x4 rk[6], rv[4];
    const __amdgpu_buffer_rsrc_t Krs = __builtin_amdgcn_make_buffer_rsrc((void*)kg, 0, 0x7fffffff, 0x00020000);
    const __amdgpu_buffer_rsrc_t Vrs = __builtin_amdgcn_make_buffer_rsrc((void*)vg, 0, 0x7fffffff, 0x00020000);
    const int kvo = (tid >> 2) * (LDKB * 2) + (tid & 3) * 16;
    const int vvo = (tid >> 3) * nkeys * 2 + (tid & 7) * 16;
#define AT_LOAD(KT0) { _Pragma("unroll") for (int i = 0; i < 6; ++i) rk[i] = __builtin_bit_cast(u32x4, __builtin_amdgcn_raw_buffer_load_b128(Krs, kvo + 64 * i, (KT0) * (LDKB * 2), 0)); \
                       _Pragma("unroll") for (int i = 0; i < 4; ++i) rv[i] = __builtin_bit_cast(u32x4, __builtin_amdgcn_raw_buffer_load_b128(Vrs, vvo, (32 * i * nkeys + (KT0)) * 2, 0)); }
#define AT_STORE() { _Pragma("unroll") for (int i = 0; i < 6; ++i) *(u32x4*)(Ks + (tid >> 2) * 400 + ((tid & 3) + 4 * i) * 16) = rk[i]; \
                     _Pragma("unroll") for (int i = 0; i < 4; ++i) { const int sg = tid & 7; char* d = Vs + ((tid >> 3) + 32 * i) * 144 + (sg >> 1) * 32 + (sg & 1) * 8; \
                       u32x2 lo, hi; lo.x = rv[i].x; lo.y = rv[i].y; hi.x = rv[i].z; hi.y = rv[i].w; *(u32x2*)d = lo; *(u32x2*)(d + 16) = hi; } }
    AT_LOAD(0);
    __syncthreads();
    AT_STORE();
    __syncthreads();
    for (int kt0 = 0; kt0 < nkeys; kt0 += 64) {
      { const int kn = kt0 + 64 < nkeys ? kt0 + 64 : kt0; AT_LOAD(kn); }
#pragma unroll
      for (int sub = 0; sub < 2; ++sub) {
        f32x16 S;
#pragma unroll
        for (int e = 0; e < 16; ++e) S[e] = 0.f;
#pragma unroll
        for (int ks = 0; ks < 12; ++ks) { const bf16x8 kf = *(const bf16x8*)(Ks + (sub * 32 + r) * 400 + ks * 32 + h * 16); S = MFMA32(kf, qf[ks], S); }
        float mx = -INFINITY;
#pragma unroll
        for (int e = 0; e < 16; ++e) { S[e] *= SC; mx = fmaxf(mx, S[e]); }
        mx = fmaxf(mx, __shfl_xor(mx, 32));
        const float mnew = fmaxf(mrun, mx);
        const float alpha = __builtin_amdgcn_exp2f(mrun - mnew);
        mrun = mnew;
        float ps = 0.f;
#pragma unroll
        for (int e = 0; e < 16; ++e) { S[e] = __builtin_amdgcn_exp2f(S[e] - mnew); ps += S[e]; }
        lrun = lrun * alpha + ps;
#pragma unroll
        for (int dt = 0; dt < 4; ++dt)
#pragma unroll
          for (int e = 0; e < 16; ++e) O[dt][e] *= alpha;
#pragma unroll
        for (int s = 0; s < 2; ++s) {
          const bf16x8 pf = pack8(S, s);
#pragma unroll
          for (int dt = 0; dt < 4; ++dt) {
            const bf16x8 vf = *(const bf16x8*)(Vs + (dt * 32 + r) * 144 + (sub * 2 + s) * 32 + h * 16);
            O[dt] = MFMA32(vf, pf, O[dt]);
          }
        }
      }
      __syncthreads();
      AT_STORE();
      __syncthreads();
    }
#undef AT_LOAD
#undef AT_STORE
    lrun += __shfl_xor(lrun, 32);
    const float inv = 1.f / lrun;
#pragma unroll
    for (int dt = 0; dt < 4; ++dt)
#pragma unroll
      for (int g = 0; g < 4; ++g) {
        const size_t o = (size_t)(T0 + r) * 2048 + head * 128 + dt * 32 + 8 * g + 4 * h;
        const size_t oo = (size_t)(T0 + r) * LDH + head * 128 + dt * 32 + 8 * g + 4 * h;
        const u32x2 sg = *(const u32x2*)(SG + o);
        st_bf4(OG + oo, O[dt][4 * g] * inv * bflo(sg.x), O[dt][4 * g + 1] * inv * bfhi(sg.x), O[dt][4 * g + 2] * inv * bflo(sg.y), O[dt][4 * g + 3] * inv * bfhi(sg.y));
      }
  }
}

DI void gemm_out(const Params& p, const u16* A, const u16* Wt, char* smem) {
  u16* OP = (u16*)(p.ws + WS_OP);
  auto epi = [&](int tm, int tn, const f32x16& acc, int r, int h) {
    const size_t m = tm + r;
#pragma unroll
    for (int g = 0; g < 4; ++g) st_bf4(OP + m * 2048 + tn + 8 * g + 4 * h, acc[4 * g], acc[4 * g + 1], acc[4 * g + 2], acc[4 * g + 3]);
  };
  const int wv_ = __builtin_amdgcn_readfirstlane(tid_() >> 6);
  for_tiles(48, 16, [&](int mt, int nt) { gemm_tile<true>(wv_, A, LDH, Wt, LDW, 2048, mt * 256, nt * 128, epi, smem); });
}

DI void s5_g1(const Params& p, char* smem) {
  char* ws = p.ws;
  const u16* H = (const u16*)(ws + WS_H); const u16* Wt = (const u16*)(ws + WS_WT_S5_IN);
  u16* U = (u16*)(ws + B_U); u16* SG = (u16*)(ws + B_SGATE);
  auto epi = [&](int tm, int tn, const f32x16& acc, int r, int h) {
    const size_t m = tm + r;
    if (tn < 2048) {
#pragma unroll
      for (int g = 0; g < 4; ++g) st_bf4(U + m * 2048 + tn + 8 * g + 4 * h, acc[4 * g], acc[4 * g + 1], acc[4 * g + 2], acc[4 * g + 3]);
    } else {
#pragma unroll
      for (int g = 0; g < 4; ++g) st_bf4(SG + m * 2048 + (tn - 2048) + 8 * g + 4 * h, siluf(acc[4 * g]), siluf(acc[4 * g + 1]), siluf(acc[4 * g + 2]), siluf(acc[4 * g + 3]));
    }
  };
  const int wv_ = __builtin_amdgcn_readfirstlane(tid_() >> 6);
  for_tiles(48, 32, [&](int mt, int nt) { gemm_tile<true>(wv_, H, LDH, Wt, LDW, 2048, mt * 256, nt * 128, epi, smem); });
}

DI void s5_scan(const Params& p, char* smem) {
  char* ws = p.ws;
  const u16* U = (const u16*)(ws + B_U);
  u16* YF = (u16*)(ws + WS_OP); u16* YB = (u16*)(ws + B_YB);
  const int tid = tid_();
  const int lane = tid & 63;
  const int w = __builtin_amdgcn_readfirstlane(tid >> 6);
  char* Hs = smem + w * 12800;
  char* BUs = Hs + 4352;
  const int pcol = lane & 15, quad = lane >> 4;
  for (int it = blockIdx.x * 4 + w; it < 6144; it += gridDim.x * 4) {
    const int dir = it & 1; int rest = it >> 1;
    const bool lat = rest < 1024;
    int b, g, L, T0;
    if (lat) { b = rest >> 7; g = rest & 127; L = 1024; T0 = NCTX + b * 1024; }
    else { rest -= 1024; b = rest >> 7; g = rest & 127; L = 256; T0 = b * 256; }
    const int n = lane;
    const int pidx = (dir * 128 + g) * 64 + n;
    const float are = p.s5_a_re[pidx], aim = p.s5_a_im[pidx];
    const float dt = __expf(p.s5_log_dt[dir * 128 + g]);
    const float mag = __expf(are * dt), rev = (aim * dt) * 0.15915494309189533577f;
    const float abr = mag * __builtin_amdgcn_cosf(rev), abi = mag * __builtin_amdgcn_sinf(rev);
    const float nr = abr - 1.f, ni = abi, den = 1.f / (are * are + aim * aim);
    const float cr = (nr * are + ni * aim) * den, ci = (ni * are - nr * aim) * den;
    {
      const float* br = p.s5_b_re + (size_t)pidx * 16; const float* bi = p.s5_b_im + (size_t)pidx * 16;
      u32x4 re0, re1, im0, im1;
      {
        const f32x4 x0 = *(const f32x4*)(br), x1 = *(const f32x4*)(br + 4), x2 = *(const f32x4*)(br + 8), x3 = *(const f32x4*)(br + 12);
        const f32x4 y0 = *(const f32x4*)(bi), y1 = *(const f32x4*)(bi + 4), y2 = *(const f32x4*)(bi + 8), y3 = *(const f32x4*)(bi + 12);
        const f32x4 r0 = cr * x0 - ci * y0, r1 = cr * x1 - ci * y1, r2 = cr * x2 - ci * y2, r3 = cr * x3 - ci * y3;
        const f32x4 i0 = cr * y0 + ci * x0, i1 = cr * y1 + ci * x1, i2 = cr * y2 + ci * x2, i3 = cr * y3 + ci * x3;
        re0.x = pk2(r0[0], r0[1]); re0.y = pk2(r0[2], r0[3]); re0.z = pk2(r1[0], r1[1]); re0.w = pk2(r1[2], r1[3]);
        re1.x = pk2(r2[0], r2[1]); re1.y = pk2(r2[2], r2[3]); re1.z = pk2(r3[0], r3[1]); re1.w = pk2(r3[2], r3[3]);
        im0.x = pk2(i0[0], i0[1]); im0.y = pk2(i0[2], i0[3]); im0.z = pk2(i1[0], i1[1]); im0.w = pk2(i1[2], i1[3]);
        im1.x = pk2(i2[0], i2[1]); im1.y = pk2(i2[2], i2[3]); im1.z = pk2(i3[0], i3[1]); im1.w = pk2(i3[2], i3[3]);
      }
      char* d = BUs + n * 64;
      *(u32x4*)(d) = re0; *(u32x4*)(d + 16) = re1; *(u32x4*)(d + 32) = im0; *(u32x4*)(d + 48) = im1;
    }
    bf16x8 bfr[8];
#pragma unroll
    for (int nt = 0; nt < 8; ++nt) {
      u32x4 v = {0u, 0u, 0u, 0u};
      if (quad < 2) v = *(const u32x4*)(BUs + (16 * nt + pcol) * 32 + quad * 16);
      bfr[nt] = __builtin_bit_cast(bf16x8, v);
    }
    bf16x8 cf[4];
    {
      const float* c1 = p.s5_c_re + ((size_t)(dir * 128 + g) * 16 + pcol) * 64; const float* c2 = p.s5_c_im + ((size_t)(dir * 128 + g) * 16 + pcol) * 64;
#pragma unroll
      for (int s = 0; s < 4; ++s) {
        const f32x4 x = *(const f32x4*)(c1 + 16 * s + 4 * quad), y = *(const f32x4*)(c2 + 16 * s + 4 * quad);
        u32x4 pk; pk.x = pk2(x[0], -y[0]); pk.y = pk2(x[1], -y[1]); pk.z = pk2(x[2], -y[2]); pk.w = pk2(x[3], -y[3]);
        cf[s] = __builtin_bit_cast(bf16x8, pk);
      }
    }
    float hr = 0.f, hi = 0.f;
    if (lat) { const float* s0 = p.state_s5 + ((size_t)((b * 2 + dir) * 128 + g) * 64 + n) * 2; hr = s0[0]; hi = s0[1]; }
    u16* Y = dir ? YB : YF;
    const int t0 = dir ? L - 1 : 0, tstep = dir ? -1 : 1;
    const u16* ub = U + (size_t)T0 * 2048 + g * 16 + (quad & 1) * 8;
    u32x4 ua = {0u, 0u, 0u, 0u};
    if (quad < 2) ua = *(const u32x4*)(ub + (size_t)(t0 + tstep * pcol) * 2048);
    for (int s0_ = 0; s0_ < L; s0_ += 16) {
      const int tchunk = t0 + tstep * s0_;
      const bf16x8 af = __builtin_bit_cast(bf16x8, ua);
      if (s0_ + 16 < L && quad < 2) ua = *(const u32x4*)(ub + (size_t)(tchunk + tstep * (16 + pcol)) * 2048);
#pragma unroll
      for (int nt = 0; nt < 8; ++nt) {
        f32x4 z = {0.f, 0.f, 0.f, 0.f};
        z = __builtin_amdgcn_mfma_f32_16x16x32_bf16(af, bfr[nt], z, 0, 0, 0);
#pragma unroll
        for (int i = 0; i < 4; ++i) *(float*)(BUs + (4 * quad + i) * 528 + (16 * nt + pcol) * 4) = z[i];
      }
#pragma unroll 4
      for (int row = 0; row < 16; ++row) {
        const f32x2 bu = *(const f32x2*)(BUs + row * 528 + n * 8);
        const float nhr = abr * hr - abi * hi + bu.x, nhi = abr * hi + abi * hr + bu.y;
        hr = nhr; hi = nhi;
        if (!lat && s0_ == 0 && row == 0) { float* so = p.out + OUT_S5 + ((size_t)((b * 2 + dir) * 128 + g) * 64 + n) * 2; so[0] = hr; so[1] = hi; }
        *(unsigned*)(Hs + row * 272 + n * 4) = pk2(hr, hi);
      }
      f32x4 yacc = {0.f, 0.f, 0.f, 0.f};
#pragma unroll
      for (int s = 0; s < 4; ++s) {
        const bf16x8 hf = *(const bf16x8*)(Hs + pcol * 272 + s * 64 + quad * 16);
        yacc = __builtin_amdgcn_mfma_f32_16x16x32_bf16(hf, cf[s], yacc, 0, 0, 0);
      }
#pragma unroll
      for (int i = 0; i < 4; ++i) { const int tok = tchunk + tstep * (4 * quad + i); Y[(size_t)(T0 + tok) * 2048 + g * 16 + pcol] = f2bf(yacc[i]); }
    }
  }
}

DI float gelu_tanh(float x) {
  const float t = 0.7978845608028654f * (x + 0.044715f * x * x * x);
  const float e = __expf(2.f * t);
  const float th = 1.f - 2.f / (e + 1.f);
  return 0.5f * x * (1.f + th);
}

DI void s5_combine(const Params& p) {
  char* ws = p.ws;
  const u16* U = (const u16*)(ws + B_U); const u16* YF = (const u16*)(ws + WS_OP); const u16* YB = (const u16*)(ws + B_YB);
  u16* YG = (u16*)(ws + WS_H);
  const size_t n4 = (size_t)NTOK * 2048 / 4;
  for (size_t i = (size_t)blockIdx.x * 256 + tid_(); i < n4; i += (size_t)gridDim.x * 256) {
    const int col = (int)((i * 4) & 2047);
    const f32x4 u = ld_bf4(U + i * 4), a = ld_bf4(YF + i * 4), b = ld_bf4(YB + i * 4), d = *(const f32x4*)(p.s5_d + col);
    const f32x4 y = d * u + a + b;
    st_bf4(YG + ((i * 4) >> 11) * LDH + col, gelu_tanh(y[0]), gelu_tanh(y[1]), gelu_tanh(y[2]), gelu_tanh(y[3]));
  }
}

DI void s5_g2(const Params& p, char* smem) {
  char* ws = p.ws;
  const u16* YG = (const u16*)(ws + WS_H); const u16* Wt = (const u16*)(ws + WS_WT_S5_GLU); const u16* SG = (const u16*)(ws + B_SGATE);
  u16* Z = (u16*)(ws + B_Z);
  auto epi = [&](int tm, int tn, const f32x16& acc, int r, int h) {
    const size_t m = tm + r;
#pragma unroll
    for (int g = 0; g < 4; ++g) {
      const int n = tn + 8 * g + 4 * h;
      const f32x4 bg = *(const f32x4*)(p.s5_b_glu + n);
      const u32x2 yv = *(const u32x2*)(YG + m * LDH + n), sg = *(const u32x2*)(SG + m * 2048 + n);
      st_bf4(Z + m * LDH + n, bflo(yv.x) * sigmf(acc[4 * g] + bg[0]) * bflo(sg.x), bfhi(yv.x) * sigmf(acc[4 * g + 1] + bg[1]) * bfhi(sg.x),
             bflo(yv.y) * sigmf(acc[4 * g + 2] + bg[2]) * bflo(sg.y), bfhi(yv.y) * sigmf(acc[4 * g + 3] + bg[3]) * bfhi(sg.y));
    }
  };
  const int wv_ = __builtin_amdgcn_readfirstlane(tid_() >> 6);
  for_tiles(48, 16, [&](int mt, int nt) { gemm_tile<true>(wv_, YG, LDH, Wt, LDW, 2048, mt * 256, nt * 128, epi, smem); });
}

DI void gla_g1(const Params& p, char* smem) {
  char* ws = p.ws;
  const u16* H = (const u16*)(ws + WS_H); const u16* Wt = (const u16*)(ws + WS_WT_GLA_IN);
  u16* VT = (u16*)(ws + C_VT);
  auto epi = [&](int tm, int tn, const f32x16& acc, int r, int h) {
    char* ws2 = p.ws;
    u16* QG = (u16*)(ws2 + C_QG); u16* KG = (u16*)(ws2 + C_KG); u16* SG = (u16*)(ws2 + C_SGATE); float* GLR = (float*)(ws2 + C_GLR);
    const size_t m = tm + r;
    if (tn < 1024) {
#pragma unroll
      for (int g = 0; g < 4; ++g) st_bf4(QG + m * 1024 + tn + 8 * g + 4 * h, acc[4 * g] * 0.0625f, acc[4 * g + 1] * 0.0625f, acc[4 * g + 2] * 0.0625f, acc[4 * g + 3] * 0.0625f);
    } else if (tn < 2048) {
#pragma unroll
      for (int g = 0; g < 4; ++g) st_bf4(KG + m * 1024 + (tn - 1024) + 8 * g + 4 * h, acc[4 * g], acc[4 * g + 1], acc[4 * g + 2], acc[4 * g + 3]);
    } else if (tn >= 4096 && tn < 6144) {
#pragma unroll
      for (int g = 0; g < 4; ++g) st_bf4(SG + m * 2048 + (tn - 4096) + 8 * g + 4 * h, siluf(acc[4 * g]), siluf(acc[4 * g + 1]), siluf(acc[4 * g + 2]), siluf(acc[4 * g + 3]));
    } else if (tn == 6144) {
#pragma unroll
      for (int g = 0; g < 4; ++g) { f32x4 o = {acc[4 * g], acc[4 * g + 1], acc[4 * g + 2], acc[4 * g + 3]}; *(f32x4*)(GLR + m * 32 + 8 * g + 4 * h) = o; }
    }
  };
  auto epiV = [&](int tm, int tn, const f32x16& acc, int r, int h) {
    const int dv = tn - 2048 + r;
    u16* dst = VT + ((size_t)(tm >> 6) * 2048 + dv) * 64 + (tm & 63);
#pragma unroll
    for (int g = 0; g < 4; ++g) st_bf4(dst + 8 * g + 4 * h, acc[4 * g], acc[4 * g + 1], acc[4 * g + 2], acc[4 * g + 3]);
  };
  const int wv_ = __builtin_amdgcn_readfirstlane(tid_() >> 6);
  for_tiles(48, 49, [&](int mt, int nt) {
    if (nt >= 16 && nt < 32) gemm_tile<false>(wv_, H, LDH, Wt, LDW, 2048, mt * 256, nt * 128, epiV, smem);
    else gemm_tile<true>(wv_, H, LDH, Wt, LDW, 2048, mt * 256, nt * 128, epi, smem);
  });
}

DI float logsigf(float z) { return fminf(z, 0.f) - __logf(1.f + __expf(-fabsf(z))); }

DI void gla_gate(const Params& p, float* smem) {
  char* ws = p.ws;
  const u16* QG = (const u16*)(ws + C_QG); const u16* KG = (const u16*)(ws + C_KG); const float* GLR = (const float*)(ws + C_GLR);
  u16* QT = (u16*)(ws + C_QT); u16* KT = (u16*)(ws + C_KT); u16* KDT = (u16*)(ws + C_KDT); float* DN = (float*)(ws + C_DN);
  const int tid = tid_();
  for (int it = blockIdx.x; it < 1536; it += gridDim.x) {
    const int dir = it & 1, hd = (it >> 1) & 3, c = it >> 3;
    const int ch = hd * 256 + tid;
    __syncthreads();
    for (int i = tid; i < 1024; i += 256) smem[i] = GLR[(size_t)(c * 64 + (i >> 4)) * 32 + dir * 16 + (i & 15)];
    __syncthreads();
    float wg[16];
#pragma unroll
    for (int q = 0; q < 16; ++q) wg[q] = p.gla_w_g2[(size_t)(dir * 16 + q) * 1024 + ch];
    const float bg = p.gla_b_g[dir * 1024 + ch];
    float tot = 0.f;
    for (int i = 0; i < 64; ++i) {
      float z = bg;
#pragma unroll
      for (int q = 0; q < 16; ++q) z += smem[i * 16 + q] * wg[q];
      tot += logsigf(z) * 0.0625f;
    }
    DN[(size_t)(dir * 192 + c) * 1024 + ch] = __expf(tot);
    float run = 0.f;
    u16* kdrow = KDT + ((size_t)((dir * 192 + c) * 4 + hd) * 256 + tid) * 64;
    for (int i8 = 0; i8 < 8; ++i8) {
      float kdv[8];
#pragma unroll
      for (int e = 0; e < 8; ++e) {
        const int ii = i8 * 8 + e;
        const int i = dir ? 63 - ii : ii;
        float z = bg;
#pragma unroll
        for (int q = 0; q < 16; ++q) z += smem[i * 16 + q] * wg[q];
        run += logsigf(z) * 0.0625f;
        const size_t T = (size_t)c * 64 + i;
        const float q_ = bf2f(QG[T * 1024 + ch]), k_ = bf2f(KG[T * 1024 + ch]);
        QT[((size_t)dir * NTOK + T) * LDQ + ch] = f2bf(q_ * __expf(run));
        KT[((size_t)dir * NTOK + T) * LDQ + ch] = f2bf(k_ * __expf(-run));
        kdv[e] = k_ * __expf(tot - run);
      }
      u32x4 pk;
      if (dir) { pk.x = pk2(kdv[7], kdv[6]); pk.y = pk2(kdv[5], kdv[4]); pk.z = pk2(kdv[3], kdv[2]); pk.w = pk2(kdv[1], kdv[0]); }
      else { pk.x = pk2(kdv[0], kdv[1]); pk.y = pk2(kdv[2], kdv[3]); pk.z = pk2(kdv[4], kdv[5]); pk.w = pk2(kdv[6], kdv[7]); }
      const int tb = dir ? 56 - i8 * 8 : i8 * 8;
      *(u32x4*)(kdrow + tb) = pk;
    }
  }
  __syncthreads();
}

DI void gla_main(const Params& p, char* smem) {
  char* ws = p.ws;
  const u16* QT = (const u16*)(ws + C_QT); const u16* KT = (const u16*)(ws + C_KT); const u16* KDT = (const u16*)(ws + C_KDT); const u16* VT = (const u16*)(ws + C_VT);
  const float* DN = (const float*)(ws + C_DN);
  u16* OF = (u16*)(ws + WS_OP); u16* OB = (u16*)(ws + C_OB);
  char* buf = smem;
  u16* att = (u16*)(smem + 36864);
  float* dns = (float*)(smem + 36864 + 9216);
  const int tid = tid_();
  const int lane = tid & 63, w = tid >> 6, r = lane & 31, h = lane >> 5;
  for (int it = blockIdx.x; it < 768; it += gridDim.x) {
    const bool lat = it < 256;
    const int i2 = lat ? it : it - 256;
    const int bs = i2 >> 5, hd = (i2 >> 3) & 3, dir = (i2 >> 2) & 1, sl = i2 & 3;
    const int nc = lat ? 16 : 4, T0 = lat ? NCTX + bs * 1024 : bs * 256;
    const int vcol0 = hd * 512 + sl * 128 + w * 32;
    f32x16 S[8];
    if (lat) {
      const float* s0 = p.state_gla + ((size_t)((bs * 2 + dir) * 4 + hd) * 256) * 512 + (sl * 128 + w * 32 + r);
#pragma unroll
      for (int mt = 0; mt < 8; ++mt)
#pragma unroll
        for (int e = 0; e < 16; ++e) S[mt][e] = s0[(size_t)(32 * mt + crow(e, h)) * 512];
    } else {
#pragma unroll
      for (int mt = 0; mt < 8; ++mt)
#pragma unroll
        for (int e = 0; e < 16; ++e) S[mt][e] = 0.f;
    }
    u16* OD = dir ? OB : OF;
    for (int cc = 0; cc < nc; ++cc) {
      const int c = dir ? nc - 1 - cc : cc;
      const int Tc = T0 + c * 64, cgx = Tc >> 6;
      const u16* kt = KT + ((size_t)dir * NTOK + Tc) * LDQ + hd * 256;
      const u16* kdT = KDT + ((size_t)((dir * 192 + cgx) * 4 + hd) * 256) * 64;
      const u16* vT = VT + ((size_t)cgx * 2048 + vcol0 + r) * 64;
      {
        u32x4 rq[8];
        const u16* qt = QT + ((size_t)dir * NTOK + Tc) * LDQ + hd * 256;
        const __amdgpu_buffer_rsrc_t qrs = __builtin_amdgcn_make_buffer_rsrc((void*)qt, 0, 0x7fffffff, 0x00020000);
#pragma unroll
        for (int i = 0; i < 8; ++i) rq[i] = __builtin_bit_cast(u32x4, __builtin_amdgcn_raw_buffer_load_b128(qrs, (tid >> 5) * (LDQ * 2) + (tid & 31) * 16, i * 8 * (LDQ * 2), 0));
        const float dnv = DN[(size_t)(dir * 192 + cgx) * 1024 + hd * 256 + tid];
        __syncthreads();
#pragma unroll
        for (int i = 0; i < 8; ++i) *(u32x4*)(buf + ((tid >> 5) + 8 * i) * 528 + (tid & 31) * 16) = rq[i];
        dns[tid] = dnv;
        __syncthreads();
      }
      {
        f32x16 a;
#pragma unroll
        for (int e = 0; e < 16; ++e) a[e] = 0.f;
        const int ci = w >> 1, si = w & 1;
        const char* qa = buf + (32 * ci + r) * 528 + h * 16; const u16* kb = kt + (size_t)(32 * si + r) * LDQ + 8 * h;
#pragma unroll
        for (int ks = 0; ks < 16; ++ks) a = MFMA32(*(const bf16x8*)(qa + ks * 32), *(const bf16x8*)(kb + ks * 16), a);
#pragma unroll
        for (int e = 0; e < 16; ++e) {
          const int cr_ = 32 * ci + crow(e, h), sc_ = 32 * si + r;
          const bool keep = dir ? (sc_ >= cr_) : (sc_ <= cr_);
          att[cr_ * 72 + sc_] = keep ? f2bf(a[e]) : (u16)0;
        }
      }
      f32x16 o[2];
#pragma unroll
      for (int q = 0; q < 2; ++q)
#pragma unroll
        for (int e = 0; e < 16; ++e) o[q][e] = 0.f;
#pragma unroll
      for (int mt = 0; mt < 8; ++mt)
#pragma unroll
        for (int s = 0; s < 2; ++s) {
          const bf16x8 sf = pack8(S[mt], s);
#pragma unroll
          for (int q = 0; q < 2; ++q) {
            const char* qa = buf + (32 * q + r) * 528 + (32 * mt + 16 * s + 4 * h) * 2;
            const s16x4 lo = *(const s16x4*)qa, hi = *(const s16x4*)(qa + 16);
            o[q] = MFMA32(cat4(lo, hi), sf, o[q]);
          }
        }
      {
        u32x4 rq[8];
        const __amdgpu_buffer_rsrc_t krs = __builtin_amdgcn_make_buffer_rsrc((void*)kdT, 0, 0x7fffffff, 0x00020000);
#pragma unroll
        for (int i = 0; i < 8; ++i) rq[i] = __builtin_bit_cast(u32x4, __builtin_amdgcn_raw_buffer_load_b128(krs, tid * 16, i * 4096, 0));
        __syncthreads();
#pragma unroll
        for (int i = 0; i < 8; ++i) *(u32x4*)(buf + ((tid >> 3) + 32 * i) * 144 + (tid & 7) * 16) = rq[i];
        __syncthreads();
      }
      bf16x8 vf[4];
#pragma unroll
      for (int ks = 0; ks < 4; ++ks) vf[ks] = *(const bf16x8*)(vT + ks * 16 + 8 * h);
#pragma unroll
      for (int q = 0; q < 2; ++q)
#pragma unroll
        for (int ks = 0; ks < 4; ++ks) { const bf16x8 af = *(const bf16x8*)(att + (32 * q + r) * 72 + ks * 16 + 8 * h); o[q] = MFMA32(af, vf[ks], o[q]); }
#pragma unroll
      for (int q = 0; q < 2; ++q)
#pragma unroll
        for (int e = 0; e < 16; ++e) OD[(size_t)(Tc + 32 * q + crow(e, h)) * 2048 + vcol0 + r] = f2bf(o[q][e]);
#pragma unroll
      for (int mt = 0; mt < 8; ++mt) {
#pragma unroll
        for (int g = 0; g < 4; ++g) {
          const f32x4 d4 = *(const f32x4*)(dns + 32 * mt + 8 * g + 4 * h);
#pragma unroll
          for (int e = 0; e < 4; ++e) S[mt][4 * g + e] *= d4[e];
        }
#pragma unroll
        for (int ks = 0; ks < 4; ++ks) { const bf16x8 af = *(const bf16x8*)(buf + (32 * mt + r) * 144 + ks * 32 + h * 16); S[mt] = MFMA32(af, vf[ks], S[mt]); }
      }
    }
    if (!lat) {
      float* so = p.out + OUT_GLA + ((size_t)((bs * 2 + dir) * 4 + hd) * 256) * 512 + (sl * 128 + w * 32 + r);
#pragma unroll
      for (int mt = 0; mt < 8; ++mt)
#pragma unroll
        for (int e = 0; e < 16; ++e) so[(size_t)(32 * mt + crow(e, h)) * 512] = S[mt][e];
    }
  }
  __syncthreads();
}

DI void gla_norm(const Params& p) {
  char* ws = p.ws;
  const u16* OF = (const u16*)(ws + WS_OP); const u16* OB = (const u16*)(ws + C_OB); const u16* SG = (const u16*)(ws + C_SGATE);
  u16* OG = (u16*)(ws + WS_H);
  const int lane = tid_() & 63, wv = tid_() >> 6;
  for (int T = blockIdx.x * 4 + wv; T < NTOK; T += gridDim.x * 4) {
    f32x4 x[8];
    float ss[4] = {0.f, 0.f, 0.f, 0.f};
#pragma unroll
    for (int j = 0; j < 8; ++j) {
      const size_t o = (size_t)T * 2048 + (j * 64 + lane) * 4;
      x[j] = ld_bf4(OF + o) + ld_bf4(OB + o);
      ss[j >> 1] += x[j][0] * x[j][0] + x[j][1] * x[j][1] + x[j][2] * x[j][2] + x[j][3] * x[j][3];
    }
#pragma unroll
    for (int q = 0; q < 4; ++q) ss[q] = rsqrtf(wave_sum(ss[q]) * (1.f / 512.f) + EPS);
#pragma unroll
    for (int j = 0; j < 8; ++j) {
      const int col = (j * 64 + lane) * 4;
      const size_t o = (size_t)T * 2048 + col;
      const f32x4 ng = *(const f32x4*)(p.gla_norm + (col & 511));
      const u32x2 sg = *(const u32x2*)(SG + o);
      const f32x4 y = x[j] * ss[j >> 1] * ng;
      st_bf4(OG + (size_t)T * LDH + col, y[0] * bflo(sg.x), y[1] * bfhi(sg.x), y[2] * bflo(sg.y), y[3] * bfhi(sg.y));
    }
  }
}

#define XB_TMO      128
#define XB_XCNT(j)  (256  + 64 * (j))
#define XB_XSUB(j)  (1280 + 64 * (j))
#define XB_XGEN(j)  (2304 + 64 * (j))
#define XB_TOP      3328
#define XB_TOPGEN   3392
#define XCD_BAR_WORDS 3456
#define XB_SPIN_CAP (1u << 18)
#define LAS __attribute__((address_space(3)))
DI unsigned xb_ld(unsigned* p) { return __hip_atomic_load(p, __ATOMIC_RELAXED, __HIP_MEMORY_SCOPE_AGENT); }
DI unsigned xb_add(unsigned* p, unsigned v) { return __hip_atomic_fetch_add(p, v, __ATOMIC_RELAXED, __HIP_MEMORY_SCOPE_AGENT); }
DI unsigned xb_xcc_id() { return (unsigned)__builtin_amdgcn_s_getreg((3 << 11) | 20) & 0xFu; }
#define XB_SPIN(cond, bar) do { unsigned _sp = 0; while (cond) { __builtin_amdgcn_s_sleep(1); \
    if ((++_sp & 255u) == 0u) { if (xb_ld(&(bar)[XB_TMO])) break; if (_sp > XB_SPIN_CAP) { atomicAdd(&(bar)[XB_TMO], 1u); break; } } } } while (0)
struct XcdBarrier { unsigned* bar; unsigned x; volatile LAS unsigned* st; };
DI XcdBarrier xcd_barrier_post(unsigned* bar, volatile LAS unsigned* st) {
  XcdBarrier b; b.bar = bar; b.x = xb_xcc_id(); b.st = st;
  if (threadIdx.x == 0) (void)xb_add(&bar[XB_XCNT(b.x)], 1u);
  return b;
}
DI void xcd_barrier_complete(unsigned* bar, unsigned x, unsigned& nloc, unsigned& nx) {
  const unsigned G = gridDim.x * gridDim.y * gridDim.z;
  unsigned sum, cnt, mine, sp = 0u;
  for (;;) {
    sum = 0u; cnt = 0u; mine = 0u;
#pragma unroll
    for (unsigned j = 0; j < 16; ++j) { const unsigned c = xb_ld(&bar[XB_XCNT(j)]); sum += c; cnt += (c > 0u) ? 1u : 0u; mine = (j == x) ? c : mine; }
    if (sum == G) break;
    __builtin_amdgcn_s_sleep(1);
    if ((++sp & 255u) == 0u) { if (xb_ld(&bar[XB_TMO])) break; if (sp > XB_SPIN_CAP) { atomicAdd(&bar[XB_TMO], 1u); break; } }
  }
  nloc = mine > 0u ? mine : 1u; nx = cnt > 0u ? cnt : 1u;
}
DI void xcd_barrier(const XcdBarrier& b) {
  asm volatile("s_waitcnt vmcnt(0)" ::: "memory");
  __syncthreads();
  if (threadIdx.x == 0) {
    unsigned* bar = b.bar;
    __builtin_amdgcn_s_waitcnt(0);
    unsigned nloc = b.st[0], nx = b.st[1];
    if (nloc == 0u) { xcd_barrier_complete(bar, b.x, nloc, nx); b.st[0] = nloc; b.st[1] = nx; }
    const unsigned old = xb_add(&bar[XB_XSUB(b.x)], 1u);
    const unsigned gen = old / nloc;
    if (old + 1u == (gen + 1u) * nloc) {
      __builtin_amdgcn_fence(__ATOMIC_RELEASE, "agent");
      asm volatile("s_waitcnt vmcnt(0)" ::: "memory");
      const unsigned og = xb_add(&bar[XB_TOP], 1u);
      const unsigned tg = og / nx;
      if (og + 1u == (tg + 1u) * nx) xb_add(&bar[XB_TOPGEN], 1u);
      else XB_SPIN(xb_ld(&bar[XB_TOPGEN]) == tg, bar);
      __builtin_amdgcn_fence(__ATOMIC_ACQUIRE, "agent");
      xb_add(&bar[XB_XGEN(b.x)], 1u);
      asm volatile("s_waitcnt vmcnt(0)" ::: "memory");
    } else {
      XB_SPIN(xb_ld(&bar[XB_XGEN(b.x)]) == gen, bar);
      __builtin_amdgcn_fence(__ATOMIC_ACQUIRE, "agent");
      asm volatile("s_waitcnt vmcnt(0)" ::: "memory");
    }
  }
  __syncthreads();
}

constexpr int NPHASE = 26;
#ifndef DUPMASK
#define DUPMASK 0u
#endif
template <int PH>
DI void run_phase(const Params& p, char* smem) {
  char* ws = p.ws;
  if constexpr (PH == 0) phase0(p, smem);
  else if constexpr (PH == 1) norm_phase(p, 0, true);
  else if constexpr (PH == 2) mla_g1(p, 0, smem);
  else if constexpr (PH == 3) mla_a2(p, 0);
  else if constexpr (PH == 4) mla_g2(p, 0, smem);
  else if constexpr (PH == 5) mla_attn(p, smem);
  else if constexpr (PH == 6) gemm_out(p, (const u16*)(ws + WS_H), (const u16*)(ws + WS_WT_MLA_OUT), smem);
  else if constexpr (PH == 7) norm_phase(p, 1, false);
  else if constexpr (PH == 8) s5_g1(p, smem);
  else if constexpr (PH == 9) s5_scan(p, smem);
  else if constexpr (PH == 10) s5_combine(p);
  else if constexpr (PH == 11) s5_g2(p, smem);
  else if constexpr (PH == 12) gemm_out(p, (const u16*)(ws + B_Z), (const u16*)(ws + WS_WT_S5_OUT), smem);
  else if constexpr (PH == 13) norm_phase(p, 2, false);
  else if constexpr (PH == 14) gla_g1(p, smem);
  else if constexpr (PH == 15) gla_gate(p, (float*)smem);
  else if constexpr (PH == 16) gla_main(p, smem);
  else if constexpr (PH == 17) gla_norm(p);
  else if constexpr (PH == 18) gemm_out(p, (const u16*)(ws + WS_H), (const u16*)(ws + WS_WT_GLA_OUT), smem);
  else if constexpr (PH == 19) norm_phase(p, 3, false);
  else if constexpr (PH == 20) mla_g1(p, 1, smem);
  else if constexpr (PH == 21) mla_a2(p, 1);
  else if constexpr (PH == 22) mla_g2(p, 1, smem);
  else if constexpr (PH == 23) mla_attn(p, smem);
  else if constexpr (PH == 24) gemm_out(p, (const u16*)(ws + WS_H), (const u16*)(ws + WS_WT_MLA_OUT) + (size_t)2048 * LDW, smem);
  else if constexpr (PH == 25) norm_phase(p, 4, false);
}

template <int PH>
DI void run_from(const Params& p, char* smem, const XcdBarrier& xb) {
  run_phase<PH>(p, smem);
  if constexpr ((DUPMASK >> PH) & 1u) { __syncthreads(); run_phase<PH>(p, smem); }
  if constexpr (PH + 1 < NPHASE) { xcd_barrier(xb); run_from<PH + 1>(p, smem, xb); }
}

#if COOP
__global__ void __launch_bounds__(256, 2) mega(Params p) {
  __shared__ __attribute__((aligned(16))) char smem[73728];
  __shared__ uint4 xb_words;
  cg::grid_group grid = cg::this_grid();
  if (p.out == nullptr) grid.sync();
  if (threadIdx.x == 0) xb_words = make_uint4(0u, 0u, 0u, 0u);
  __syncthreads();
  const XcdBarrier xb = xcd_barrier_post((unsigned*)(p.ws + WS_BAR), (volatile LAS unsigned*)&xb_words);
  run_from<0>(p, smem, xb);
}
#else
template <int PH>
__global__ void __launch_bounds__(256, 2) phase_k(Params p) {
  __shared__ __attribute__((aligned(16))) char smem[73728];
  run_phase<PH>(p, smem);
}
template <int PH>
static void launch_from(const Params& p, int grid, hipStream_t stream) {
  hipLaunchKernelGGL(phase_k<PH>, dim3(grid), dim3(256), 0, stream, p);
  if constexpr (PH + 1 < NPHASE) launch_from<PH + 1>(p, grid, stream);
}
#endif

extern "C" void kernel_launch(void* const* d_in, const int* in_sizes, int n_in, void* d_out, int out_size, void* d_ws, size_t ws_size, hipStream_t stream) {
  static int grid_blocks = 0;
  if (!grid_blocks) {
    int dev = 0, cus = 0, per_cu = 0;
    (void)hipGetDevice(&dev);
    (void)hipDeviceGetAttribute(&cus, hipDeviceAttributeMultiprocessorCount, dev);
#if COOP
    (void)hipOccupancyMaxActiveBlocksPerMultiprocessor(&per_cu, mega, 256, 0);
#else
    per_cu = 2;
#endif
    if (per_cu < 1) per_cu = 1;
    if (per_cu > 2) per_cu = 2;
    grid_blocks = cus * per_cu;
  }
  Params p{};
  const float** pp = (const float**)&p;
  for (int i = 0; i < 33; ++i) pp[i] = (const float*)d_in[i];
  p.out = (float*)d_out;
  p.ws = (char*)d_ws;
#if COOP
  (void)hipMemsetAsync(d_ws, 0, XCD_BAR_WORDS * 4, stream);
  void* args[] = {&p};
  hipError_t e = hipLaunchCooperativeKernel((void*)mega, dim3(grid_blocks), dim3(256), args, 0, stream);
  if (e != hipSuccess) fprintf(stderr, "cooperative launch failed: %s (grid %d)\n", hipGetErrorString(e), grid_blocks);
#else
  launch_from<0>(p, grid_blocks, stream);
#endif
}
```

```cpp
#include <hip/hip_runtime.h>
#include <hip/hip_cooperative_groups.h>
#include <stdint.h>
#include <cstdio>
namespace cg = cooperative_groups;

#ifndef COOP
#define COOP 1
#endif

typedef unsigned short u16;
typedef short bf16x8 __attribute__((ext_vector_type(8)));
typedef short s16x4 __attribute__((ext_vector_type(4)));
typedef float f32x16 __attribute__((ext_vector_type(16)));
typedef float f32x4 __attribute__((ext_vector_type(4)));
typedef float f32x2 __attribute__((ext_vector_type(2)));
typedef unsigned u32x4 __attribute__((ext_vector_type(4)));
typedef unsigned u32x2 __attribute__((ext_vector_type(2)));
typedef __bf16 bfv2 __attribute__((ext_vector_type(2)));
#define DI __device__ __forceinline__
#define MFMA32(a, b, c) __builtin_amdgcn_mfma_f32_32x32x16_bf16((a), (b), (c), 0, 0, 0)

constexpr int D = 2048, NTOK = 12288, NCTX = 4096;
constexpr float EPS = 1e-6f;
constexpr int LDH = 2112, LDW = 2112, LDC = 576, LDKB = 3136, LDQ = 1088;
constexpr size_t OUT_CKV = 25165824, OUT_KROPE = 29360128, OUT_S5 = 29884416, OUT_GLA = 30408704;
constexpr size_t WS_BAR = 0;
constexpr size_t WS_WT_MLA_IN = 16384;
constexpr size_t WS_WT_MLA_UKV = WS_WT_MLA_IN + 2ull * 5760 * LDW * 2;
constexpr size_t WS_WT_MLA_OUT = WS_WT_MLA_UKV + 2ull * 4096 * LDC * 2;
constexpr size_t WS_WT_S5_IN = WS_WT_MLA_OUT + 2ull * 2048 * LDW * 2;
constexpr size_t WS_WT_S5_GLU = WS_WT_S5_IN + 4096ull * LDW * 2;
constexpr size_t WS_WT_S5_OUT = WS_WT_S5_GLU + 2048ull * LDW * 2;
constexpr size_t WS_WT_GLA_IN = WS_WT_S5_OUT + 2048ull * LDW * 2;
constexpr size_t WS_WT_GLA_OUT = WS_WT_GLA_IN + 6272ull * LDW * 2;
constexpr size_t WS_MOD = WS_WT_GLA_OUT + 2048ull * LDW * 2;
constexpr size_t WS_H = WS_MOD + 4ull * 9 * 6144 * 4;
constexpr size_t WS_OP = WS_H + 12288ull * LDH * 2;
constexpr size_t WS_SCR = WS_OP + 12288ull * 2048 * 4;
constexpr size_t A_QB = WS_SCR;
constexpr size_t A_CKVRAW = A_QB + 12288ull * 3072 * 2;
constexpr size_t A_CKVALL = A_CKVRAW + 12288ull * 512 * 4;
constexpr size_t A_SGATE = A_CKVALL + 14336ull * LDC * 2;
constexpr size_t A_KB = A_SGATE + 12288ull * 2048 * 2;
constexpr size_t A_VT = A_KB + 14336ull * LDKB * 2;
constexpr size_t B_U = WS_SCR;
constexpr size_t B_SGATE = B_U + 12288ull * 2048 * 4;
constexpr size_t B_YB = B_SGATE + 12288ull * 2048 * 2;
constexpr size_t B_Z = B_YB + 12288ull * 2048 * 4;
constexpr size_t C_QG = WS_SCR;
constexpr size_t C_KG = C_QG + 12288ull * 1024 * 2;
constexpr size_t C_VT = C_KG + 12288ull * 1024 * 2;
constexpr size_t C_SGATE = C_VT + 12288ull * 2048 * 2;
constexpr size_t C_GLR = C_SGATE + 12288ull * 2048 * 2;
constexpr size_t C_QT = C_GLR + 12288ull * 32 * 4;
constexpr size_t C_KT = C_QT + 2ull * 12288 * LDQ * 2;
constexpr size_t C_KDT = C_KT + 2ull * 12288 * LDQ * 2;
constexpr size_t C_DN = C_KDT + 2ull * 12288 * 1024 * 2;
constexpr size_t C_OB = C_DN + 2ull * 192 * 1024 * 4;

struct Params {
  const float *x_prompt, *x_sample, *cache_ckv, *cache_krope, *state_s5, *state_gla, *c, *c_ctx;
  const float *ada_w, *ada_b, *norm_pre, *norm_post;
  const float *mla_w_in, *mla_kv_norm, *mla_w_ukv, *mla_w_out;
  const float *s5_w_in, *s5_a_re, *s5_a_im, *s5_log_dt, *s5_b_re, *s5_b_im, *s5_c_re, *s5_c_im, *s5_d, *s5_w_glu, *s5_b_glu, *s5_w_out;
  const float *gla_w_in, *gla_w_g2, *gla_b_g, *gla_norm, *gla_w_out;
  float* out;
  char* ws;
};

DI unsigned pk2(float a, float b) { f32x2 v; v.x = a; v.y = b; bfv2 r = __builtin_convertvector(v, bfv2); return __builtin_bit_cast(unsigned, r); }
DI u16 f2bf(float a) { return (u16)(pk2(a, 0.f) & 0xffffu); }
DI float bf2f(u16 v) { return __uint_as_float(((unsigned)v) << 16); }
DI float bflo(unsigned v) { return __uint_as_float(v << 16); }
DI float bfhi(unsigned v) { return __uint_as_float(v & 0xffff0000u); }
DI float siluf(float x) { return x / (1.f + __expf(-x)); }
DI float sigmf(float x) { return 1.f / (1.f + __expf(-x)); }
DI f32x4 ld_bf4(const u16* p) { const u32x2 v = *(const u32x2*)p; f32x4 o = {bflo(v.x), bfhi(v.x), bflo(v.y), bfhi(v.y)}; return o; }
DI int crow(int reg, int h) { return (reg & 3) + 8 * (reg >> 2) + 4 * h; }
DI void st_bf4(u16* p, float a, float b, float c, float d) { u32x2 v; v.x = pk2(a, b); v.y = pk2(c, d); *(u32x2*)p = v; }
DI bf16x8 pack8(const f32x16& x, int s) {
  u32x4 p;
  p.x = pk2(x[8 * s + 0], x[8 * s + 1]); p.y = pk2(x[8 * s + 2], x[8 * s + 3]);
  p.z = pk2(x[8 * s + 4], x[8 * s + 5]); p.w = pk2(x[8 * s + 6], x[8 * s + 7]);
  return __builtin_bit_cast(bf16x8, p);
}
DI bf16x8 cat4(s16x4 lo, s16x4 hi) { return __builtin_shufflevector(lo, hi, 0, 1, 2, 3, 4, 5, 6, 7); }
DI float wave_sum(float v) {
#pragma unroll
  for (int o = 32; o >= 1; o >>= 1) v += __shfl_xor(v, o);
  return v;
}
DI int tid_() { int t = threadIdx.x; asm volatile("" : "+v"(t)); return t; }
DI int cond_of(int T) { return T < NCTX ? 8 : ((T - NCTX) >> 10); }
DI int kvrow_of(int T) { return T < NCTX ? T : NCTX + ((T - NCTX) >> 10) * 1280 + ((T - NCTX) & 1023); }

DI void ada_phase(const Params& p, float* smem) {
  const int tid = tid_();
  float* mod = (float*)(p.ws + WS_MOD);
  for (int it = blockIdx.x; it < 384; it += gridDim.x) {
    const int l = it / 96, n0 = (it % 96) * 64;
    __syncthreads();
    for (int i = tid; i < 9 * 2048; i += 256) { const int cd = i >> 11, k = i & 2047; const float v = cd < 8 ? p.c[cd * 2048 + k] : p.c_ctx[k]; smem[i] = siluf(v); }
    __syncthreads();
    const int c4 = tid & 15, ks = tid >> 4;
    const float* w = p.ada_w + (size_t)l * 2048 * 6144 + n0 + c4 * 4;
    float acc[9][4];
#pragma unroll
    for (int cd = 0; cd < 9; ++cd)
#pragma unroll
      for (int e = 0; e < 4; ++e) acc[cd][e] = 0.f;
#pragma unroll 4
    for (int kk = 0; kk < 128; ++kk) {
      const int k = ks * 128 + kk;
      const f32x4 wv = __builtin_nontemporal_load((const f32x4*)(w + (size_t)k * 6144));
#pragma unroll
      for (int cd = 0; cd < 9; ++cd) {
        const float s = smem[cd * 2048 + k];
#pragma unroll
        for (int e = 0; e < 4; ++e) acc[cd][e] += s * wv[e];
      }
    }
    __syncthreads();
#pragma unroll
    for (int cd = 0; cd < 9; ++cd)
#pragma unroll
      for (int e = 0; e < 4; ++e) smem[(ks * 9 + cd) * 64 + c4 * 4 + e] = acc[cd][e];
    __syncthreads();
    for (int o = tid; o < 576; o += 256) {
      const int cd = o >> 6, col = o & 63;
      float s = 0.f;
#pragma unroll
      for (int k2 = 0; k2 < 16; ++k2) s += smem[(k2 * 9 + cd) * 64 + col];
      mod[(size_t)(l * 9 + cd) * 6144 + n0 + col] = s + p.ada_b[l * 6144 + n0 + col];
    }
  }
  __syncthreads();
}

DI void transpose_job(const float* __restrict__ src, u16* __restrict__ dst, int K, int N, int Npad, int ldw, float* tile) {
  const int tid = tid_();
  const int nkt = K / 64, total = nkt * (Npad / 64);
  for (int t = blockIdx.x; t < total; t += gridDim.x) {
    const int k0 = (t % nkt) * 64, n0 = (t / nkt) * 64;
    const int c = tid & 63, r0 = tid >> 6;
#pragma unroll
    for (int i = 0; i < 16; ++i) { const int r = r0 + 4 * i; tile[r * 65 + c] = (n0 + c < N) ? src[(size_t)(k0 + r) * N + n0 + c] : 0.f; }
    __syncthreads();
    const int n = tid >> 2, ks = (tid & 3) * 16;
    u32x4 v0, v1;
    v0.x = pk2(tile[(ks + 0) * 65 + n], tile[(ks + 1) * 65 + n]); v0.y = pk2(tile[(ks + 2) * 65 + n], tile[(ks + 3) * 65 + n]);
    v0.z = pk2(tile[(ks + 4) * 65 + n], tile[(ks + 5) * 65 + n]); v0.w = pk2(tile[(ks + 6) * 65 + n], tile[(ks + 7) * 65 + n]);
    v1.x = pk2(tile[(ks + 8) * 65 + n], tile[(ks + 9) * 65 + n]); v1.y = pk2(tile[(ks + 10) * 65 + n], tile[(ks + 11) * 65 + n]);
    v1.z = pk2(tile[(ks + 12) * 65 + n], tile[(ks + 13) * 65 + n]); v1.w = pk2(tile[(ks + 14) * 65 + n], tile[(ks + 15) * 65 + n]);
    u16* d = dst + (size_t)(n0 + n) * ldw + k0 + ks;
    *(u32x4*)d = v0; *(u32x4*)(d + 8) = v1;
    __syncthreads();
  }
}

DI void phase0(const Params& p, char* smem) {
  ada_phase(p, (float*)smem);
  float* tile = (float*)smem;
  char* ws = p.ws;
  for (int j = 0; j < 2; ++j) {
    transpose_job(p.mla_w_in + (size_t)j * 2048 * 5696, (u16*)(ws + WS_WT_MLA_IN) + (size_t)j * 5760 * LDW, 2048, 5696, 5760, LDW, tile);
    transpose_job(p.mla_w_ukv + (size_t)j * 512 * 4096, (u16*)(ws + WS_WT_MLA_UKV) + (size_t)j * 4096 * LDC, 512, 4096, 4096, LDC, tile);
    transpose_job(p.mla_w_out + (size_t)j * 2048 * 2048, (u16*)(ws + WS_WT_MLA_OUT) + (size_t)j * 2048 * LDW, 2048, 2048, 2048, LDW, tile);
  }
  transpose_job(p.s5_w_in, (u16*)(ws + WS_WT_S5_IN), 2048, 4096, 4096, LDW, tile);
  transpose_job(p.s5_w_glu, (u16*)(ws + WS_WT_S5_GLU), 2048, 2048, 2048, LDW, tile);
  transpose_job(p.s5_w_out, (u16*)(ws + WS_WT_S5_OUT), 2048, 2048, 2048, LDW, tile);
  transpose_job(p.gla_w_in, (u16*)(ws + WS_WT_GLA_IN), 2048, 6176, 6272, LDW, tile);
  transpose_job(p.gla_w_out, (u16*)(ws + WS_WT_GLA_OUT), 2048, 2048, 2048, LDW, tile);
}

DI void norm_phase(const Params& p, int l, bool first) {
  const int lane = tid_() & 63, wv = tid_() >> 6;
  const float* mod = (const float*)(p.ws + WS_MOD);
  const u16* OP = (const u16*)(p.ws + WS_OP);
  u16* H = (u16*)(p.ws + WS_H);
  for (int T = blockIdx.x * 4 + wv; T < NTOK; T += gridDim.x * 4) {
    const int cd = cond_of(T);
    const float* xin = T < NCTX ? p.x_prompt + (size_t)T * D : p.x_sample + (size_t)(T - NCTX) * D;
    float* xrow = p.out + (size_t)T * D;
    f32x4 x[8];
    if (first) {
#pragma unroll
      for (int j = 0; j < 8; ++j) x[j] = *(const f32x4*)(xin + (j * 64 + lane) * 4);
    } else {
      const float* xold = (l == 1) ? xin : xrow;
      const u16* op = OP + (size_t)T * D;
      f32x4 o[8];
      float ss = 0.f;
#pragma unroll
      for (int j = 0; j < 8; ++j) { o[j] = ld_bf4(op + (j * 64 + lane) * 4); ss += o[j][0] * o[j][0] + o[j][1] * o[j][1] + o[j][2] * o[j][2] + o[j][3] * o[j][3]; }
      ss = wave_sum(ss);
      const float rstd = rsqrtf(ss * (1.f / D) + EPS);
      const float* npost = p.norm_post + (l - 1) * D;
      const float* gate = mod + (size_t)((l - 1) * 9 + cd) * 6144 + 4096;
#pragma unroll
      for (int j = 0; j < 8; ++j) {
        const int col = (j * 64 + lane) * 4;
        const f32x4 xo = *(const f32x4*)(xold + col), np = *(const f32x4*)(npost + col), g = *(const f32x4*)(gate + col);
        x[j] = xo + g * (o[j] * rstd * np);
        *(f32x4*)(xrow + col) = x[j];
      }
    }
    if (l < 4) {
      float ss = 0.f;
#pragma unroll
      for (int j = 0; j < 8; ++j) ss += x[j][0] * x[j][0] + x[j][1] * x[j][1] + x[j][2] * x[j][2] + x[j][3] * x[j][3];
      ss = wave_sum(ss);
      const float rstd = rsqrtf(ss * (1.f / D) + EPS);
      const float* npre = p.norm_pre + l * D;
      const float* sh = mod + (size_t)(l * 9 + cd) * 6144;
      u16* hrow = H + (size_t)T * LDH;
#pragma unroll
      for (int j = 0; j < 8; ++j) {
        const int col = (j * 64 + lane) * 4;
        const f32x4 np = *(const f32x4*)(npre + col), s1 = *(const f32x4*)(sh + col), sc = *(const f32x4*)(sh + 2048 + col);
        const f32x4 hv = x[j] * rstd * np * (1.f + sc) + s1;
        st_bf4(hrow + col, hv[0], hv[1], hv[2], hv[3]);
      }
    }
  }
}

template <int BM, bool SWAP, class Epi>
DI void gemm_tile(const int w, const u16* __restrict__ A, int lda, const u16* __restrict__ Bt, int ldb, int K, int m0, int n0, const Epi& epi, char* smem) {
  u16* As = (u16*)smem;
  u16* Bs = As + 256 * 72;
  const int tid = tid_(), lane = tid & 63, r = lane & 31, h = lane >> 5;
  const int wm = w >> 1, wn = w & 1;
  const int lrow = tid >> 3, lseg = tid & 7;
  const __amdgpu_buffer_rsrc_t Ars = __builtin_amdgcn_make_buffer_rsrc((void*)(A + (size_t)m0 * lda), 0, 0x7fffffff, 0x00020000);
  const __amdgpu_buffer_rsrc_t Brs = __builtin_amdgcn_make_buffer_rsrc((void*)(Bt + (size_t)n0 * ldb), 0, 0x7fffffff, 0x00020000);
  const int aoff = (lrow * lda + lseg * 8) * 2, boff = (lrow * ldb + lseg * 8) * 2;
  constexpr int NA = BM / 32, NI = BM / 64;
  u32x4 ra[NA], rb[4];
  f32x16 acc[NI][2];
#pragma unroll
  for (int i = 0; i < NI; ++i)
#pragma unroll
    for (int j = 0; j < 2; ++j)
#pragma unroll
      for (int e = 0; e < 16; ++e) acc[i][j][e] = 0.f;
#define GT_GL(K0) { _Pragma("unroll") for (int q = 0; q < NA; ++q) ra[q] = __builtin_bit_cast(u32x4, __builtin_amdgcn_raw_buffer_load_b128(Ars, aoff, (32 * q * lda + (K0)) * 2, 0)); \
                    _Pragma("unroll") for (int q = 0; q < 4; ++q) rb[q] = __builtin_bit_cast(u32x4, __builtin_amdgcn_raw_buffer_load_b128(Brs, boff, (32 * q * ldb + (K0)) * 2, 0)); }
#define GT_LS() { _Pragma("unroll") for (int q = 0; q < NA; ++q) *(u32x4*)(As + (lrow + 32 * q) * 72 + lseg * 8) = ra[q]; \
                  _Pragma("unroll") for (int q = 0; q < 4; ++q) *(u32x4*)(Bs + (lrow + 32 * q) * 72 + lseg * 8) = rb[q]; }
  const int nk = K >> 6;
  GT_GL(0);
  __syncthreads();
  GT_LS();
  __syncthreads();
  const u16* as = As + (wm * (BM / 2) + r) * 72 + h * 8;
  const u16* bs = Bs + (wn * 64 + r) * 72 + h * 8;
  for (int kt = 0; kt < nk; ++kt) {
    { const int k1 = (kt + 1 < nk ? kt + 1 : kt) << 6; GT_GL(k1); }
    __builtin_amdgcn_sched_barrier(0);
#pragma unroll
    for (int ks = 0; ks < 4; ++ks) {
      bf16x8 b[2];
#pragma unroll
      for (int j = 0; j < 2; ++j) b[j] = *(const bf16x8*)(bs + j * 32 * 72 + ks * 16);
#pragma unroll
      for (int i = 0; i < NI; ++i) {
        const bf16x8 a = *(const bf16x8*)(as + i * 32 * 72 + ks * 16);
#pragma unroll
        for (int j = 0; j < 2; ++j) acc[i][j] = SWAP ? MFMA32(b[j], a, acc[i][j]) : MFMA32(a, b[j], acc[i][j]);
      }
    }
    __syncthreads();
    GT_LS();
    __syncthreads();
  }
#undef GT_GL
#undef GT_LS
  int lane2;
  asm volatile("v_mbcnt_lo_u32_b32 %0, -1, 0\n\tv_mbcnt_hi_u32_b32 %0, -1, %0" : "=v"(lane2));
  const int r2 = lane2 & 31, h2 = lane2 >> 5;
#pragma unroll
  for (int i = 0; i < NI; ++i)
#pragma unroll
    for (int j = 0; j < 2; ++j) epi(m0 + wm * (BM / 2) + i * 32, n0 + wn * 64 + j * 32, acc[i][j], r2, h2);
}

template <class F>
DI void for_tiles(int MT, int NT, const F& f) {
  const int G = gridDim.x;
  if ((G & 7) == 0 && (MT & 7) == 0) {
    const int G8 = G >> 3, xcd = blockIdx.x & 7, loc = blockIdx.x >> 3;
    const int SM = MT >> 3, SN = (NT + 7) >> 3, total = SM * SN * 64;
    for (int i = 0;; ++i) {
      const int u = (i * 8 + xcd) * G8 + loc;
      if (u >= total) break;
      const int sup = u >> 6, win = u & 63;
      const int mt = (sup % SM) * 8 + (win & 7), nt = (sup / SM) * 8 + (win >> 3);
      if (nt < NT) f(mt, nt);
    }
  } else {
    for (int t = blockIdx.x; t < MT * NT; t += G) f(t % MT, t / MT);
  }
}

DI void rope16(f32x16& v, int pos, int h) {
#pragma unroll
  for (int g = 0; g < 2; ++g)
#pragma unroll
    for (int e = 0; e < 4; ++e) {
      const int f = 8 * g + 4 * h + e;
      const float invf = exp2f(-(float)f * 0.83048202372184058696f);
      const float rev = ((float)pos * invf) * 0.15915494309189533577f;
      const float sn = __builtin_amdgcn_sinf(rev), cs = __builtin_amdgcn_cosf(rev);
      const float x1 = v[4 * g + e], x2 = v[4 * (g + 2) + e];
      v[4 * g + e] = x1 * cs - x2 * sn;
      v[4 * (g + 2) + e] = x1 * sn + x2 * cs;
    }
}

DI void mla_g1(const Params& p, int j, char* smem) {
  char* ws = p.ws;
  const u16* H = (const u16*)(ws + WS_H);
  const u16* Wt = (const u16*)(ws + WS_WT_MLA_IN) + (size_t)j * 5760 * LDW;
  auto epi = [&](int tm, int tn, const f32x16& acc, int r, int h) {
    char* ws2 = p.ws;
    u16* QB = (u16*)(ws2 + A_QB); float* CKVRAW = (float*)(ws2 + A_CKVRAW); u16* SG = (u16*)(ws2 + A_SGATE); u16* KB = (u16*)(ws2 + A_KB);
    float* okr = p.out + OUT_KROPE;
    const int m = tm + r;
    if (tn < 3072) {
      const int within = tn % 192;
      f32x16 v = acc;
      if (within >= 128 && m >= NCTX) { const int tl = (m - NCTX) & 1023; rope16(v, within < 160 ? (tl >> 6) : (tl & 63), h); }
#pragma unroll
      for (int g = 0; g < 4; ++g) st_bf4(QB + (size_t)m * 3072 + tn + 8 * g + 4 * h, v[4 * g], v[4 * g + 1], v[4 * g + 2], v[4 * g + 3]);
    } else if (tn < 3584) {
#pragma unroll
      for (int g = 0; g < 4; ++g) { f32x4 o = {acc[4 * g], acc[4 * g + 1], acc[4 * g + 2], acc[4 * g + 3]}; *(f32x4*)(CKVRAW + (size_t)m * 512 + (tn - 3072) + 8 * g + 4 * h) = o; }
    } else if (tn < 3648) {
      f32x16 v = acc;
      const int c0 = tn - 3584;
      if (m >= NCTX) { const int tl = (m - NCTX) & 1023; rope16(v, c0 == 0 ? (tl >> 6) : (tl & 63), h); }
      else {
        const int b = m >> 8, t = m & 255;
#pragma unroll
        for (int g = 0; g < 4; ++g) { f32x4 o = {v[4 * g], v[4 * g + 1], v[4 * g + 2], v[4 * g + 3]}; *(f32x4*)(okr + ((size_t)(b * 2 + j) * 256 + t) * 64 + c0 + 8 * g + 4 * h) = o; }
      }
      const size_t R = kvrow_of(m);
      for (int hd = 0; hd < 16; ++hd)
#pragma unroll
        for (int g = 0; g < 4; ++g) st_bf4(KB + R * LDKB + hd * 192 + 128 + c0 + 8 * g + 4 * h, v[4 * g], v[4 * g + 1], v[4 * g + 2], v[4 * g + 3]);
    } else if (tn < 5696) {
#pragma unroll
      for (int g = 0; g < 4; ++g) st_bf4(SG + (size_t)m * 2048 + (tn - 3648) + 8 * g + 4 * h, siluf(acc[4 * g]), siluf(acc[4 * g + 1]), siluf(acc[4 * g + 2]), siluf(acc[4 * g + 3]));
    }
  };
  const int wv_ = __builtin_amdgcn_readfirstlane(tid_() >> 6);
  for_tiles(48, 45, [&](int mt, int nt) { gemm_tile<256, true>(wv_, H, LDH, Wt, LDW, 2048, mt * 256, nt * 128, epi, smem); });
}

DI void mla_a2(const Params& p, int j) {
  char* ws = p.ws;
  const int lane = tid_() & 63, wv = tid_() >> 6;
  const float* CKVRAW = (const float*)(ws + A_CKVRAW); u16* CKVALL = (u16*)(ws + A_CKVALL); u16* KB = (u16*)(ws + A_KB);
  const float* kvn = p.mla_kv_norm + j * 512;
  float* ockv = p.out + OUT_CKV;
  for (int R = blockIdx.x * 4 + wv; R < 14336; R += gridDim.x * 4) {
    int T = -1, cb = 0, ct = 0;
    if (R < NCTX) T = R;
    else { const int r2 = R - NCTX; cb = r2 / 1280; const int tp = r2 - cb * 1280; if (tp < 1024) T = NCTX + cb * 1024 + tp; else ct = tp - 1024; }
    u16* dst = CKVALL + (size_t)R * LDC;
    if (T >= 0) {
      const float* src = CKVRAW + (size_t)T * 512;
      const f32x4 a = *(const f32x4*)(src + lane * 4), b = *(const f32x4*)(src + 256 + lane * 4);
      float ss = a[0] * a[0] + a[1] * a[1] + a[2] * a[2] + a[3] * a[3] + b[0] * b[0] + b[1] * b[1] + b[2] * b[2] + b[3] * b[3];
      ss = wave_sum(ss);
      const float rstd = rsqrtf(ss * (1.f / 512.f) + EPS);
      const f32x4 g0 = *(const f32x4*)(kvn + lane * 4), g1 = *(const f32x4*)(kvn + 256 + lane * 4);
      const f32x4 y0 = a * rstd * g0, y1 = b * rstd * g1;
      st_bf4(dst + lane * 4, y0[0], y0[1], y0[2], y0[3]);
      st_bf4(dst + 256 + lane * 4, y1[0], y1[1], y1[2], y1[3]);
      if (T < NCTX) {
        float* o = ockv + ((size_t)((T >> 8) * 2 + j) * 256 + (T & 255)) * 512;
        *(f32x4*)(o + lane * 4) = y0; *(f32x4*)(o + 256 + lane * 4) = y1;
      }
    } else {
      const float* src = p.cache_ckv + ((size_t)(cb * 2 + j) * 256 + ct) * 512;
      const f32x4 a = *(const f32x4*)(src + lane * 4), b = *(const f32x4*)(src + 256 + lane * 4);
      st_bf4(dst + lane * 4, a[0], a[1], a[2], a[3]);
      st_bf4(dst + 256 + lane * 4, b[0], b[1], b[2], b[3]);
      const float kr = p.cache_krope[((size_t)(cb * 2 + j) * 256 + ct) * 64 + lane];
      const u16 kb = f2bf(kr);
      for (int hd = 0; hd < 16; ++hd) KB[(size_t)R * LDKB + hd * 192 + 128 + lane] = kb;
    }
  }
}

DI void mla_g2(const Params& p, int j, char* smem) {
  char* ws = p.ws;
  const u16* CKVALL = (const u16*)(ws + A_CKVALL);
  const u16* Wt = (const u16*)(ws + WS_WT_MLA_UKV) + (size_t)j * 4096 * LDC;
  u16* KB = (u16*)(ws + A_KB); u16* VT = (u16*)(ws + A_VT);
  auto epiK = [&](int tm, int tn, const f32x16& acc, int r, int h) {
    const size_t R = tm + r; const int hd = tn >> 8, wi = tn & 255;
#pragma unroll
    for (int g = 0; g < 4; ++g) st_bf4(KB + R * LDKB + hd * 192 + wi + 8 * g + 4 * h, acc[4 * g], acc[4 * g + 1], acc[4 * g + 2], acc[4 * g + 3]);
  };
  auto epiV = [&](int tm, int tn, const f32x16& acc, int r, int h) {
    const int n = tn + r; const int hd = n >> 8, d = (n & 255) - 128;
    size_t base; int nkeys, key0;
    if (tm < NCTX) { base = (size_t)(tm >> 8) * 256 * 2048; nkeys = 256; key0 = tm & 255; }
    else { const int r2 = tm - NCTX; const int b = r2 / 1280; base = (size_t)NCTX * 2048 + (size_t)b * 1280 * 2048; nkeys = 1280; key0 = r2 - b * 1280; }
    u16* dst = VT + base + (size_t)(hd * 128 + d) * nkeys + key0;
#pragma unroll
    for (int g = 0; g < 4; ++g) st_bf4(dst + 8 * g + 4 * h, acc[4 * g], acc[4 * g + 1], acc[4 * g + 2], acc[4 * g + 3]);
  };
  const int wv_ = __builtin_amdgcn_readfirstlane(tid_() >> 6);
  for_tiles(56, 32, [&](int mt, int nt) {
    if ((nt & 1) == 0) gemm_tile<256, true>(wv_, CKVALL, LDC, Wt, LDC, 512, mt * 256, nt * 128, epiK, smem);
    else gemm_tile<256, false>(wv_, CKVALL, LDC, Wt, LDC, 512, mt * 256, nt * 128, epiV, smem);
  });
}

DI void mla_attn(const Params& p, char* smem) {
  char* ws = p.ws;
  const u16* QB = (const u16*)(ws + A_QB); const u16* KB = (const u16*)(ws + A_KB); const u16* VT = (const u16*)(ws + A_VT); const u16* SG = (const u16*)(ws + A_SGATE);
  u16* OG = (u16*)(ws + WS_H);
  char* Ks = smem;
  char* Vs = smem + 25600;
  const int tid = tid_();
  const int lane = tid & 63, w = tid >> 6, r = lane & 31, h = lane >> 5;
  const float SC = 0.07216878364870322f * 1.4426950408889634f;
  for (int it = blockIdx.x; it < 1536; it += gridDim.x) {
    int head, T0, R0, nkeys; size_t vbase;
    if (it < 1024) { const int b = it >> 7; head = (it >> 3) & 15; T0 = NCTX + b * 1024 + (it & 7) * 128; R0 = NCTX + b * 1280; nkeys = 1280; vbase = (size_t)NCTX * 2048 + (size_t)b * 1280 * 2048; }
    else { const int i2 = it - 1024; const int b = i2 >> 5; head = (i2 >> 1) & 15; T0 = b * 256 + (i2 & 1) * 128; R0 = b * 256; nkeys = 256; vbase = (size_t)b * 256 * 2048; }
    T0 += w * 32;
    bf16x8 qf[12];
    const u16* qp = QB + (size_t)(T0 + r) * 3072 + head * 192 + 8 * h;
#pragma unroll
    for (int ks = 0; ks < 12; ++ks) qf[ks] = *(const bf16x8*)(qp + ks * 16);
    f32x16 O[4];
#pragma unroll
    for (int dt = 0; dt < 4; ++dt)
#pragma unroll
      for (int e = 0; e < 16; ++e) O[dt][e] = 0.f;
    float mrun = -INFINITY, lrun = 0.f;
    const u16* kg = KB + (size_t)R0 * LDKB + head * 192;
    const u16* vg = VT + vbase + (size_t)(head * 128) * nkeys;
    u32x4 rk[6], rv[4];
    const __amdgpu_buffer_rsrc_t Krs = __builtin_amdgcn_make_buffer_rsrc((void*)kg, 0, 0x7fffffff, 0x00020000);
    const __amdgpu_buffer_rsrc_t Vrs = __builtin_amdgcn_make_buffer_rsrc((void*)vg, 0, 0x7fffffff, 0x00020000);
    const int kvo = (tid >> 2) * (LDKB * 2) + (tid & 3) * 16;
    const int vvo = (tid >> 3) * nkeys * 2 + (tid & 7) * 16;
#define AT_LOAD(KT0) { _Pragma("unroll") for (int i = 0; i < 6; ++i) rk[i] = __builtin_bit_cast(u32x4, __builtin_amdgcn_raw_buffer_load_b128(Krs, kvo + 64 * i, (KT0) * (LDKB * 2), 0)); \
                       _Pragma("unroll") for (int i = 0; i < 4; ++i) rv[i] = __builtin_bit_cast(u32x4, __builtin_amdgcn_raw_buffer_load_b128(Vrs, vvo, (32 * i * nkeys + (KT0)) * 2, 0)); }
#define AT_STORE() { _Pragma("unroll") for (int i = 0; i < 6; ++i) *(u32x4*)(Ks + (tid >> 2) * 400 + ((tid & 3) + 4 * i) * 16) = rk[i]; \
                     _Pragma("unroll") for (int i = 0; i < 4; ++i) { const int sg = tid & 7; char* d = Vs + ((tid >> 3) + 32 * i) * 144 + (sg >> 1) * 32 + (sg & 1) * 8; \
                       u32x2 lo, hi; lo.x = rv[i].x; lo.y = rv[i].y; hi.x = rv[i].z; hi.y = rv[i].w; *(u32x2*)d = lo; *(u32x2*)(d + 16) = hi; } }
    AT_LOAD(0);
    __syncthreads();
    AT_STORE();
    __syncthreads();
    for (int kt0 = 0; kt0 < nkeys; kt0 += 64) {
      { const int kn = kt0 + 64 < nkeys ? kt0 + 64 : kt0; AT_LOAD(kn); }
#pragma unroll
      for (int sub = 0; sub < 2; ++sub) {
        f32x16 S;
#pragma unroll
        for (int e = 0; e < 16; ++e) S[e] = 0.f;
#pragma unroll
        for (int ks = 0; ks < 12; ++ks) { const bf16x8 kf = *(const bf16x8*)(Ks + (sub * 32 + r) * 400 + ks * 32 + h * 16); S = MFMA32(kf, qf[ks], S); }
        float mx = -INFINITY;
#pragma unroll
        for (int e = 0; e < 16; ++e) { S[e] *= SC; mx = fmaxf(mx, S[e]); }
        mx = fmaxf(mx, __shfl_xor(mx, 32));
        const float mnew = fmaxf(mrun, mx);
        const float alpha = __builtin_amdgcn_exp2f(mrun - mnew);
        mrun = mnew;
        float ps = 0.f;
#pragma unroll
        for (int e = 0; e < 16; ++e) { S[e] = __builtin_amdgcn_exp2f(S[e] - mnew); ps += S[e]; }
        lrun = lrun * alpha + ps;
#pragma unroll
        for (int dt = 0; dt < 4; ++dt)
#pragma unroll
          for (int e = 0; e < 16; ++e) O[dt][e] *= alpha;
#pragma unroll
        for (int s = 0; s < 2; ++s) {
          const bf16x8 pf = pack8(S, s);
#pragma unroll
          for (int dt = 0; dt < 4; ++dt) {
            const bf16x8 vf = *(const bf16x8*)(Vs + (dt * 32 + r) * 144 + (sub * 2 + s) * 32 + h * 16);
            O[dt] = MFMA32(vf, pf, O[dt]);
          }
        }
      }
      __syncthreads();
      AT_STORE();
      __syncthreads();
    }
#undef AT_LOAD
#undef AT_STORE
    lrun += __shfl_xor(lrun, 32);
    const float inv = 1.f / lrun;
#pragma unroll
    for (int dt = 0; dt < 4; ++dt)
#pragma unroll
      for (int g = 0; g < 4; ++g) {
        const size_t o = (size_t)(T0 + r) * 2048 + head * 128 + dt * 32 + 8 * g + 4 * h;
        const size_t oo = (size_t)(T0 + r) * LDH + head * 128 + dt * 32 + 8 * g + 4 * h;
        const u32x2 sg = *(const u32x2*)(SG + o);
        st_bf4(OG + oo, O[dt][4 * g] * inv * bflo(sg.x), O[dt][4 * g + 1] * inv * bfhi(sg.x), O[dt][4 * g + 2] * inv * bflo(sg.y), O[dt][4 * g + 3] * inv * bfhi(sg.y));
      }
  }
}

DI void gemm_out(const Params& p, const u16* A, const u16* Wt, char* smem) {
  u16* OP = (u16*)(p.ws + WS_OP);
  auto epi = [&](int tm, int tn, const f32x16& acc, int r, int h) {
    const size_t m = tm + r;
#pragma unroll
    for (int g = 0; g < 4; ++g) st_bf4(OP + m * 2048 + tn + 8 * g + 4 * h, acc[4 * g], acc[4 * g + 1], acc[4 * g + 2], acc[4 * g + 3]);
  };
  const int wv_ = __builtin_amdgcn_readfirstlane(tid_() >> 6);
  for_tiles(96, 16, [&](int mt, int nt) { gemm_tile<128, true>(wv_, A, LDH, Wt, LDW, 2048, mt * 128, nt * 128, epi, smem); });
}

DI void s5_g1(const Params& p, char* smem) {
  char* ws = p.ws;
  const u16* H = (const u16*)(ws + WS_H); const u16* Wt = (const u16*)(ws + WS_WT_S5_IN);
  u16* U = (u16*)(ws + B_U); u16* SG = (u16*)(ws + B_SGATE);
  auto epi = [&](int tm, int tn, const f32x16& acc, int r, int h) {
    const size_t m = tm + r;
    if (tn < 2048) {
#pragma unroll
      for (int g = 0; g < 4; ++g) st_bf4(U + m * 2048 + tn + 8 * g + 4 * h, acc[4 * g], acc[4 * g + 1], acc[4 * g + 2], acc[4 * g + 3]);
    } else {
#pragma unroll
      for (int g = 0; g < 4; ++g) st_bf4(SG + m * 2048 + (tn - 2048) + 8 * g + 4 * h, siluf(acc[4 * g]), siluf(acc[4 * g + 1]), siluf(acc[4 * g + 2]), siluf(acc[4 * g + 3]));
    }
  };
  const int wv_ = __builtin_amdgcn_readfirstlane(tid_() >> 6);
  for_tiles(48, 32, [&](int mt, int nt) { gemm_tile<256, true>(wv_, H, LDH, Wt, LDW, 2048, mt * 256, nt * 128, epi, smem); });
}

DI void s5_scan(const Params& p, char* smem) {
  char* ws = p.ws;
  const u16* U = (const u16*)(ws + B_U);
  u16* YF = (u16*)(ws + WS_OP); u16* YB = (u16*)(ws + B_YB);
  const int tid = tid_();
  const int lane = tid & 63;
  const int w = __builtin_amdgcn_readfirstlane(tid >> 6);
  char* Hs = smem + w * 12800;
  char* BUs = Hs + 4352;
  const int pcol = lane & 15, quad = lane >> 4;
  for (int it = blockIdx.x * 4 + w; it < 6144; it += gridDim.x * 4) {
    const int dir = it & 1; int rest = it >> 1;
    const bool lat = rest < 1024;
    int b, g, L, T0;
    if (lat) { b = rest >> 7; g = rest & 127; L = 1024; T0 = NCTX + b * 1024; }
    else { rest -= 1024; b = rest >> 7; g = rest & 127; L = 256; T0 = b * 256; }
    const int n = lane;
    const int pidx = (dir * 128 + g) * 64 + n;
    const float are = p.s5_a_re[pidx], aim = p.s5_a_im[pidx];
    const float dt = __expf(p.s5_log_dt[dir * 128 + g]);
    const float mag = __expf(are * dt), rev = (aim * dt) * 0.15915494309189533577f;
    const float abr = mag * __builtin_amdgcn_cosf(rev), abi = mag * __builtin_amdgcn_sinf(rev);
    const float nr = abr - 1.f, ni = abi, den = 1.f / (are * are + aim * aim);
    const float cr = (nr * are + ni * aim) * den, ci = (ni * are - nr * aim) * den;
    {
      const float* br = p.s5_b_re + (size_t)pidx * 16; const float* bi = p.s5_b_im + (size_t)pidx * 16;
      u32x4 re0, re1, im0, im1;
      {
        const f32x4 x0 = *(const f32x4*)(br), x1 = *(const f32x4*)(br + 4), x2 = *(const f32x4*)(br + 8), x3 = *(const f32x4*)(br + 12);
        const f32x4 y0 = *(const f32x4*)(bi), y1 = *(const f32x4*)(bi + 4), y2 = *(const f32x4*)(bi + 8), y3 = *(const f32x4*)(bi + 12);
        const f32x4 r0 = cr * x0 - ci * y0, r1 = cr * x1 - ci * y1, r2 = cr * x2 - ci * y2, r3 = cr * x3 - ci * y3;
        const f32x4 i0 = cr * y0 + ci * x0, i1 = cr * y1 + ci * x1, i2 = cr * y2 + ci * x2, i3 = cr * y3 + ci * x3;
        re0.x = pk2(r0[0], r0[1]); re0.y = pk2(r0[2], r0[3]); re0.z = pk2(r1[0], r1[1]); re0.w = pk2(r1[2], r1[3]);
        re1.x = pk2(r2[0], r2[1]); re1.y = pk2(r2[2], r2[3]); re1.z = pk2(r3[0], r3[1]); re1.w = pk2(r3[2], r3[3]);
        im0.x = pk2(i0[0], i0[1]); im0.y = pk2(i0[2], i0[3]); im0.z = pk2(i1[0], i1[1]); im0.w = pk2(i1[2], i1[3]);
        im1.x = pk2(i2[0], i2[1]); im1.y = pk2(i2[2], i2[3]); im1.z = pk2(i3[0], i3[1]); im1.w = pk2(i3[2], i3[3]);
      }
      char* d = BUs + n * 64;
      *(u32x4*)(d) = re0; *(u32x4*)(d + 16) = re1; *(u32x4*)(d + 32) = im0; *(u32x4*)(d + 48) = im1;
    }
    bf16x8 bfr[8];
#pragma unroll
    for (int nt = 0; nt < 8; ++nt) {
      u32x4 v = {0u, 0u, 0u, 0u};
      if (quad < 2) v = *(const u32x4*)(BUs + (16 * nt + pcol) * 32 + quad * 16);
      bfr[nt] = __builtin_bit_cast(bf16x8, v);
    }
    bf16x8 cf[4];
    {
      const float* c1 = p.s5_c_re + ((size_t)(dir * 128 + g) * 16 + pcol) * 64; const float* c2 = p.s5_c_im + ((size_t)(dir * 128 + g) * 16 + pcol) * 64;
#pragma unroll
      for (int s = 0; s < 4; ++s) {
        const f32x4 x = *(const f32x4*)(c1 + 16 * s + 4 * quad), y = *(const f32x4*)(c2 + 16 * s + 4 * quad);
        u32x4 pk; pk.x = pk2(x[0], -y[0]); pk.y = pk2(x[1], -y[1]); pk.z = pk2(x[2], -y[2]); pk.w = pk2(x[3], -y[3]);
        cf[s] = __builtin_bit_cast(bf16x8, pk);
      }
    }
    float hr = 0.f, hi = 0.f;
    if (lat) { const float* s0 = p.state_s5 + ((size_t)((b * 2 + dir) * 128 + g) * 64 + n) * 2; hr = s0[0]; hi = s0[1]; }
    u16* Y = dir ? YB : YF;
    const int t0 = dir ? L - 1 : 0, tstep = dir ? -1 : 1;
    const u16* ub = U + (size_t)T0 * 2048 + g * 16 + (quad & 1) * 8;
    u32x4 ua = {0u, 0u, 0u, 0u};
    if (quad < 2) ua = *(const u32x4*)(ub + (size_t)(t0 + tstep * pcol) * 2048);
    for (int s0_ = 0; s0_ < L; s0_ += 16) {
      const int tchunk = t0 + tstep * s0_;
      const bf16x8 af = __builtin_bit_cast(bf16x8, ua);
      if (s0_ + 16 < L && quad < 2) ua = *(const u32x4*)(ub + (size_t)(tchunk + tstep * (16 + pcol)) * 2048);
#pragma unroll
      for (int nt = 0; nt < 8; ++nt) {
        f32x4 z = {0.f, 0.f, 0.f, 0.f};
        z = __builtin_amdgcn_mfma_f32_16x16x32_bf16(af, bfr[nt], z, 0, 0, 0);
#pragma unroll
        for (int i = 0; i < 4; ++i) *(float*)(BUs + (4 * quad + i) * 528 + (16 * nt + pcol) * 4) = z[i];
      }
#pragma unroll 4
      for (int row = 0; row < 16; ++row) {
        const f32x2 bu = *(const f32x2*)(BUs + row * 528 + n * 8);
        const float nhr = abr * hr - abi * hi + bu.x, nhi = abr * hi + abi * hr + bu.y;
        hr = nhr; hi = nhi;
        if (!lat && s0_ == 0 && row == 0) { float* so = p.out + OUT_S5 + ((size_t)((b * 2 + dir) * 128 + g) * 64 + n) * 2; so[0] = hr; so[1] = hi; }
        *(unsigned*)(Hs + row * 272 + n * 4) = pk2(hr, hi);
      }
      f32x4 yacc = {0.f, 0.f, 0.f, 0.f};
#pragma unroll
      for (int s = 0; s < 4; ++s) {
        const bf16x8 hf = *(const bf16x8*)(Hs + pcol * 272 + s * 64 + quad * 16);
        yacc = __builtin_amdgcn_mfma_f32_16x16x32_bf16(hf, cf[s], yacc, 0, 0, 0);
      }
#pragma unroll
      for (int i = 0; i < 4; ++i) { const int tok = tchunk + tstep * (4 * quad + i); Y[(size_t)(T0 + tok) * 2048 + g * 16 + pcol] = f2bf(yacc[i]); }
    }
  }
}

DI float gelu_tanh(float x) {
  const float t = 0.7978845608028654f * (x + 0.044715f * x * x * x);
  const float e = __expf(2.f * t);
  const float th = 1.f - 2.f / (e + 1.f);
  return 0.5f * x * (1.f + th);
}

DI void s5_combine(const Params& p) {
  char* ws = p.ws;
  const u16* U = (const u16*)(ws + B_U); const u16* YF = (const u16*)(ws + WS_OP); const u16* YB = (const u16*)(ws + B_YB);
  u16* YG = (u16*)(ws + WS_H);
  const size_t n4 = (size_t)NTOK * 2048 / 4;
  for (size_t i = (size_t)blockIdx.x * 256 + tid_(); i < n4; i += (size_t)gridDim.x * 256) {
    const int col = (int)((i * 4) & 2047);
    const f32x4 u = ld_bf4(U + i * 4), a = ld_bf4(YF + i * 4), b = ld_bf4(YB + i * 4), d = *(const f32x4*)(p.s5_d + col);
    const f32x4 y = d * u + a + b;
    st_bf4(YG + ((i * 4) >> 11) * LDH + col, gelu_tanh(y[0]), gelu_tanh(y[1]), gelu_tanh(y[2]), gelu_tanh(y[3]));
  }
}

DI void s5_g2(const Params& p, char* smem) {
  char* ws = p.ws;
  const u16* YG = (const u16*)(ws + WS_H); const u16* Wt = (const u16*)(ws + WS_WT_S5_GLU); const u16* SG = (const u16*)(ws + B_SGATE);
  u16* Z = (u16*)(ws + B_Z);
  auto epi = [&](int tm, int tn, const f32x16& acc, int r, int h) {
    const size_t m = tm + r;
#pragma unroll
    for (int g = 0; g < 4; ++g) {
      const int n = tn + 8 * g + 4 * h;
      const f32x4 bg = *(const f32x4*)(p.s5_b_glu + n);
      const u32x2 yv = *(const u32x2*)(YG + m * LDH + n), sg = *(const u32x2*)(SG + m * 2048 + n);
      st_bf4(Z + m * LDH + n, bflo(yv.x) * sigmf(acc[4 * g] + bg[0]) * bflo(sg.x), bfhi(yv.x) * sigmf(acc[4 * g + 1] + bg[1]) * bfhi(sg.x),
             bflo(yv.y) * sigmf(acc[4 * g + 2] + bg[2]) * bflo(sg.y), bfhi(yv.y) * sigmf(acc[4 * g + 3] + bg[3]) * bfhi(sg.y));
    }
  };
  const int wv_ = __builtin_amdgcn_readfirstlane(tid_() >> 6);
  for_tiles(96, 16, [&](int mt, int nt) { gemm_tile<128, true>(wv_, YG, LDH, Wt, LDW, 2048, mt * 128, nt * 128, epi, smem); });
}

DI void gla_g1(const Params& p, char* smem) {
  char* ws = p.ws;
  const u16* H = (const u16*)(ws + WS_H); const u16* Wt = (const u16*)(ws + WS_WT_GLA_IN);
  u16* VT = (u16*)(ws + C_VT);
  auto epi = [&](int tm, int tn, const f32x16& acc, int r, int h) {
    char* ws2 = p.ws;
    u16* QG = (u16*)(ws2 + C_QG); u16* KG = (u16*)(ws2 + C_KG); u16* SG = (u16*)(ws2 + C_SGATE); float* GLR = (float*)(ws2 + C_GLR);
    const size_t m = tm + r;
    if (tn < 1024) {
#pragma unroll
      for (int g = 0; g < 4; ++g) st_bf4(QG + m * 1024 + tn + 8 * g + 4 * h, acc[4 * g] * 0.0625f, acc[4 * g + 1] * 0.0625f, acc[4 * g + 2] * 0.0625f, acc[4 * g + 3] * 0.0625f);
    } else if (tn < 2048) {
#pragma unroll
      for (int g = 0; g < 4; ++g) st_bf4(KG + m * 1024 + (tn - 1024) + 8 * g + 4 * h, acc[4 * g], acc[4 * g + 1], acc[4 * g + 2], acc[4 * g + 3]);
    } else if (tn >= 4096 && tn < 6144) {
#pragma unroll
      for (int g = 0; g < 4; ++g) st_bf4(SG + m * 2048 + (tn - 4096) + 8 * g + 4 * h, siluf(acc[4 * g]), siluf(acc[4 * g + 1]), siluf(acc[4 * g + 2]), siluf(acc[4 * g + 3]));
    } else if (tn == 6144) {
#pragma unroll
      for (int g = 0; g < 4; ++g) { f32x4 o = {acc[4 * g], acc[4 * g + 1], acc[4 * g + 2], acc[4 * g + 3]}; *(f32x4*)(GLR + m * 32 + 8 * g + 4 * h) = o; }
    }
  };
  auto epiV = [&](int tm, int tn, const f32x16& acc, int r, int h) {
    const int dv = tn - 2048 + r;
    u16* dst = VT + ((size_t)(tm >> 6) * 2048 + dv) * 64 + (tm & 63);
#pragma unroll
    for (int g = 0; g < 4; ++g) st_bf4(dst + 8 * g + 4 * h, acc[4 * g], acc[4 * g + 1], acc[4 * g + 2], acc[4 * g + 3]);
  };
  const int wv_ = __builtin_amdgcn_readfirstlane(tid_() >> 6);
  for_tiles(48, 49, [&](int mt, int nt) {
    if (nt >= 16 && nt < 32) gemm_tile<256, false>(wv_, H, LDH, Wt, LDW, 2048, mt * 256, nt * 128, epiV, smem);
    else gemm_tile<256, true>(wv_, H, LDH, Wt, LDW, 2048, mt * 256, nt * 128, epi, smem);
  });
}

DI float logsigf(float z) { return fminf(z, 0.f) - __logf(1.f + __expf(-fabsf(z))); }

DI void gla_gate(const Params& p, float* smem) {
  char* ws = p.ws;
  const u16* QG = (const u16*)(ws + C_QG); const u16* KG = (const u16*)(ws + C_KG); const float* GLR = (const float*)(ws + C_GLR);
  u16* QT = (u16*)(ws + C_QT); u16* KT = (u16*)(ws + C_KT); u16* KDT = (u16*)(ws + C_KDT); float* DN = (float*)(ws + C_DN);
  const int tid = tid_();
  for (int it = blockIdx.x; it < 1536; it += gridDim.x) {
    const int dir = it & 1, hd = (it >> 1) & 3, c = it >> 3;
    const int ch = hd * 256 + tid;
    __syncthreads();
    for (int i = tid; i < 1024; i += 256) smem[i] = GLR[(size_t)(c * 64 + (i >> 4)) * 32 + dir * 16 + (i & 15)];
    __syncthreads();
    float wg[16];
#pragma unroll
    for (int q = 0; q < 16; ++q) wg[q] = p.gla_w_g2[(size_t)(dir * 16 + q) * 1024 + ch];
    const float bg = p.gla_b_g[dir * 1024 + ch];
    float tot = 0.f;
    for (int i = 0; i < 64; ++i) {
      float z = bg;
#pragma unroll
      for (int q = 0; q < 16; ++q) z += smem[i * 16 + q] * wg[q];
      tot += logsigf(z) * 0.0625f;
    }
    DN[(size_t)(dir * 192 + c) * 1024 + ch] = __expf(tot);
    float run = 0.f;
    u16* kdrow = KDT + ((size_t)((dir * 192 + c) * 4 + hd) * 256 + tid) * 64;
    for (int i8 = 0; i8 < 8; ++i8) {
      float kdv[8];
#pragma unroll
      for (int e = 0; e < 8; ++e) {
        const int ii = i8 * 8 + e;
        const int i = dir ? 63 - ii : ii;
        float z = bg;
#pragma unroll
        for (int q = 0; q < 16; ++q) z += smem[i * 16 + q] * wg[q];
        run += logsigf(z) * 0.0625f;
        const size_t T = (size_t)c * 64 + i;
        const float q_ = bf2f(QG[T * 1024 + ch]), k_ = bf2f(KG[T * 1024 + ch]);
        QT[((size_t)dir * NTOK + T) * LDQ + ch] = f2bf(q_ * __expf(run));
        KT[((size_t)dir * NTOK + T) * LDQ + ch] = f2bf(k_ * __expf(-run));
        kdv[e] = k_ * __expf(tot - run);
      }
      u32x4 pk;
      if (dir) { pk.x = pk2(kdv[7], kdv[6]); pk.y = pk2(kdv[5], kdv[4]); pk.z = pk2(kdv[3], kdv[2]); pk.w = pk2(kdv[1], kdv[0]); }
      else { pk.x = pk2(kdv[0], kdv[1]); pk.y = pk2(kdv[2], kdv[3]); pk.z = pk2(kdv[4], kdv[5]); pk.w = pk2(kdv[6], kdv[7]); }
      const int tb = dir ? 56 - i8 * 8 : i8 * 8;
      *(u32x4*)(kdrow + tb) = pk;
    }
  }
  __syncthreads();
}

DI void gla_main(const Params& p, char* smem) {
  char* ws = p.ws;
  const u16* QT = (const u16*)(ws + C_QT); const u16* KT = (const u16*)(ws + C_KT); const u16* KDT = (const u16*)(ws + C_KDT); const u16* VT = (const u16*)(ws + C_VT);
  const float* DN = (const float*)(ws + C_DN);
  u16* OF = (u16*)(ws + WS_OP); u16* OB = (u16*)(ws + C_OB);
  char* buf = smem;
  u16* att = (u16*)(smem + 36864);
  float* dns = (float*)(smem + 36864 + 9216);
  const int tid = tid_();
  const int lane = tid & 63, w = tid >> 6, r = lane & 31, h = lane >> 5;
  for (int it = blockIdx.x; it < 768; it += gridDim.x) {
    const bool lat = it < 256;
    const int i2 = lat ? it : it - 256;
    const int bs = i2 >> 5, hd = (i2 >> 3) & 3, dir = (i2 >> 2) & 1, sl = i2 & 3;
    const int nc = lat ? 16 : 4, T0 = lat ? NCTX + bs * 1024 : bs * 256;
    const int vcol0 = hd * 512 + sl * 128 + w * 32;
    f32x16 S[8];
    if (lat) {
      const float* s0 = p.state_gla + ((size_t)((bs * 2 + dir) * 4 + hd) * 256) * 512 + (sl * 128 + w * 32 + r);
#pragma unroll
      for (int mt = 0; mt < 8; ++mt)
#pragma unroll
        for (int e = 0; e < 16; ++e) S[mt][e] = s0[(size_t)(32 * mt + crow(e, h)) * 512];
    } else {
#pragma unroll
      for (int mt = 0; mt < 8; ++mt)
#pragma unroll
        for (int e = 0; e < 16; ++e) S[mt][e] = 0.f;
    }
    u16* OD = dir ? OB : OF;
    for (int cc = 0; cc < nc; ++cc) {
      const int c = dir ? nc - 1 - cc : cc;
      const int Tc = T0 + c * 64, cgx = Tc >> 6;
      const u16* kt = KT + ((size_t)dir * NTOK + Tc) * LDQ + hd * 256;
      const u16* kdT = KDT + ((size_t)((dir * 192 + cgx) * 4 + hd) * 256) * 64;
      const u16* vT = VT + ((size_t)cgx * 2048 + vcol0 + r) * 64;
      {
        u32x4 rq[8];
        const u16* qt = QT + ((size_t)dir * NTOK + Tc) * LDQ + hd * 256;
        const __amdgpu_buffer_rsrc_t qrs = __builtin_amdgcn_make_buffer_rsrc((void*)qt, 0, 0x7fffffff, 0x00020000);
#pragma unroll
        for (int i = 0; i < 8; ++i) rq[i] = __builtin_bit_cast(u32x4, __builtin_amdgcn_raw_buffer_load_b128(qrs, (tid >> 5) * (LDQ * 2) + (tid & 31) * 16, i * 8 * (LDQ * 2), 0));
        const float dnv = DN[(size_t)(dir * 192 + cgx) * 1024 + hd * 256 + tid];
        __syncthreads();
#pragma unroll
        for (int i = 0; i < 8; ++i) *(u32x4*)(buf + ((tid >> 5) + 8 * i) * 528 + (tid & 31) * 16) = rq[i];
        dns[tid] = dnv;
        __syncthreads();
      }
      {
        f32x16 a;
#pragma unroll
        for (int e = 0; e < 16; ++e) a[e] = 0.f;
        const int ci = w >> 1, si = w & 1;
        const char* qa = buf + (32 * ci + r) * 528 + h * 16; const u16* kb = kt + (size_t)(32 * si + r) * LDQ + 8 * h;
#pragma unroll
        for (int ks = 0; ks < 16; ++ks) a = MFMA32(*(const bf16x8*)(qa + ks * 32), *(const bf16x8*)(kb + ks * 16), a);
#pragma unroll
        for (int e = 0; e < 16; ++e) {
          const int cr_ = 32 * ci + crow(e, h), sc_ = 32 * si + r;
          const bool keep = dir ? (sc_ >= cr_) : (sc_ <= cr_);
          att[cr_ * 72 + sc_] = keep ? f2bf(a[e]) : (u16)0;
        }
      }
      f32x16 o[2];
#pragma unroll
      for (int q = 0; q < 2; ++q)
#pragma unroll
        for (int e = 0; e < 16; ++e) o[q][e] = 0.f;
#pragma unroll
      for (int mt = 0; mt < 8; ++mt)
#pragma unroll
        for (int s = 0; s < 2; ++s) {
          const bf16x8 sf = pack8(S[mt], s);
#pragma unroll
          for (int q = 0; q < 2; ++q) {
            const char* qa = buf + (32 * q + r) * 528 + (32 * mt + 16 * s + 4 * h) * 2;
            const s16x4 lo = *(const s16x4*)qa, hi = *(const s16x4*)(qa + 16);
            o[q] = MFMA32(cat4(lo, hi), sf, o[q]);
          }
        }
      {
        u32x4 rq[8];
        const __amdgpu_buffer_rsrc_t krs = __builtin_amdgcn_make_buffer_rsrc((void*)kdT, 0, 0x7fffffff, 0x00020000);
#pragma unroll
        for (int i = 0; i < 8; ++i) rq[i] = __builtin_bit_cast(u32x4, __builtin_amdgcn_raw_buffer_load_b128(krs, tid * 16, i * 4096, 0));
        __syncthreads();
#pragma unroll
        for (int i = 0; i < 8; ++i) *(u32x4*)(buf + ((tid >> 3) + 32 * i) * 144 + (tid & 7) * 16) = rq[i];
        __syncthreads();
      }
      bf16x8 vf[4];
#pragma unroll
      for (int ks = 0; ks < 4; ++ks) vf[ks] = *(const bf16x8*)(vT + ks * 16 + 8 * h);
#pragma unroll
      for (int q = 0; q < 2; ++q)
#pragma unroll
        for (int ks = 0; ks < 4; ++ks) { const bf16x8 af = *(const bf16x8*)(att + (32 * q + r) * 72 + ks * 16 + 8 * h); o[q] = MFMA32(af, vf[ks], o[q]); }
#pragma unroll
      for (int q = 0; q < 2; ++q)
#pragma unroll
        for (int e = 0; e < 16; ++e) OD[(size_t)(Tc + 32 * q + crow(e, h)) * 2048 + vcol0 + r] = f2bf(o[q][e]);
#pragma unroll
      for (int mt = 0; mt < 8; ++mt) {
#pragma unroll
        for (int g = 0; g < 4; ++g) {
          const f32x4 d4 = *(const f32x4*)(dns + 32 * mt + 8 * g + 4 * h);
#pragma unroll
          for (int e = 0; e < 4; ++e) S[mt][4 * g + e] *= d4[e];
        }
#pragma unroll
        for (int ks = 0; ks < 4; ++ks) { const bf16x8 af = *(const bf16x8*)(buf + (32 * mt + r) * 144 + ks * 32 + h * 16); S[mt] = MFMA32(af, vf[ks], S[mt]); }
      }
    }
    if (!lat) {
      float* so = p.out + OUT_GLA + ((size_t)((bs * 2 + dir) * 4 + hd) * 256) * 512 + (sl * 128 + w * 32 + r);
#pragma unroll
      for (int mt = 0; mt < 8; ++mt)
#pragma unroll
        for (int e = 0; e < 16; ++e) so[(size_t)(32 * mt + crow(e, h)) * 512] = S[mt][e];
    }
  }
  __syncthreads();
}

DI void gla_norm(const Params& p) {
  char* ws = p.ws;
  const u16* OF = (const u16*)(ws + WS_OP); const u16* OB = (const u16*)(ws + C_OB); const u16* SG = (const u16*)(ws + C_SGATE);
  u16* OG = (u16*)(ws + WS_H);
  const int lane = tid_() & 63, wv = tid_() >> 6;
  for (int T = blockIdx.x * 4 + wv; T < NTOK; T += gridDim.x * 4) {
    f32x4 x[8];
    float ss[4] = {0.f, 0.f, 0.f, 0.f};
#pragma unroll
    for (int j = 0; j < 8; ++j) {
      const size_t o = (size_t)T * 2048 + (j * 64 + lane) * 4;
      x[j] = ld_bf4(OF + o) + ld_bf4(OB + o);
      ss[j >> 1] += x[j][0] * x[j][0] + x[j][1] * x[j][1] + x[j][2] * x[j][2] + x[j][3] * x[j][3];
    }
#pragma unroll
    for (int q = 0; q < 4; ++q) ss[q] = rsqrtf(wave_sum(ss[q]) * (1.f / 512.f) + EPS);
#pragma unroll
    for (int j = 0; j < 8; ++j) {
      const int col = (j * 64 + lane) * 4;
      const size_t o = (size_t)T * 2048 + col;
      const f32x4 ng = *(const f32x4*)(p.gla_norm + (col & 511));
      const u32x2 sg = *(const u32x2*)(SG + o);
      const f32x4 y = x[j] * ss[j >> 1] * ng;
      st_bf4(OG + (size_t)T * LDH + col, y[0] * bflo(sg.x), y[1] * bfhi(sg.x), y[2] * bflo(sg.y), y[3] * bfhi(sg.y));
    }
  }
}

#define XB_TMO      128
#define XB_XCNT(j)  (256  + 64 * (j))
#define XB_XSUB(j)  (1280 + 64 * (j))
#define XB_XGEN(j)  (2304 + 64 * (j))
#define XB_TOP      3328
#define XB_TOPGEN   3392
#define XCD_BAR_WORDS 3456
#define XB_SPIN_CAP (1u << 18)
#define LAS __attribute__((address_space(3)))
DI unsigned xb_ld(unsigned* p) { return __hip_atomic_load(p, __ATOMIC_RELAXED, __HIP_MEMORY_SCOPE_AGENT); }
DI unsigned xb_add(unsigned* p, unsigned v) { return __hip_atomic_fetch_add(p, v, __ATOMIC_RELAXED, __HIP_MEMORY_SCOPE_AGENT); }
DI unsigned xb_xcc_id() { return (unsigned)__builtin_amdgcn_s_getreg((3 << 11) | 20) & 0xFu; }
#define XB_SPIN(cond, bar) do { unsigned _sp = 0; while (cond) { __builtin_amdgcn_s_sleep(1); \
    if ((++_sp & 255u) == 0u) { if (xb_ld(&(bar)[XB_TMO])) break; if (_sp > XB_SPIN_CAP) { atomicAdd(&(bar)[XB_TMO], 1u); break; } } } } while (0)
struct XcdBarrier { unsigned* bar; unsigned x; volatile LAS unsigned* st; };
DI XcdBarrier xcd_barrier_post(unsigned* bar, volatile LAS unsigned* st) {
  XcdBarrier b; b.bar = bar; b.x = xb_xcc_id(); b.st = st;
  if (threadIdx.x == 0) (void)xb_add(&bar[XB_XCNT(b.x)], 1u);
  return b;
}
DI void xcd_barrier_complete(unsigned* bar, unsigned x, unsigned& nloc, unsigned& nx) {
  const unsigned G = gridDim.x * gridDim.y * gridDim.z;
  unsigned sum, cnt, mine, sp = 0u;
  for (;;) {
    sum = 0u; cnt = 0u; mine = 0u;
#pragma unroll
    for (unsigned j = 0; j < 16; ++j) { const unsigned c = xb_ld(&bar[XB_XCNT(j)]); sum += c; cnt += (c > 0u) ? 1u : 0u; mine = (j == x) ? c : mine; }
    if (sum == G) break;
    __builtin_amdgcn_s_sleep(1);
    if ((++sp & 255u) == 0u) { if (xb_ld(&bar[XB_TMO])) break; if (sp > XB_SPIN_CAP) { atomicAdd(&bar[XB_TMO], 1u); break; } }
  }
  nloc = mine > 0u ? mine : 1u; nx = cnt > 0u ? cnt : 1u;
}
DI void xcd_barrier(const XcdBarrier& b) {
  asm volatile("s_waitcnt vmcnt(0)" ::: "memory");
  __syncthreads();
  if (threadIdx.x == 0) {
    unsigned* bar = b.bar;
    __builtin_amdgcn_s_waitcnt(0);
    unsigned nloc = b.st[0], nx = b.st[1];
    if (nloc == 0u) { xcd_barrier_complete(bar, b.x, nloc, nx); b.st[0] = nloc; b.st[1] = nx; }
    const unsigned old = xb_add(&bar[XB_XSUB(b.x)], 1u);
    const unsigned gen = old / nloc;
    if (old + 1u == (gen + 1u) * nloc) {
      __builtin_amdgcn_fence(__ATOMIC_RELEASE, "agent");
      asm volatile("s_waitcnt vmcnt(0)" ::: "memory");
      const unsigned og = xb_add(&bar[XB_TOP], 1u);
      const unsigned tg = og / nx;
      if (og + 1u == (tg + 1u) * nx) xb_add(&bar[XB_TOPGEN], 1u);
      else XB_SPIN(xb_ld(&bar[XB_TOPGEN]) == tg, bar);
      __builtin_amdgcn_fence(__ATOMIC_ACQUIRE, "agent");
      xb_add(&bar[XB_XGEN(b.x)], 1u);
      asm volatile("s_waitcnt vmcnt(0)" ::: "memory");
    } else {
      XB_SPIN(xb_ld(&bar[XB_XGEN(b.x)]) == gen, bar);
      __builtin_amdgcn_fence(__ATOMIC_ACQUIRE, "agent");
      asm volatile("s_waitcnt vmcnt(0)" ::: "memory");
    }
  }
  __syncthreads();
}

constexpr int NPHASE = 26;
#ifndef DUPMASK
#define DUPMASK 0u
#endif
template <int PH>
DI void run_phase(const Params& p, char* smem) {
  char* ws = p.ws;
  if constexpr (PH == 0) phase0(p, smem);
  else if constexpr (PH == 1) norm_phase(p, 0, true);
  else if constexpr (PH == 2) mla_g1(p, 0, smem);
  else if constexpr (PH == 3) mla_a2(p, 0);
  else if constexpr (PH == 4) mla_g2(p, 0, smem);
  else if constexpr (PH == 5) mla_attn(p, smem);
  else if constexpr (PH == 6) gemm_out(p, (const u16*)(ws + WS_H), (const u16*)(ws + WS_WT_MLA_OUT), smem);
  else if constexpr (PH == 7) norm_phase(p, 1, false);
  else if constexpr (PH == 8) s5_g1(p, smem);
  else if constexpr (PH == 9) s5_scan(p, smem);
  else if constexpr (PH == 10) s5_combine(p);
  else if constexpr (PH == 11) s5_g2(p, smem);
  else if constexpr (PH == 12) gemm_out(p, (const u16*)(ws + B_Z), (const u16*)(ws + WS_WT_S5_OUT), smem);
  else if constexpr (PH == 13) norm_phase(p, 2, false);
  else if constexpr (PH == 14) gla_g1(p, smem);
  else if constexpr (PH == 15) gla_gate(p, (float*)smem);
  else if constexpr (PH == 16) gla_main(p, smem);
  else if constexpr (PH == 17) gla_norm(p);
  else if constexpr (PH == 18) gemm_out(p, (const u16*)(ws + WS_H), (const u16*)(ws + WS_WT_GLA_OUT), smem);
  else if constexpr (PH == 19) norm_phase(p, 3, false);
  else if constexpr (PH == 20) mla_g1(p, 1, smem);
  else if constexpr (PH == 21) mla_a2(p, 1);
  else if constexpr (PH == 22) mla_g2(p, 1, smem);
  else if constexpr (PH == 23) mla_attn(p, smem);
  else if constexpr (PH == 24) gemm_out(p, (const u16*)(ws + WS_H), (const u16*)(ws + WS_WT_MLA_OUT) + (size_t)2048 * LDW, smem);
  else if constexpr (PH == 25) norm_phase(p, 4, false);
}

template <int PH>
DI void run_from(const Params& p, char* smem, const XcdBarrier& xb) {
  run_phase<PH>(p, smem);
  if constexpr ((DUPMASK >> PH) & 1u) { __syncthreads(); run_phase<PH>(p, smem); }
  if constexpr (PH + 1 < NPHASE) { xcd_barrier(xb); run_from<PH + 1>(p, smem, xb); }
}

#if COOP
__global__ void __launch_bounds__(256, 2) mega(Params p) {
  __shared__ __attribute__((aligned(16))) char smem[73728];
  __shared__ uint4 xb_words;
  cg::grid_group grid = cg::this_grid();
  if (p.out == nullptr) grid.sync();
  if (threadIdx.x == 0) xb_words = make_uint4(0u, 0u, 0u, 0u);
  __syncthreads();
  const XcdBarrier xb = xcd_barrier_post((unsigned*)(p.ws + WS_BAR), (volatile LAS unsigned*)&xb_words);
  run_from<0>(p, smem, xb);
}
#else
template <int PH>
__global__ void __launch_bounds__(256, 2) phase_k(Params p) {
  __shared__ __attribute__((aligned(16))) char smem[73728];
  run_phase<PH>(p, smem);
}
template <int PH>
static void launch_from(const Params& p, int grid, hipStream_t stream) {
  hipLaunchKernelGGL(phase_k<PH>, dim3(grid), dim3(256), 0, stream, p);
  if constexpr (PH + 1 < NPHASE) launch_from<PH + 1>(p, grid, stream);
}
#endif

extern "C" void kernel_launch(void* const* d_in, const int* in_sizes, int n_in, void* d_out, int out_size, void* d_ws, size_t ws_size, hipStream_t stream) {
  static int grid_blocks = 0;
  if (!grid_blocks) {
    int dev = 0, cus = 0, per_cu = 0;
    (void)hipGetDevice(&dev);
    (void)hipDeviceGetAttribute(&cus, hipDeviceAttributeMultiprocessorCount, dev);
#if COOP
    (void)hipOccupancyMaxActiveBlocksPerMultiprocessor(&per_cu, mega, 256, 0);
#else
    per_cu = 2;
#endif
    if (per_cu < 1) per_cu = 1;
    if (per_cu > 2) per_cu = 2;
    grid_blocks = cus * per_cu;
  }
  Params p{};
  const float** pp = (const float**)&p;
  for (int i = 0; i < 33; ++i) pp[i] = (const float*)d_in[i];
  p.out = (float*)d_out;
  p.ws = (char*)d_ws;
#if COOP
  (void)hipMemsetAsync(d_ws, 0, XCD_BAR_WORDS * 4, stream);
  void* args[] = {&p};
  hipError_t e = hipLaunchCooperativeKernel((void*)mega, dim3(grid_blocks), dim3(256), args, 0, stream);
  if (e != hipSuccess) fprintf(stderr, "cooperative launch failed: %s (grid %d)\n", hipGetErrorString(e), grid_blocks);
#else
  launch_from<0>(p, grid_blocks, stream);
#endif
}
```

```cpp
#include <hip/hip_runtime.h>
#include <hip/hip_cooperative_groups.h>
#include <stdint.h>
#include <cstdio>
namespace cg = cooperative_groups;

#ifndef COOP
#define COOP 1
#endif

typedef unsigned short u16;
typedef short bf16x8 __attribute__((ext_vector_type(8)));
typedef short s16x4 __attribute__((ext_vector_type(4)));
typedef float f32x16 __attribute__((ext_vector_type(16)));
typedef float f32x4 __attribute__((ext_vector_type(4)));
typedef float f32x2 __attribute__((ext_vector_type(2)));
typedef unsigned u32x4 __attribute__((ext_vector_type(4)));
typedef unsigned u32x2 __attribute__((ext_vector_type(2)));
typedef __bf16 bfv2 __attribute__((ext_vector_type(2)));
#define DI __device__ __forceinline__
#define MFMA32(a, b, c) __builtin_amdgcn_mfma_f32_32x32x16_bf16((a), (b), (c), 0, 0, 0)

constexpr int D = 2048, NTOK = 12288, NCTX = 4096;
constexpr float EPS = 1e-6f;
constexpr int LDH = 2112, LDW = 2112, LDC = 576, LDKB = 3136, LDQ = 1088;
constexpr size_t OUT_CKV = 25165824, OUT_KROPE = 29360128, OUT_S5 = 29884416, OUT_GLA = 30408704;
constexpr size_t WS_BAR = 0;
constexpr size_t WS_WT_MLA_IN = 16384;
constexpr size_t WS_WT_MLA_UKV = WS_WT_MLA_IN + 2ull * 5760 * LDW * 2;
constexpr size_t WS_WT_MLA_OUT = WS_WT_MLA_UKV + 2ull * 4096 * LDC * 2;
constexpr size_t WS_WT_S5_IN = WS_WT_MLA_OUT + 2ull * 2048 * LDW * 2;
constexpr size_t WS_WT_S5_GLU = WS_WT_S5_IN + 4096ull * LDW * 2;
constexpr size_t WS_WT_S5_OUT = WS_WT_S5_GLU + 2048ull * LDW * 2;
constexpr size_t WS_WT_GLA_IN = WS_WT_S5_OUT + 2048ull * LDW * 2;
constexpr size_t WS_WT_GLA_OUT = WS_WT_GLA_IN + 6272ull * LDW * 2;
constexpr size_t WS_MOD = WS_WT_GLA_OUT + 2048ull * LDW * 2;
constexpr size_t WS_H = WS_MOD + 4ull * 9 * 6144 * 4;
constexpr size_t WS_OP = WS_H + 12288ull * LDH * 2;
constexpr size_t WS_SCR = WS_OP + 12288ull * 2048 * 4;
constexpr size_t A_QB = WS_SCR;
constexpr size_t A_CKVRAW = A_QB + 12288ull * 3072 * 2;
constexpr size_t A_CKVALL = A_CKVRAW + 12288ull * 512 * 4;
constexpr size_t A_SGATE = A_CKVALL + 14336ull * LDC * 2;
constexpr size_t A_KB = A_SGATE + 12288ull * 2048 * 2;
constexpr size_t A_VT = A_KB + 14336ull * LDKB * 2;
constexpr size_t B_U = WS_SCR;
constexpr size_t B_SGATE = B_U + 12288ull * 2048 * 4;
constexpr size_t B_YB = B_SGATE + 12288ull * 2048 * 2;
constexpr size_t B_Z = B_YB + 12288ull * 2048 * 4;
constexpr size_t C_QG = WS_SCR;
constexpr size_t C_KG = C_QG + 12288ull * 1024 * 2;
constexpr size_t C_VT = C_KG + 12288ull * 1024 * 2;
constexpr size_t C_SGATE = C_VT + 12288ull * 2048 * 2;
constexpr size_t C_GLR = C_SGATE + 12288ull * 2048 * 2;
constexpr size_t C_QT = C_GLR + 12288ull * 32 * 4;
constexpr size_t C_KT = C_QT + 2ull * 12288 * LDQ * 2;
constexpr size_t C_KDT = C_KT + 2ull * 12288 * LDQ * 2;
constexpr size_t C_DN = C_KDT + 2ull * 12288 * 1024 * 2;
constexpr size_t C_OB = C_DN + 2ull * 192 * 1024 * 4;

struct Params {
  const float *x_prompt, *x_sample, *cache_ckv, *cache_krope, *state_s5, *state_gla, *c, *c_ctx;
  const float *ada_w, *ada_b, *norm_pre, *norm_post;
  const float *mla_w_in, *mla_kv_norm, *mla_w_ukv, *mla_w_out;
  const float *s5_w_in, *s5_a_re, *s5_a_im, *s5_log_dt, *s5_b_re, *s5_b_im, *s5_c_re, *s5_c_im, *s5_d, *s5_w_glu, *s5_b_glu, *s5_w_out;
  const float *gla_w_in, *gla_w_g2, *gla_b_g, *gla_norm, *gla_w_out;
  float* out;
  char* ws;
};

DI unsigned pk2(float a, float b) { f32x2 v; v.x = a; v.y = b; bfv2 r = __builtin_convertvector(v, bfv2); return __builtin_bit_cast(unsigned, r); }
DI u16 f2bf(float a) { return (u16)(pk2(a, 0.f) & 0xffffu); }
DI float bf2f(u16 v) { return __uint_as_float(((unsigned)v) << 16); }
DI float bflo(unsigned v) { return __uint_as_float(v << 16); }
DI float bfhi(unsigned v) { return __uint_as_float(v & 0xffff0000u); }
DI float siluf(float x) { return x / (1.f + __expf(-x)); }
DI float sigmf(float x) { return 1.f / (1.f + __expf(-x)); }
DI f32x4 ld_bf4(const u16* p) { const u32x2 v = *(const u32x2*)p; f32x4 o = {bflo(v.x), bfhi(v.x), bflo(v.y), bfhi(v.y)}; return o; }
DI int crow(int reg, int h) { return (reg & 3) + 8 * (reg >> 2) + 4 * h; }
DI void st_bf4(u16* p, float a, float b, float c, float d) { u32x2 v; v.x = pk2(a, b); v.y = pk2(c, d); *(u32x2*)p = v; }
DI bf16x8 pack8(const f32x16& x, int s) {
  u32x4 p;
  p.x = pk2(x[8 * s + 0], x[8 * s + 1]); p.y = pk2(x[8 * s + 2], x[8 * s + 3]);
  p.z = pk2(x[8 * s + 4], x[8 * s + 5]); p.w = pk2(x[8 * s + 6], x[8 * s + 7]);
  return __builtin_bit_cast(bf16x8, p);
}
DI bf16x8 cat4(s16x4 lo, s16x4 hi) { return __builtin_shufflevector(lo, hi, 0, 1, 2, 3, 4, 5, 6, 7); }
DI float wave_sum(float v) {
#pragma unroll
  for (int o = 32; o >= 1; o >>= 1) v += __shfl_xor(v, o);
  return v;
}
DI int tid_() { int t = threadIdx.x; asm volatile("" : "+v"(t)); return t; }
DI int cond_of(int T) { return T < NCTX ? 8 : ((T - NCTX) >> 10); }
DI int kvrow_of(int T) { return T < NCTX ? T : NCTX + ((T - NCTX) >> 10) * 1280 + ((T - NCTX) & 1023); }

DI void ada_phase(const Params& p, float* smem) {
  const int tid = tid_();
  float* mod = (float*)(p.ws + WS_MOD);
  for (int it = blockIdx.x; it < 384; it += gridDim.x) {
    const int l = it / 96, n0 = (it % 96) * 64;
    __syncthreads();
    for (int i = tid; i < 9 * 2048; i += 256) { const int cd = i >> 11, k = i & 2047; const float v = cd < 8 ? p.c[cd * 2048 + k] : p.c_ctx[k]; smem[i] = siluf(v); }
    __syncthreads();
    const int c4 = tid & 15, ks = tid >> 4;
    const float* w = p.ada_w + (size_t)l * 2048 * 6144 + n0 + c4 * 4;
    float acc[9][4];
#pragma unroll
    for (int cd = 0; cd < 9; ++cd)
#pragma unroll
      for (int e = 0; e < 4; ++e) acc[cd][e] = 0.f;
#pragma unroll 4
    for (int kk = 0; kk < 128; ++kk) {
      const int k = ks * 128 + kk;
      const f32x4 wv = __builtin_nontemporal_load((const f32x4*)(w + (size_t)k * 6144));
#pragma unroll
      for (int cd = 0; cd < 9; ++cd) {
        const float s = smem[cd * 2048 + k];
#pragma unroll
        for (int e = 0; e < 4; ++e) acc[cd][e] += s * wv[e];
      }
    }
    __syncthreads();
#pragma unroll
    for (int cd = 0; cd < 9; ++cd)
#pragma unroll
      for (int e = 0; e < 4; ++e) smem[(ks * 9 + cd) * 64 + c4 * 4 + e] = acc[cd][e];
    __syncthreads();
    for (int o = tid; o < 576; o += 256) {
      const int cd = o >> 6, col = o & 63;
      float s = 0.f;
#pragma unroll
      for (int k2 = 0; k2 < 16; ++k2) s += smem[(k2 * 9 + cd) * 64 + col];
      mod[(size_t)(l * 9 + cd) * 6144 + n0 + col] = s + p.ada_b[l * 6144 + n0 + col];
    }
  }
  __syncthreads();
}

DI void transpose_job(const float* __restrict__ src, u16* __restrict__ dst, int K, int N, int Npad, int ldw, float* tile) {
  const int tid = tid_();
  const int nkt = K / 64, total = nkt * (Npad / 64);
  for (int t = blockIdx.x; t < total; t += gridDim.x) {
    const int k0 = (t % nkt) * 64, n0 = (t / nkt) * 64;
    const int c = tid & 63, r0 = tid >> 6;
#pragma unroll
    for (int i = 0; i < 16; ++i) { const int r = r0 + 4 * i; tile[r * 65 + c] = (n0 + c < N) ? src[(size_t)(k0 + r) * N + n0 + c] : 0.f; }
    __syncthreads();
    const int n = tid >> 2, ks = (tid & 3) * 16;
    u32x4 v0, v1;
    v0.x = pk2(tile[(ks + 0) * 65 + n], tile[(ks + 1) * 65 + n]); v0.y = pk2(tile[(ks + 2) * 65 + n], tile[(ks + 3) * 65 + n]);
    v0.z = pk2(tile[(ks + 4) * 65 + n], tile[(ks + 5) * 65 + n]); v0.w = pk2(tile[(ks + 6) * 65 + n], tile[(ks + 7) * 65 + n]);
    v1.x = pk2(tile[(ks + 8) * 65 + n], tile[(ks + 9) * 65 + n]); v1.y = pk2(tile[(ks + 10) * 65 + n], tile[(ks + 11) * 65 + n]);
    v1.z = pk2(tile[(ks + 12) * 65 + n], tile[(ks + 13) * 65 + n]); v1.w = pk2(tile[(ks + 14) * 65 + n], tile[(ks + 15) * 65 + n]);
    u16* d = dst + (size_t)(n0 + n) * ldw + k0 + ks;
    *(u32x4*)d = v0; *(u32x4*)(d + 8) = v1;
    __syncthreads();
  }
}

DI void phase0(const Params& p, char* smem) {
  ada_phase(p, (float*)smem);
  float* tile = (float*)smem;
  char* ws = p.ws;
  for (int j = 0; j < 2; ++j) {
    transpose_job(p.mla_w_in + (size_t)j * 2048 * 5696, (u16*)(ws + WS_WT_MLA_IN) + (size_t)j * 5760 * LDW, 2048, 5696, 5760, LDW, tile);
    transpose_job(p.mla_w_ukv + (size_t)j * 512 * 4096, (u16*)(ws + WS_WT_MLA_UKV) + (size_t)j * 4096 * LDC, 512, 4096, 4096, LDC, tile);
    transpose_job(p.mla_w_out + (size_t)j * 2048 * 2048, (u16*)(ws + WS_WT_MLA_OUT) + (size_t)j * 2048 * LDW, 2048, 2048, 2048, LDW, tile);
  }
  transpose_job(p.s5_w_in, (u16*)(ws + WS_WT_S5_IN), 2048, 4096, 4096, LDW, tile);
  transpose_job(p.s5_w_glu, (u16*)(ws + WS_WT_S5_GLU), 2048, 2048, 2048, LDW, tile);
  transpose_job(p.s5_w_out, (u16*)(ws + WS_WT_S5_OUT), 2048, 2048, 2048, LDW, tile);
  transpose_job(p.gla_w_in, (u16*)(ws + WS_WT_GLA_IN), 2048, 6176, 6272, LDW, tile);
  transpose_job(p.gla_w_out, (u16*)(ws + WS_WT_GLA_OUT), 2048, 2048, 2048, LDW, tile);
}

DI void norm_phase(const Params& p, int l, bool first) {
  const int lane = tid_() & 63, wv = tid_() >> 6;
  const float* mod = (const float*)(p.ws + WS_MOD);
  const u16* OP = (const u16*)(p.ws + WS_OP);
  u16* H = (u16*)(p.ws + WS_H);
  for (int T = blockIdx.x * 4 + wv; T < NTOK; T += gridDim.x * 4) {
    const int cd = cond_of(T);
    const float* xin = T < NCTX ? p.x_prompt + (size_t)T * D : p.x_sample + (size_t)(T - NCTX) * D;
    float* xrow = p.out + (size_t)T * D;
    f32x4 x[8];
    if (first) {
#pragma unroll
      for (int j = 0; j < 8; ++j) x[j] = *(const f32x4*)(xin + (j * 64 + lane) * 4);
    } else {
      const float* xold = (l == 1) ? xin : xrow;
      const u16* op = OP + (size_t)T * D;
      f32x4 o[8];
      float ss = 0.f;
#pragma unroll
      for (int j = 0; j < 8; ++j) { o[j] = ld_bf4(op + (j * 64 + lane) * 4); ss += o[j][0] * o[j][0] + o[j][1] * o[j][1] + o[j][2] * o[j][2] + o[j][3] * o[j][3]; }
      ss = wave_sum(ss);
      const float rstd = rsqrtf(ss * (1.f / D) + EPS);
      const float* npost = p.norm_post + (l - 1) * D;
      const float* gate = mod + (size_t)((l - 1) * 9 + cd) * 6144 + 4096;
#pragma unroll
      for (int j = 0; j < 8; ++j) {
        const int col = (j * 64 + lane) * 4;
        const f32x4 xo = *(const f32x4*)(xold + col), np = *(const f32x4*)(npost + col), g = *(const f32x4*)(gate + col);
        x[j] = xo + g * (o[j] * rstd * np);
        *(f32x4*)(xrow + col) = x[j];
      }
    }
    if (l < 4) {
      float ss = 0.f;
#pragma unroll
      for (int j = 0; j < 8; ++j) ss += x[j][0] * x[j][0] + x[j][1] * x[j][1] + x[j][2] * x[j][2] + x[j][3] * x[j][3];
      ss = wave_sum(ss);
      const float rstd = rsqrtf(ss * (1.f / D) + EPS);
      const float* npre = p.norm_pre + l * D;
      const float* sh = mod + (size_t)(l * 9 + cd) * 6144;
      u16* hrow = H + (size_t)T * LDH;
#pragma unroll
      for (int j = 0; j < 8; ++j) {
        const int col = (j * 64 + lane) * 4;
        const f32x4 np = *(const f32x4*)(npre + col), s1 = *(const f32x4*)(sh + col), sc = *(const f32x4*)(sh + 2048 + col);
        const f32x4 hv = x[j] * rstd * np * (1.f + sc) + s1;
        st_bf4(hrow + col, hv[0], hv[1], hv[2], hv[3]);
      }
    }
  }
}

template <int BM, bool SWAP, class Epi>
DI void gemm_tile(const int w, const u16* __restrict__ A, int lda, const u16* __restrict__ Bt, int ldb, int K, int m0, int n0, const Epi& epi, char* smem) {
  u16* As = (u16*)smem;
  u16* Bs = As + 256 * 72;
  const int tid = tid_(), lane = tid & 63, r = lane & 31, h = lane >> 5;
  const int wm = w >> 1, wn = w & 1;
  const int lrow = tid >> 3, lseg = tid & 7;
  const __amdgpu_buffer_rsrc_t Ars = __builtin_amdgcn_make_buffer_rsrc((void*)(A + (size_t)m0 * lda), 0, 0x7fffffff, 0x00020000);
  const __amdgpu_buffer_rsrc_t Brs = __builtin_amdgcn_make_buffer_rsrc((void*)(Bt + (size_t)n0 * ldb), 0, 0x7fffffff, 0x00020000);
  const int aoff = (lrow * lda + lseg * 8) * 2, boff = (lrow * ldb + lseg * 8) * 2;
  constexpr int NA = BM / 32, NI = BM / 64;
  u32x4 ra[NA], rb[4];
  f32x16 acc[NI][2];
#pragma unroll
  for (int i = 0; i < NI; ++i)
#pragma unroll
    for (int j = 0; j < 2; ++j)
#pragma unroll
      for (int e = 0; e < 16; ++e) acc[i][j][e] = 0.f;
#define GT_GL(K0) { _Pragma("unroll") for (int q = 0; q < NA; ++q) ra[q] = __builtin_bit_cast(u32x4, __builtin_amdgcn_raw_buffer_load_b128(Ars, aoff, (32 * q * lda + (K0)) * 2, 0)); \
                    _Pragma("unroll") for (int q = 0; q < 4; ++q) rb[q] = __builtin_bit_cast(u32x4, __builtin_amdgcn_raw_buffer_load_b128(Brs, boff, (32 * q * ldb + (K0)) * 2, 0)); }
#define GT_LS() { _Pragma("unroll") for (int q = 0; q < NA; ++q) *(u32x4*)(As + (lrow + 32 * q) * 72 + lseg * 8) = ra[q]; \
                  _Pragma("unroll") for (int q = 0; q < 4; ++q) *(u32x4*)(Bs + (lrow + 32 * q) * 72 + lseg * 8) = rb[q]; }
  const int nk = K >> 6;
  GT_GL(0);
  __syncthreads();
  GT_LS();
  __syncthreads();
  const u16* as = As + (wm * (BM / 2) + r) * 72 + h * 8;
  const u16* bs = Bs + (wn * 64 + r) * 72 + h * 8;
  for (int kt = 0; kt < nk; ++kt) {
    { const int k1 = (kt + 1 < nk ? kt + 1 : kt) << 6; GT_GL(k1); }
    __builtin_amdgcn_sched_barrier(0);
    __builtin_amdgcn_s_setprio(2);
#pragma unroll
    for (int ks = 0; ks < 4; ++ks) {
      bf16x8 b[2];
#pragma unroll
      for (int j = 0; j < 2; ++j) b[j] = *(const bf16x8*)(bs + j * 32 * 72 + ks * 16);
#pragma unroll
      for (int i = 0; i < NI; ++i) {
        const bf16x8 a = *(const bf16x8*)(as + i * 32 * 72 + ks * 16);
#pragma unroll
        for (int j = 0; j < 2; ++j) acc[i][j] = SWAP ? MFMA32(b[j], a, acc[i][j]) : MFMA32(a, b[j], acc[i][j]);
      }
    }
    __builtin_amdgcn_s_setprio(0);
    __syncthreads();
    GT_LS();
    __syncthreads();
  }
#undef GT_GL
#undef GT_LS
  int lane2;
  asm volatile("v_mbcnt_lo_u32_b32 %0, -1, 0\n\tv_mbcnt_hi_u32_b32 %0, -1, %0" : "=v"(lane2));
  const int r2 = lane2 & 31, h2 = lane2 >> 5;
#pragma unroll
  for (int i = 0; i < NI; ++i)
#pragma unroll
    for (int j = 0; j < 2; ++j) epi(m0 + wm * (BM / 2) + i * 32, n0 + wn * 64 + j * 32, acc[i][j], r2, h2);
}

template <class F>
DI void for_tiles(int MT, int NT, const F& f) {
  const int G = gridDim.x;
  if ((G & 7) == 0 && (MT & 7) == 0) {
    const int G8 = G >> 3, xcd = blockIdx.x & 7, loc = blockIdx.x >> 3;
    const int SM = MT >> 3, SN = (NT + 7) >> 3, total = SM * SN * 64;
    for (int i = 0;; ++i) {
      const int u = (i * 8 + xcd) * G8 + loc;
      if (u >= total) break;
      const int sup = u >> 6, win = u & 63;
      const int mt = (sup % SM) * 8 + (win & 7), nt = (sup / SM) * 8 + (win >> 3);
      if (nt < NT) f(mt, nt);
    }
  } else {
    for (int t = blockIdx.x; t < MT * NT; t += G) f(t % MT, t / MT);
  }
}

DI void rope16(f32x16& v, int pos, int h) {
#pragma unroll
  for (int g = 0; g < 2; ++g)
#pragma unroll
    for (int e = 0; e < 4; ++e) {
      const int f = 8 * g + 4 * h + e;
      const float invf = exp2f(-(float)f * 0.83048202372184058696f);
      const float rev = ((float)pos * invf) * 0.15915494309189533577f;
      const float sn = __builtin_amdgcn_sinf(rev), cs = __builtin_amdgcn_cosf(rev);
      const float x1 = v[4 * g + e], x2 = v[4 * (g + 2) + e];
      v[4 * g + e] = x1 * cs - x2 * sn;
      v[4 * (g + 2) + e] = x1 * sn + x2 * cs;
    }
}

DI void mla_g1(const Params& p, int j, char* smem) {
  char* ws = p.ws;
  const u16* H = (const u16*)(ws + WS_H);
  const u16* Wt = (const u16*)(ws + WS_WT_MLA_IN) + (size_t)j * 5760 * LDW;
  auto epi = [&](int tm, int tn, const f32x16& acc, int r, int h) {
    char* ws2 = p.ws;
    u16* QB = (u16*)(ws2 + A_QB); float* CKVRAW = (float*)(ws2 + A_CKVRAW); u16* SG = (u16*)(ws2 + A_SGATE); u16* KB = (u16*)(ws2 + A_KB);
    float* okr = p.out + OUT_KROPE;
    const int m = tm + r;
    if (tn < 3072) {
      const int within = tn % 192;
      f32x16 v = acc;
      if (within >= 128 && m >= NCTX) { const int tl = (m - NCTX) & 1023; rope16(v, within < 160 ? (tl >> 6) : (tl & 63), h); }
#pragma unroll
      for (int g = 0; g < 4; ++g) st_bf4(QB + (size_t)m * 3072 + tn + 8 * g + 4 * h, v[4 * g], v[4 * g + 1], v[4 * g + 2], v[4 * g + 3]);
    } else if (tn < 3584) {
#pragma unroll
      for (int g = 0; g < 4; ++g) { f32x4 o = {acc[4 * g], acc[4 * g + 1], acc[4 * g + 2], acc[4 * g + 3]}; *(f32x4*)(CKVRAW + (size_t)m * 512 + (tn - 3072) + 8 * g + 4 * h) = o; }
    } else if (tn < 3648) {
      f32x16 v = acc;
      const int c0 = tn - 3584;
      if (m >= NCTX) { const int tl = (m - NCTX) & 1023; rope16(v, c0 == 0 ? (tl >> 6) : (tl & 63), h); }
      else {
        const int b = m >> 8, t = m & 255;
#pragma unroll
        for (int g = 0; g < 4; ++g) { f32x4 o = {v[4 * g], v[4 * g + 1], v[4 * g + 2], v[4 * g + 3]}; *(f32x4*)(okr + ((size_t)(b * 2 + j) * 256 + t) * 64 + c0 + 8 * g + 4 * h) = o; }
      }
      const size_t R = kvrow_of(m);
      for (int hd = 0; hd < 16; ++hd)
#pragma unroll
        for (int g = 0; g < 4; ++g) st_bf4(KB + R * LDKB + hd * 192 + 128 + c0 + 8 * g + 4 * h, v[4 * g], v[4 * g + 1], v[4 * g + 2], v[4 * g + 3]);
    } else if (tn < 5696) {
#pragma unroll
      for (int g = 0; g < 4; ++g) st_bf4(SG + (size_t)m * 2048 + (tn - 3648) + 8 * g + 4 * h, siluf(acc[4 * g]), siluf(acc[4 * g + 1]), siluf(acc[4 * g + 2]), siluf(acc[4 * g + 3]));
    }
  };
  const int wv_ = __builtin_amdgcn_readfirstlane(tid_() >> 6);
  for_tiles(48, 45, [&](int mt, int nt) { gemm_tile<256, true>(wv_, H, LDH, Wt, LDW, 2048, mt * 256, nt * 128, epi, smem); });
}

DI void mla_a2(const Params& p, int j) {
  char* ws = p.ws;
  const int lane = tid_() & 63, wv = tid_() >> 6;
  const float* CKVRAW = (const float*)(ws + A_CKVRAW); u16* CKVALL = (u16*)(ws + A_CKVALL); u16* KB = (u16*)(ws + A_KB);
  const float* kvn = p.mla_kv_norm + j * 512;
  float* ockv = p.out + OUT_CKV;
  for (int R = blockIdx.x * 4 + wv; R < 14336; R += gridDim.x * 4) {
    int T = -1, cb = 0, ct = 0;
    if (R < NCTX) T = R;
    else { const int r2 = R - NCTX; cb = r2 / 1280; const int tp = r2 - cb * 1280; if (tp < 1024) T = NCTX + cb * 1024 + tp; else ct = tp - 1024; }
    u16* dst = CKVALL + (size_t)R * LDC;
    if (T >= 0) {
      const float* src = CKVRAW + (size_t)T * 512;
      const f32x4 a = *(const f32x4*)(src + lane * 4), b = *(const f32x4*)(src + 256 + lane * 4);
      float ss = a[0] * a[0] + a[1] * a[1] + a[2] * a[2] + a[3] * a[3] + b[0] * b[0] + b[1] * b[1] + b[2] * b[2] + b[3] * b[3];
      ss = wave_sum(ss);
      const float rstd = rsqrtf(ss * (1.f / 512.f) + EPS);
      const f32x4 g0 = *(const f32x4*)(kvn + lane * 4), g1 = *(const f32x4*)(kvn + 256 + lane * 4);
      const f32x4 y0 = a * rstd * g0, y1 = b * rstd * g1;
      st_bf4(dst + lane * 4, y0[0], y0[1], y0[2], y0[3]);
      st_bf4(dst + 256 + lane * 4, y1[0], y1[1], y1[2], y1[3]);
      if (T < NCTX) {
        float* o = ockv + ((size_t)((T >> 8) * 2 + j) * 256 + (T & 255)) * 512;
        *(f32x4*)(o + lane * 4) = y0; *(f32x4*)(o + 256 + lane * 4) = y1;
      }
    } else {
      const float* src = p.cache_ckv + ((size_t)(cb * 2 + j) * 256 + ct) * 512;
      const f32x4 a = *(const f32x4*)(src + lane * 4), b = *(const f32x4*)(src + 256 + lane * 4);
      st_bf4(dst + lane * 4, a[0], a[1], a[2], a[3]);
      st_bf4(dst + 256 + lane * 4, b[0], b[1], b[2], b[3]);
      const float kr = p.cache_krope[((size_t)(cb * 2 + j) * 256 + ct) * 64 + lane];
      const u16 kb = f2bf(kr);
      for (int hd = 0; hd < 16; ++hd) KB[(size_t)R * LDKB + hd * 192 + 128 + lane] = kb;
    }
  }
}

DI void mla_g2(const Params& p, int j, char* smem) {
  char* ws = p.ws;
  const u16* CKVALL = (const u16*)(ws + A_CKVALL);
  const u16* Wt = (const u16*)(ws + WS_WT_MLA_UKV) + (size_t)j * 4096 * LDC;
  u16* KB = (u16*)(ws + A_KB); u16* VT = (u16*)(ws + A_VT);
  auto epiK = [&](int tm, int tn, const f32x16& acc, int r, int h) {
    const size_t R = tm + r; const int hd = tn >> 8, wi = tn & 255;
#pragma unroll
    for (int g = 0; g < 4; ++g) st_bf4(KB + R * LDKB + hd * 192 + wi + 8 * g + 4 * h, acc[4 * g], acc[4 * g + 1], acc[4 * g + 2], acc[4 * g + 3]);
  };
  auto epiV = [&](int tm, int tn, const f32x16& acc, int r, int h) {
    const int n = tn + r; const int hd = n >> 8, d = (n & 255) - 128;
    size_t base; int nkeys, key0;
    if (tm < NCTX) { base = (size_t)(tm >> 8) * 256 * 2048; nkeys = 256; key0 = tm & 255; }
    else { const int r2 = tm - NCTX; const int b = r2 / 1280; base = (size_t)NCTX * 2048 + (size_t)b * 1280 * 2048; nkeys = 1280; key0 = r2 - b * 1280; }
    u16* dst = VT + base + (size_t)(hd * 128 + d) * nkeys + key0;
#pragma unroll
    for (int g = 0; g < 4; ++g) st_bf4(dst + 8 * g + 4 * h, acc[4 * g], acc[4 * g + 1], acc[4 * g + 2], acc[4 * g + 3]);
  };
  const int wv_ = __builtin_amdgcn_readfirstlane(tid_() >> 6);
  for_tiles(56, 32, [&](int mt, int nt) {
    if ((nt & 1) == 0) gemm_tile<256, true>(wv_, CKVALL, LDC, Wt, LDC, 512, mt * 256, nt * 128, epiK, smem);
    else gemm_tile<256, false>(wv_, CKVALL, LDC, Wt, LDC, 512, mt * 256, nt * 128, epiV, smem);
  });
}

DI void mla_attn(const Params& p, char* smem) {
  char* ws = p.ws;
  const u16* QB = (const u16*)(ws + A_QB); const u16* KB = (const u16*)(ws + A_KB); const u16* VT = (const u16*)(ws + A_VT); const u16* SG = (const u16*)(ws + A_SGATE);
  u16* OG = (u16*)(ws + WS_H);
  char* Ks = smem;
  char* Vs = smem + 25600;
  const int tid = tid_();
  const int lane = tid & 63, w = tid >> 6, r = lane & 31, h = lane >> 5;
  const float SC = 0.07216878364870322f * 1.4426950408889634f;
  for (int it = blockIdx.x; it < 1536; it += gridDim.x) {
    int head, T0, R0, nkeys; size_t vbase;
    if (it < 1024) { const int b = it >> 7; head = (it >> 3) & 15; T0 = NCTX + b * 1024 + (it & 7) * 128; R0 = NCTX + b * 1280; nkeys = 1280; vbase = (size_t)NCTX * 2048 + (size_t)b * 1280 * 2048; }
    else { const int i2 = it - 1024; const int b = i2 >> 5; head = (i2 >> 1) & 15; T0 = b * 256 + (i2 & 1) * 128; R0 = b * 256; nkeys = 256; vbase = (size_t)b * 256 * 2048; }
    T0 += w * 32;
    bf16x8 qf[12];
    const u16* qp = QB + (size_t)(T0 + r) * 3072 + head * 192 + 8 * h;
#pragma unroll
    for (int ks = 0; ks < 12; ++ks) qf[ks] = *(const bf16x8*)(qp + ks * 16);
    f32x16 O[4];
#pragma unroll
    for (int dt = 0; dt < 4; ++dt)
#pragma unroll
      for (int e = 0; e < 16; ++e) O[dt][e] = 0.f;
    float mrun = -INFINITY, lrun = 0.f;
    const u16* kg = KB + (size_t)R0 * LDKB + head * 192;
    const u16* vg = VT + vbase + (size_t)(head * 128) * nkeys;
    u32x4 rk[6], rv[4];
    const __amdgpu_buffer_rsrc_t Krs = __builtin_amdgcn_make_buffer_rsrc((void*)kg, 0, 0x7fffffff, 0x00020000);
    const __amdgpu_buffer_rsrc_t Vrs = __builtin_amdgcn_make_buffer_rsrc((void*)vg, 0, 0x7fffffff, 0x00020000);
    const int kvo = (tid >> 2) * (LDKB * 2) + (tid & 3) * 16;
    const int vvo = (tid >> 3) * nkeys * 2 + (tid & 7) * 16;
#define AT_LOAD(KT0) { _Pragma("unroll") for (int i = 0; i < 6; ++i) rk[i] = __builtin_bit_cast(u32x4, __builtin_amdgcn_raw_buffer_load_b128(Krs, kvo + 64 * i, (KT0) * (LDKB * 2), 0)); \
                       _Pragma("unroll") for (int i = 0; i < 4; ++i) rv[i] = __builtin_bit_cast(u32x4, __builtin_amdgcn_raw_buffer_load_b128(Vrs, vvo, (32 * i * nkeys + (KT0)) * 2, 0)); }
#define AT_STORE() { _Pragma("unroll") for (int i = 0; i < 6; ++i) *(u32x4*)(Ks + (tid >> 2) * 400 + ((tid & 3) + 4 * i) * 16) = rk[i]; \
                     _Pragma("unroll") for (int i = 0; i < 4; ++i) { const int sg = tid & 7; char* d = Vs + ((tid >> 3) + 32 * i) * 144 + (sg >> 1) * 32 + (sg & 1) * 8; \
                       u32x2 lo, hi; lo.x = rv[i].x; lo.y = rv[i].y; hi.x = rv[i].z; hi.y = rv[i].w; *(u32x2*)d = lo; *(u32x2*)(d + 16) = hi; } }
    AT_LOAD(0);
    __syncthreads();
    AT_STORE();
    __syncthreads();
    for (int kt0 = 0; kt0 < nkeys; kt0 += 64) {
      { const int kn = kt0 + 64 < nkeys ? kt0 + 64 : kt0; AT_LOAD(kn); }
#pragma unroll
      for (int sub = 0; sub < 2; ++sub) {
        f32x16 S;
#pragma unroll
        for (int e = 0; e < 16; ++e) S[e] = 0.f;
#pragma unroll
        for (int ks = 0; ks < 12; ++ks) { const bf16x8 kf = *(const bf16x8*)(Ks + (sub * 32 + r) * 400 + ks * 32 + h * 16); S = MFMA32(kf, qf[ks], S); }
        float mx = -INFINITY;
#pragma unroll
        for (int e = 0; e < 16; ++e) { S[e] *= SC; mx = fmaxf(mx, S[e]); }
        mx = fmaxf(mx, __shfl_xor(mx, 32));
        const float mnew = fmaxf(mrun, mx);
        const float alpha = __builtin_amdgcn_exp2f(mrun - mnew);
        mrun = mnew;
        float ps = 0.f;
#pragma unroll
        for (int e = 0; e < 16; ++e) { S[e] = __builtin_amdgcn_exp2f(S[e] - mnew); ps += S[e]; }
        lrun = lrun * alpha + ps;
#pragma unroll
        for (int dt = 0; dt < 4; ++dt)
#pragma unroll
          for (int e = 0; e < 16; ++e) O[dt][e] *= alpha;
#pragma unroll
        for (int s = 0; s < 2; ++s) {
          const bf16x8 pf = pack8(S, s);
#pragma unroll
          for (int dt = 0; dt < 4; ++dt) {
            const bf16x8 vf = *(const bf16x8*)(Vs + (dt * 32 + r) * 144 + (sub * 2 + s) * 32 + h * 16);
            O[dt] = MFMA32(vf, pf, O[dt]);
          }
        }
      }
      __syncthreads();
      AT_STORE();
      __syncthreads();
    }
#undef AT_LOAD
#undef AT_STORE
    lrun += __shfl_xor(lrun, 32);
    const float inv = 1.f / lrun;
#pragma unroll
    for (int dt = 0; dt < 4; ++dt)
#pragma unroll
      for (int g = 0; g < 4; ++g) {
        const size_t o = (size_t)(T0 + r) * 2048 + head * 128 + dt * 32 + 8 * g + 4 * h;
        const size_t oo = (size_t)(T0 + r) * LDH + head * 128 + dt * 32 + 8 * g + 4 * h;
        const u32x2 sg = *(const u32x2*)(SG + o);
        st_bf4(OG + oo, O[dt][4 * g] * inv * bflo(sg.x), O[dt][4 * g + 1] * inv * bfhi(sg.x), O[dt][4 * g + 2] * inv * bflo(sg.y), O[dt][4 * g + 3] * inv * bfhi(sg.y));
      }
  }
}

DI void gemm_out(const Params& p, const u16* A, const u16* Wt, char* smem) {
  u16* OP = (u16*)(p.ws + WS_OP);
  auto epi = [&](int tm, int tn, const f32x16& acc, int r, int h) {
    const size_t m = tm + r;
#pragma unroll
    for (int g = 0; g < 4; ++g) st_bf4(OP + m * 2048 + tn + 8 * g + 4 * h, acc[4 * g], acc[4 * g + 1], acc[4 * g + 2], acc[4 * g + 3]);
  };
  const int wv_ = __builtin_amdgcn_readfirstlane(tid_() >> 6);
  for_tiles(96, 16, [&](int mt, int nt) { gemm_tile<128, true>(wv_, A, LDH, Wt, LDW, 2048, mt * 128, nt * 128, epi, smem); });
}

DI void s5_g1(const Params& p, char* smem) {
  char* ws = p.ws;
  const u16* H = (const u16*)(ws + WS_H); const u16* Wt = (const u16*)(ws + WS_WT_S5_IN);
  u16* U = (u16*)(ws + B_U); u16* SG = (u16*)(ws + B_SGATE);
  auto epi = [&](int tm, int tn, const f32x16& acc, int r, int h) {
    const size_t m = tm + r;
    if (tn < 2048) {
#pragma unroll
      for (int g = 0; g < 4; ++g) st_bf4(U + m * 2048 + tn + 8 * g + 4 * h, acc[4 * g], acc[4 * g + 1], acc[4 * g + 2], acc[4 * g + 3]);
    } else {
#pragma unroll
      for (int g = 0; g < 4; ++g) st_bf4(SG + m * 2048 + (tn - 2048) + 8 * g + 4 * h, siluf(acc[4 * g]), siluf(acc[4 * g + 1]), siluf(acc[4 * g + 2]), siluf(acc[4 * g + 3]));
    }
  };
  const int wv_ = __builtin_amdgcn_readfirstlane(tid_() >> 6);
  for_tiles(48, 32, [&](int mt, int nt) { gemm_tile<256, true>(wv_, H, LDH, Wt, LDW, 2048, mt * 256, nt * 128, epi, smem); });
}

DI void s5_scan(const Params& p, char* smem) {
  char* ws = p.ws;
  const u16* U = (const u16*)(ws + B_U);
  u16* YF = (u16*)(ws + WS_OP); u16* YB = (u16*)(ws + B_YB);
  const int tid = tid_();
  const int lane = tid & 63;
  const int w = __builtin_amdgcn_readfirstlane(tid >> 6);
  char* Hs = smem + w * 12800;
  char* BUs = Hs + 4352;
  const int pcol = lane & 15, quad = lane >> 4;
  for (int it = blockIdx.x * 4 + w; it < 6144; it += gridDim.x * 4) {
    const int g = ((it >> 2) & 31) * 4 + (it & 3);
    const int db = it >> 7, dir = db & 1, bseq = db >> 1;
    const bool lat = bseq < 8;
    int b, L, T0;
    if (lat) { b = bseq; L = 1024; T0 = NCTX + b * 1024; }
    else { b = bseq - 8; L = 256; T0 = b * 256; }
    const int n = lane;
    const int pidx = (dir * 128 + g) * 64 + n;
    const float are = p.s5_a_re[pidx], aim = p.s5_a_im[pidx];
    const float dt = __expf(p.s5_log_dt[dir * 128 + g]);
    const float mag = __expf(are * dt), rev = (aim * dt) * 0.15915494309189533577f;
    const float abr = mag * __builtin_amdgcn_cosf(rev), abi = mag * __builtin_amdgcn_sinf(rev);
    const float nr = abr - 1.f, ni = abi, den = 1.f / (are * are + aim * aim);
    const float cr = (nr * are + ni * aim) * den, ci = (ni * are - nr * aim) * den;
    {
      const float* br = p.s5_b_re + (size_t)pidx * 16; const float* bi = p.s5_b_im + (size_t)pidx * 16;
      u32x4 re0, re1, im0, im1;
      {
        const f32x4 x0 = *(const f32x4*)(br), x1 = *(const f32x4*)(br + 4), x2 = *(const f32x4*)(br + 8), x3 = *(const f32x4*)(br + 12);
        const f32x4 y0 = *(const f32x4*)(bi), y1 = *(const f32x4*)(bi + 4), y2 = *(const f32x4*)(bi + 8), y3 = *(const f32x4*)(bi + 12);
        const f32x4 r0 = cr * x0 - ci * y0, r1 = cr * x1 - ci * y1, r2 = cr * x2 - ci * y2, r3 = cr * x3 - ci * y3;
        const f32x4 i0 = cr * y0 + ci * x0, i1 = cr * y1 + ci * x1, i2 = cr * y2 + ci * x2, i3 = cr * y3 + ci * x3;
        re0.x = pk2(r0[0], r0[1]); re0.y = pk2(r0[2], r0[3]); re0.z = pk2(r1[0], r1[1]); re0.w = pk2(r1[2], r1[3]);
        re1.x = pk2(r2[0], r2[1]); re1.y = pk2(r2[2], r2[3]); re1.z = pk2(r3[0], r3[1]); re1.w = pk2(r3[2], r3[3]);
        im0.x = pk2(i0[0], i0[1]); im0.y = pk2(i0[2], i0[3]); im0.z = pk2(i1[0], i1[1]); im0.w = pk2(i1[2], i1[3]);
        im1.x = pk2(i2[0], i2[1]); im1.y = pk2(i2[2], i2[3]); im1.z = pk2(i3[0], i3[1]); im1.w = pk2(i3[2], i3[3]);
      }
      char* d = BUs + n * 64;
      *(u32x4*)(d) = re0; *(u32x4*)(d + 16) = re1; *(u32x4*)(d + 32) = im0; *(u32x4*)(d + 48) = im1;
    }
    bf16x8 bfr[8];
#pragma unroll
    for (int nt = 0; nt < 8; ++nt) {
      u32x4 v = {0u, 0u, 0u, 0u};
      if (quad < 2) v = *(const u32x4*)(BUs + (16 * nt + pcol) * 32 + quad * 16);
      bfr[nt] = __builtin_bit_cast(bf16x8, v);
    }
    bf16x8 cf[4];
    {
      const float* c1 = p.s5_c_re + ((size_t)(dir * 128 + g) * 16 + pcol) * 64; const float* c2 = p.s5_c_im + ((size_t)(dir * 128 + g) * 16 + pcol) * 64;
#pragma unroll
      for (int s = 0; s < 4; ++s) {
        const f32x4 x = *(const f32x4*)(c1 + 16 * s + 4 * quad), y = *(const f32x4*)(c2 + 16 * s + 4 * quad);
        u32x4 pk; pk.x = pk2(x[0], -y[0]); pk.y = pk2(x[1], -y[1]); pk.z = pk2(x[2], -y[2]); pk.w = pk2(x[3], -y[3]);
        cf[s] = __builtin_bit_cast(bf16x8, pk);
      }
    }
    float hr = 0.f, hi = 0.f;
    if (lat) { const float* s0 = p.state_s5 + ((size_t)((b * 2 + dir) * 128 + g) * 64 + n) * 2; hr = s0[0]; hi = s0[1]; }
    u16* Y = dir ? YB : YF;
    const int t0 = dir ? L - 1 : 0, tstep = dir ? -1 : 1;
    const u16* ub = U + (size_t)T0 * 2048 + g * 16 + (quad & 1) * 8;
    u32x4 ua = {0u, 0u, 0u, 0u};
    if (quad < 2) ua = *(const u32x4*)(ub + (size_t)(t0 + tstep * pcol) * 2048);
    for (int s0_ = 0; s0_ < L; s0_ += 16) {
      const int tchunk = t0 + tstep * s0_;
      const bf16x8 af = __builtin_bit_cast(bf16x8, ua);
      if (s0_ + 16 < L && quad < 2) ua = *(const u32x4*)(ub + (size_t)(tchunk + tstep * (16 + pcol)) * 2048);
#pragma unroll
      for (int nt = 0; nt < 8; ++nt) {
        f32x4 z = {0.f, 0.f, 0.f, 0.f};
        z = __builtin_amdgcn_mfma_f32_16x16x32_bf16(af, bfr[nt], z, 0, 0, 0);
#pragma unroll
        for (int i = 0; i < 4; ++i) *(float*)(BUs + (4 * quad + i) * 528 + (16 * nt + pcol) * 4) = z[i];
      }
#pragma unroll 4
      for (int row = 0; row < 16; ++row) {
        const f32x2 bu = *(const f32x2*)(BUs + row * 528 + n * 8);
        const float nhr = abr * hr - abi * hi + bu.x, nhi = abr * hi + abi * hr + bu.y;
        hr = nhr; hi = nhi;
        if (!lat && s0_ == 0 && row == 0) { float* so = p.out + OUT_S5 + ((size_t)((b * 2 + dir) * 128 + g) * 64 + n) * 2; so[0] = hr; so[1] = hi; }
        *(unsigned*)(Hs + row * 272 + n * 4) = pk2(hr, hi);
      }
      f32x4 yacc = {0.f, 0.f, 0.f, 0.f};
#pragma unroll
      for (int s = 0; s < 4; ++s) {
        const bf16x8 hf = *(const bf16x8*)(Hs + pcol * 272 + s * 64 + quad * 16);
        yacc = __builtin_amdgcn_mfma_f32_16x16x32_bf16(hf, cf[s], yacc, 0, 0, 0);
      }
#pragma unroll
      for (int i = 0; i < 4; ++i) { const int tok = tchunk + tstep * (4 * quad + i); Y[(size_t)(T0 + tok) * 2048 + g * 16 + pcol] = f2bf(yacc[i]); }
    }
  }
}

DI float gelu_tanh(float x) {
  const float t = 0.7978845608028654f * (x + 0.044715f * x * x * x);
  const float e = __expf(2.f * t);
  const float th = 1.f - 2.f / (e + 1.f);
  return 0.5f * x * (1.f + th);
}

DI void s5_combine(const Params& p) {
  char* ws = p.ws;
  const u16* U = (const u16*)(ws + B_U); const u16* YF = (const u16*)(ws + WS_OP); const u16* YB = (const u16*)(ws + B_YB);
  u16* YG = (u16*)(ws + WS_H);
  const size_t n4 = (size_t)NTOK * 2048 / 4;
  for (size_t i = (size_t)blockIdx.x * 256 + tid_(); i < n4; i += (size_t)gridDim.x * 256) {
    const int col = (int)((i * 4) & 2047);
    const f32x4 u = ld_bf4(U + i * 4), a = ld_bf4(YF + i * 4), b = ld_bf4(YB + i * 4), d = *(const f32x4*)(p.s5_d + col);
    const f32x4 y = d * u + a + b;
    st_bf4(YG + ((i * 4) >> 11) * LDH + col, gelu_tanh(y[0]), gelu_tanh(y[1]), gelu_tanh(y[2]), gelu_tanh(y[3]));
  }
}

DI void s5_g2(const Params& p, char* smem) {
  char* ws = p.ws;
  const u16* YG = (const u16*)(ws + WS_H); const u16* Wt = (const u16*)(ws + WS_WT_S5_GLU); const u16* SG = (const u16*)(ws + B_SGATE);
  u16* Z = (u16*)(ws + B_Z);
  auto epi = [&](int tm, int tn, const f32x16& acc, int r, int h) {
    const size_t m = tm + r;
#pragma unroll
    for (int g = 0; g < 4; ++g) {
      const int n = tn + 8 * g + 4 * h;
      const f32x4 bg = *(const f32x4*)(p.s5_b_glu + n);
      const u32x2 yv = *(const u32x2*)(YG + m * LDH + n), sg = *(const u32x2*)(SG + m * 2048 + n);
      st_bf4(Z + m * LDH + n, bflo(yv.x) * sigmf(acc[4 * g] + bg[0]) * bflo(sg.x), bfhi(yv.x) * sigmf(acc[4 * g + 1] + bg[1]) * bfhi(sg.x),
             bflo(yv.y) * sigmf(acc[4 * g + 2] + bg[2]) * bflo(sg.y), bfhi(yv.y) * sigmf(acc[4 * g + 3] + bg[3]) * bfhi(sg.y));
    }
  };
  const int wv_ = __builtin_amdgcn_readfirstlane(tid_() >> 6);
  for_tiles(96, 16, [&](int mt, int nt) { gemm_tile<128, true>(wv_, YG, LDH, Wt, LDW, 2048, mt * 128, nt * 128, epi, smem); });
}

DI void gla_g1(const Params& p, char* smem) {
  char* ws = p.ws;
  const u16* H = (const u16*)(ws + WS_H); const u16* Wt = (const u16*)(ws + WS_WT_GLA_IN);
  u16* VT = (u16*)(ws + C_VT);
  auto epi = [&](int tm, int tn, const f32x16& acc, int r, int h) {
    char* ws2 = p.ws;
    u16* QG = (u16*)(ws2 + C_QG); u16* KG = (u16*)(ws2 + C_KG); u16* SG = (u16*)(ws2 + C_SGATE); float* GLR = (float*)(ws2 + C_GLR);
    const size_t m = tm + r;
    if (tn < 1024) {
#pragma unroll
      for (int g = 0; g < 4; ++g) st_bf4(QG + m * 1024 + tn + 8 * g + 4 * h, acc[4 * g] * 0.0625f, acc[4 * g + 1] * 0.0625f, acc[4 * g + 2] * 0.0625f, acc[4 * g + 3] * 0.0625f);
    } else if (tn < 2048) {
#pragma unroll
      for (int g = 0; g < 4; ++g) st_bf4(KG + m * 1024 + (tn - 1024) + 8 * g + 4 * h, acc[4 * g], acc[4 * g + 1], acc[4 * g + 2], acc[4 * g + 3]);
    } else if (tn >= 4096 && tn < 6144) {
#pragma unroll
      for (int g = 0; g < 4; ++g) st_bf4(SG + m * 2048 + (tn - 4096) + 8 * g + 4 * h, siluf(acc[4 * g]), siluf(acc[4 * g + 1]), siluf(acc[4 * g + 2]), siluf(acc[4 * g + 3]));
    } else if (tn == 6144) {
#pragma unroll
      for (int g = 0; g < 4; ++g) { f32x4 o = {acc[4 * g], acc[4 * g + 1], acc[4 * g + 2], acc[4 * g + 3]}; *(f32x4*)(GLR + m * 32 + 8 * g + 4 * h) = o; }
    }
  };
  auto epiV = [&](int tm, int tn, const f32x16& acc, int r, int h) {
    const int dv = tn - 2048 + r;
    u16* dst = VT + ((size_t)(tm >> 6) * 2048 + dv) * 64 + (tm & 63);
#pragma unroll
    for (int g = 0; g < 4; ++g) st_bf4(dst + 8 * g + 4 * h, acc[4 * g], acc[4 * g + 1], acc[4 * g + 2], acc[4 * g + 3]);
  };
  const int wv_ = __builtin_amdgcn_readfirstlane(tid_() >> 6);
  for_tiles(48, 49, [&](int mt, int nt) {
    if (nt >= 16 && nt < 32) gemm_tile<256, false>(wv_, H, LDH, Wt, LDW, 2048, mt * 256, nt * 128, epiV, smem);
    else gemm_tile<256, true>(wv_, H, LDH, Wt, LDW, 2048, mt * 256, nt * 128, epi, smem);
  });
}

DI float logsigf(float z) { return fminf(z, 0.f) - __logf(1.f + __expf(-fabsf(z))); }

DI void gla_gate(const Params& p, float* smem) {
  char* ws = p.ws;
  const u16* QG = (const u16*)(ws + C_QG); const u16* KG = (const u16*)(ws + C_KG); const float* GLR = (const float*)(ws + C_GLR);
  u16* QT = (u16*)(ws + C_QT); u16* KT = (u16*)(ws + C_KT); u16* KDT = (u16*)(ws + C_KDT); float* DN = (float*)(ws + C_DN);
  const int tid = tid_();
  for (int it = blockIdx.x; it < 1536; it += gridDim.x) {
    const int dir = it & 1, hd = (it >> 1) & 3, c = it >> 3;
    const int ch = hd * 256 + tid;
    __syncthreads();
    for (int i = tid; i < 1024; i += 256) smem[i] = GLR[(size_t)(c * 64 + (i >> 4)) * 32 + dir * 16 + (i & 15)];
    __syncthreads();
    float wg[16];
#pragma unroll
    for (int q = 0; q < 16; ++q) wg[q] = p.gla_w_g2[(size_t)(dir * 16 + q) * 1024 + ch];
    const float bg = p.gla_b_g[dir * 1024 + ch];
    float tot = 0.f;
    for (int i = 0; i < 64; ++i) {
      float z = bg;
#pragma unroll
      for (int q = 0; q < 16; ++q) z += smem[i * 16 + q] * wg[q];
      tot += logsigf(z) * 0.0625f;
    }
    DN[(size_t)(dir * 192 + c) * 1024 + ch] = __expf(tot);
    float run = 0.f;
    u16* kdrow = KDT + ((size_t)((dir * 192 + c) * 4 + hd) * 256 + tid) * 64;
    for (int i8 = 0; i8 < 8; ++i8) {
      float kdv[8];
#pragma unroll
      for (int e = 0; e < 8; ++e) {
        const int ii = i8 * 8 + e;
        const int i = dir ? 63 - ii : ii;
        float z = bg;
#pragma unroll
        for (int q = 0; q < 16; ++q) z += smem[i * 16 + q] * wg[q];
        run += logsigf(z) * 0.0625f;
        const size_t T = (size_t)c * 64 + i;
        const float q_ = bf2f(QG[T * 1024 + ch]), k_ = bf2f(KG[T * 1024 + ch]);
        QT[((size_t)dir * NTOK + T) * LDQ + ch] = f2bf(q_ * __expf(run));
        KT[((size_t)dir * NTOK + T) * LDQ + ch] = f2bf(k_ * __expf(-run));
        kdv[e] = k_ * __expf(tot - run);
      }
      u32x4 pk;
      if (dir) { pk.x = pk2(kdv[7], kdv[6]); pk.y = pk2(kdv[5], kdv[4]); pk.z = pk2(kdv[3], kdv[2]); pk.w = pk2(kdv[1], kdv[0]); }
      else { pk.x = pk2(kdv[0], kdv[1]); pk.y = pk2(kdv[2], kdv[3]); pk.z = pk2(kdv[4], kdv[5]); pk.w = pk2(kdv[6], kdv[7]); }
      const int tb = dir ? 56 - i8 * 8 : i8 * 8;
      *(u32x4*)(kdrow + tb) = pk;
    }
  }
  __syncthreads();
}

DI void gla_main(const Params& p, char* smem) {
  char* ws = p.ws;
  const u16* QT = (const u16*)(ws + C_QT); const u16* KT = (const u16*)(ws + C_KT); const u16* KDT = (const u16*)(ws + C_KDT); const u16* VT = (const u16*)(ws + C_VT);
  const float* DN = (const float*)(ws + C_DN);
  u16* OF = (u16*)(ws + WS_OP); u16* OB = (u16*)(ws + C_OB);
  char* buf = smem;
  u16* att = (u16*)(smem + 36864);
  float* dns = (float*)(smem + 36864 + 9216);
  const int tid = tid_();
  const int lane = tid & 63, w = tid >> 6, r = lane & 31, h = lane >> 5;
  for (int it = blockIdx.x; it < 768; it += gridDim.x) {
    const bool lat = it < 256;
    const int i2 = lat ? it : it - 256;
    const int bs = i2 >> 5, hd = (i2 >> 3) & 3, dir = (i2 >> 2) & 1, sl = i2 & 3;
    const int nc = lat ? 16 : 4, T0 = lat ? NCTX + bs * 1024 : bs * 256;
    const int vcol0 = hd * 512 + sl * 128 + w * 32;
    f32x16 S[8];
    if (lat) {
      const float* s0 = p.state_gla + ((size_t)((bs * 2 + dir) * 4 + hd) * 256) * 512 + (sl * 128 + w * 32 + r);
#pragma unroll
      for (int mt = 0; mt < 8; ++mt)
#pragma unroll
        for (int e = 0; e < 16; ++e) S[mt][e] = s0[(size_t)(32 * mt + crow(e, h)) * 512];
    } else {
#pragma unroll
      for (int mt = 0; mt < 8; ++mt)
#pragma unroll
        for (int e = 0; e < 16; ++e) S[mt][e] = 0.f;
    }
    u16* OD = dir ? OB : OF;
    for (int cc = 0; cc < nc; ++cc) {
      const int c = dir ? nc - 1 - cc : cc;
      const int Tc = T0 + c * 64, cgx = Tc >> 6;
      const u16* kt = KT + ((size_t)dir * NTOK + Tc) * LDQ + hd * 256;
      const u16* kdT = KDT + ((size_t)((dir * 192 + cgx) * 4 + hd) * 256) * 64;
      const u16* vT = VT + ((size_t)cgx * 2048 + vcol0 + r) * 64;
      {
        u32x4 rq[8];
        const u16* qt = QT + ((size_t)dir * NTOK + Tc) * LDQ + hd * 256;
        const __amdgpu_buffer_rsrc_t qrs = __builtin_amdgcn_make_buffer_rsrc((void*)qt, 0, 0x7fffffff, 0x00020000);
#pragma unroll
        for (int i = 0; i < 8; ++i) rq[i] = __builtin_bit_cast(u32x4, __builtin_amdgcn_raw_buffer_load_b128(qrs, (tid >> 5) * (LDQ * 2) + (tid & 31) * 16, i * 8 * (LDQ * 2), 0));
        const float dnv = DN[(size_t)(dir * 192 + cgx) * 1024 + hd * 256 + tid];
        __syncthreads();
#pragma unroll
        for (int i = 0; i < 8; ++i) *(u32x4*)(buf + ((tid >> 5) + 8 * i) * 528 + (tid & 31) * 16) = rq[i];
        dns[tid] = dnv;
        __syncthreads();
      }
      {
        f32x16 a;
#pragma unroll
        for (int e = 0; e < 16; ++e) a[e] = 0.f;
        const int ci = w >> 1, si = w & 1;
        const char* qa = buf + (32 * ci + r) * 528 + h * 16; const u16* kb = kt + (size_t)(32 * si + r) * LDQ + 8 * h;
#pragma unroll
        for (int ks = 0; ks < 16; ++ks) a = MFMA32(*(const bf16x8*)(qa + ks * 32), *(const bf16x8*)(kb + ks * 16), a);
#pragma unroll
        for (int e = 0; e < 16; ++e) {
          const int cr_ = 32 * ci + crow(e, h), sc_ = 32 * si + r;
          const bool keep = dir ? (sc_ >= cr_) : (sc_ <= cr_);
          att[cr_ * 72 + sc_] = keep ? f2bf(a[e]) : (u16)0;
        }
      }
      f32x16 o[2];
#pragma unroll
      for (int q = 0; q < 2; ++q)
#pragma unroll
        for (int e = 0; e < 16; ++e) o[q][e] = 0.f;
#pragma unroll
      for (int mt = 0; mt < 8; ++mt)
#pragma unroll
        for (int s = 0; s < 2; ++s) {
          const bf16x8 sf = pack8(S[mt], s);
#pragma unroll
          for (int q = 0; q < 2; ++q) {
            const char* qa = buf + (32 * q + r) * 528 + (32 * mt + 16 * s + 4 * h) * 2;
            const s16x4 lo = *(const s16x4*)qa, hi = *(const s16x4*)(qa + 16);
            o[q] = MFMA32(cat4(lo, hi), sf, o[q]);
          }
        }
      {
        u32x4 rq[8];
        const __amdgpu_buffer_rsrc_t krs = __builtin_amdgcn_make_buffer_rsrc((void*)kdT, 0, 0x7fffffff, 0x00020000);
#pragma unroll
        for (int i = 0; i < 8; ++i) rq[i] = __builtin_bit_cast(u32x4, __builtin_amdgcn_raw_buffer_load_b128(krs, tid * 16, i * 4096, 0));
        __syncthreads();
#pragma unroll
        for (int i = 0; i < 8; ++i) *(u32x4*)(buf + ((tid >> 3) + 32 * i) * 144 + (tid & 7) * 16) = rq[i];
        __syncthreads();
      }
      bf16x8 vf[4];
#pragma unroll
      for (int ks = 0; ks < 4; ++ks) vf[ks] = *(const bf16x8*)(vT + ks * 16 + 8 * h);
#pragma unroll
      for (int q = 0; q < 2; ++q)
#pragma unroll
        for (int ks = 0; ks < 4; ++ks) { const bf16x8 af = *(const bf16x8*)(att + (32 * q + r) * 72 + ks * 16 + 8 * h); o[q] = MFMA32(af, vf[ks], o[q]); }
#pragma unroll
      for (int q = 0; q < 2; ++q)
#pragma unroll
        for (int e = 0; e < 16; ++e) OD[(size_t)(Tc + 32 * q + crow(e, h)) * 2048 + vcol0 + r] = f2bf(o[q][e]);
#pragma unroll
      for (int mt = 0; mt < 8; ++mt) {
#pragma unroll
        for (int g = 0; g < 4; ++g) {
          const f32x4 d4 = *(const f32x4*)(dns + 32 * mt + 8 * g + 4 * h);
#pragma unroll
          for (int e = 0; e < 4; ++e) S[mt][4 * g + e] *= d4[e];
        }
#pragma unroll
        for (int ks = 0; ks < 4; ++ks) { const bf16x8 af = *(const bf16x8*)(buf + (32 * mt + r) * 144 + ks * 32 + h * 16); S[mt] = MFMA32(af, vf[ks], S[mt]); }
      }
    }
    if (!lat) {
      float* so = p.out + OUT_GLA + ((size_t)((bs * 2 + dir) * 4 + hd) * 256) * 512 + (sl * 128 + w * 32 + r);
#pragma unroll
      for (int mt = 0; mt < 8; ++mt)
#pragma unroll
        for (int e = 0; e < 16; ++e) so[(size_t)(32 * mt + crow(e, h)) * 512] = S[mt][e];
    }
  }
  __syncthreads();
}

DI void gla_norm(const Params& p) {
  char* ws = p.ws;
  const u16* OF = (const u16*)(ws + WS_OP); const u16* OB = (const u16*)(ws + C_OB); const u16* SG = (const u16*)(ws + C_SGATE);
  u16* OG = (u16*)(ws + WS_H);
  const int lane = tid_() & 63, wv = tid_() >> 6;
  for (int T = blockIdx.x * 4 + wv; T < NTOK; T += gridDim.x * 4) {
    f32x4 x[8];
    float ss[4] = {0.f, 0.f, 0.f, 0.f};
#pragma unroll
    for (int j = 0; j < 8; ++j) {
      const size_t o = (size_t)T * 2048 + (j * 64 + lane) * 4;
      x[j] = ld_bf4(OF + o) + ld_bf4(OB + o);
      ss[j >> 1] += x[j][0] * x[j][0] + x[j][1] * x[j][1] + x[j][2] * x[j][2] + x[j][3] * x[j][3];
    }
#pragma unroll
    for (int q = 0; q < 4; ++q) ss[q] = rsqrtf(wave_sum(ss[q]) * (1.f / 512.f) + EPS);
#pragma unroll
    for (int j = 0; j < 8; ++j) {
      const int col = (j * 64 + lane) * 4;
      const size_t o = (size_t)T * 2048 + col;
      const f32x4 ng = *(const f32x4*)(p.gla_norm + (col & 511));
      const u32x2 sg = *(const u32x2*)(SG + o);
      const f32x4 y = x[j] * ss[j >> 1] * ng;
      st_bf4(OG + (size_t)T * LDH + col, y[0] * bflo(sg.x), y[1] * bfhi(sg.x), y[2] * bflo(sg.y), y[3] * bfhi(sg.y));
    }
  }
}

#define XB_TMO      128
#define XB_XCNT(j)  (256  + 64 * (j))
#define XB_XSUB(j)  (1280 + 64 * (j))
#define XB_XGEN(j)  (2304 + 64 * (j))
#define XB_TOP      3328
#define XB_TOPGEN   3392
#define XCD_BAR_WORDS 3456
#define XB_SPIN_CAP (1u << 18)
#define LAS __attribute__((address_space(3)))
DI unsigned xb_ld(unsigned* p) { return __hip_atomic_load(p, __ATOMIC_RELAXED, __HIP_MEMORY_SCOPE_AGENT); }
DI unsigned xb_add(unsigned* p, unsigned v) { return __hip_atomic_fetch_add(p, v, __ATOMIC_RELAXED, __HIP_MEMORY_SCOPE_AGENT); }
DI unsigned xb_xcc_id() { return (unsigned)__builtin_amdgcn_s_getreg((3 << 11) | 20) & 0xFu; }
#define XB_SPIN(cond, bar) do { unsigned _sp = 0; while (cond) { __builtin_amdgcn_s_sleep(1); \
    if ((++_sp & 255u) == 0u) { if (xb_ld(&(bar)[XB_TMO])) break; if (_sp > XB_SPIN_CAP) { atomicAdd(&(bar)[XB_TMO], 1u); break; } } } } while (0)
struct XcdBarrier { unsigned* bar; unsigned x; volatile LAS unsigned* st; };
DI XcdBarrier xcd_barrier_post(unsigned* bar, volatile LAS unsigned* st) {
  XcdBarrier b; b.bar = bar; b.x = xb_xcc_id(); b.st = st;
  if (threadIdx.x == 0) (void)xb_add(&bar[XB_XCNT(b.x)], 1u);
  return b;
}
DI void xcd_barrier_complete(unsigned* bar, unsigned x, unsigned& nloc, unsigned& nx) {
  const unsigned G = gridDim.x * gridDim.y * gridDim.z;
  unsigned sum, cnt, mine, sp = 0u;
  for (;;) {
    sum = 0u; cnt = 0u; mine = 0u;
#pragma unroll
    for (unsigned j = 0; j < 16; ++j) { const unsigned c = xb_ld(&bar[XB_XCNT(j)]); sum += c; cnt += (c > 0u) ? 1u : 0u; mine = (j == x) ? c : mine; }
    if (sum == G) break;
    __builtin_amdgcn_s_sleep(1);
    if ((++sp & 255u) == 0u) { if (xb_ld(&bar[XB_TMO])) break; if (sp > XB_SPIN_CAP) { atomicAdd(&bar[XB_TMO], 1u); break; } }
  }
  nloc = mine > 0u ? mine : 1u; nx = cnt > 0u ? cnt : 1u;
}
DI void xcd_barrier(const XcdBarrier& b) {
  asm volatile("s_waitcnt vmcnt(0)" ::: "memory");
  __syncthreads();
  if (threadIdx.x == 0) {
    unsigned* bar = b.bar;
    __builtin_amdgcn_s_waitcnt(0);
    unsigned nloc = b.st[0], nx = b.st[1];
    if (nloc == 0u) { xcd_barrier_complete(bar, b.x, nloc, nx); b.st[0] = nloc; b.st[1] = nx; }
    const unsigned old = xb_add(&bar[XB_XSUB(b.x)], 1u);
    const unsigned gen = old / nloc;
    if (old + 1u == (gen + 1u) * nloc) {
      __builtin_amdgcn_fence(__ATOMIC_RELEASE, "agent");
      asm volatile("s_waitcnt vmcnt(0)" ::: "memory");
      const unsigned og = xb_add(&bar[XB_TOP], 1u);
      const unsigned tg = og / nx;
      if (og + 1u == (tg + 1u) * nx) xb_add(&bar[XB_TOPGEN], 1u);
      else XB_SPIN(xb_ld(&bar[XB_TOPGEN]) == tg, bar);
      __builtin_amdgcn_fence(__ATOMIC_ACQUIRE, "agent");
      xb_add(&bar[XB_XGEN(b.x)], 1u);
      asm volatile("s_waitcnt vmcnt(0)" ::: "memory");
    } else {
      XB_SPIN(xb_ld(&bar[XB_XGEN(b.x)]) == gen, bar);
      __builtin_amdgcn_fence(__ATOMIC_ACQUIRE, "agent");
      asm volatile("s_waitcnt vmcnt(0)" ::: "memory");
    }
  }
  __syncthreads();
}

constexpr int NPHASE = 26;
#ifndef DUPMASK
#define DUPMASK 0u
#endif
template <int PH>
DI void run_phase(const Params& p, char* smem) {
  char* ws = p.ws;
  if constexpr (PH == 0) phase0(p, smem);
  else if constexpr (PH == 1) norm_phase(p, 0, true);
  else if constexpr (PH == 2) mla_g1(p, 0, smem);
  else if constexpr (PH == 3) mla_a2(p, 0);
  else if constexpr (PH == 4) mla_g2(p, 0, smem);
  else if constexpr (PH == 5) mla_attn(p, smem);
  else if constexpr (PH == 6) gemm_out(p, (const u16*)(ws + WS_H), (const u16*)(ws + WS_WT_MLA_OUT), smem);
  else if constexpr (PH == 7) norm_phase(p, 1, false);
  else if constexpr (PH == 8) s5_g1(p, smem);
  else if constexpr (PH == 9) s5_scan(p, smem);
  else if constexpr (PH == 10) s5_combine(p);
  else if constexpr (PH == 11) s5_g2(p, smem);
  else if constexpr (PH == 12) gemm_out(p, (const u16*)(ws + B_Z), (const u16*)(ws + WS_WT_S5_OUT), smem);
  else if constexpr (PH == 13) norm_phase(p, 2, false);
  else if constexpr (PH == 14) gla_g1(p, smem);
  else if constexpr (PH == 15) gla_gate(p, (float*)smem);
  else if constexpr (PH == 16) gla_main(p, smem);
  else if constexpr (PH == 17) gla_norm(p);
  else if constexpr (PH == 18) gemm_out(p, (const u16*)(ws + WS_H), (const u16*)(ws + WS_WT_GLA_OUT), smem);
  else if constexpr (PH == 19) norm_phase(p, 3, false);
  else if constexpr (PH == 20) mla_g1(p, 1, smem);
  else if constexpr (PH == 21) mla_a2(p, 1);
  else if constexpr (PH == 22) mla_g2(p, 1, smem);
  else if constexpr (PH == 23) mla_attn(p, smem);
  else if constexpr (PH == 24) gemm_out(p, (const u16*)(ws + WS_H), (const u16*)(ws + WS_WT_MLA_OUT) + (size_t)2048 * LDW, smem);
  else if constexpr (PH == 25) norm_phase(p, 4, false);
}

template <int PH>
DI void run_from(const Params& p, char* smem, const XcdBarrier& xb) {
  run_phase<PH>(p, smem);
  if constexpr ((DUPMASK >> PH) & 1u) { __syncthreads(); run_phase<PH>(p, smem); }
  if constexpr (PH + 1 < NPHASE) { xcd_barrier(xb); run_from<PH + 1>(p, smem, xb); }
}

#if COOP
__global__ void __launch_bounds__(256, 2) mega(Params p) {
  __shared__ __attribute__((aligned(16))) char smem[73728];
  __shared__ uint4 xb_words;
  cg::grid_group grid = cg::this_grid();
  if (p.out == nullptr) grid.sync();
  if (threadIdx.x == 0) xb_words = make_uint4(0u, 0u, 0u, 0u);
  __syncthreads();
  const XcdBarrier xb = xcd_barrier_post((unsigned*)(p.ws + WS_BAR), (volatile LAS unsigned*)&xb_words);
  run_from<0>(p, smem, xb);
}
#else
template <int PH>
__global__ void __launch_bounds__(256, 2) phase_k(Params p) {
  __shared__ __attribute__((aligned(16))) char smem[73728];
  run_phase<PH>(p, smem);
}
template <int PH>
static void launch_from(const Params& p, int grid, hipStream_t stream) {
  hipLaunchKernelGGL(phase_k<PH>, dim3(grid), dim3(256), 0, stream, p);
  if constexpr (PH + 1 < NPHASE) launch_from<PH + 1>(p, grid, stream);
}
#endif

extern "C" void kernel_launch(void* const* d_in, const int* in_sizes, int n_in, void* d_out, int out_size, void* d_ws, size_t ws_size, hipStream_t stream) {
  static int grid_blocks = 0;
  if (!grid_blocks) {
    int dev = 0, cus = 0, per_cu = 0;
    (void)hipGetDevice(&dev);
    (void)hipDeviceGetAttribute(&cus, hipDeviceAttributeMultiprocessorCount, dev);
#if COOP
    (void)hipOccupancyMaxActiveBlocksPerMultiprocessor(&per_cu, mega, 256, 0);
#else
    per_cu = 2;
#endif
    if (per_cu < 1) per_cu = 1;
    if (per_cu > 2) per_cu = 2;
    grid_blocks = cus * per_cu;
  }
  Params p{};
  const float** pp = (const float**)&p;
  for (int i = 0; i < 33; ++i) pp[i] = (const float*)d_in[i];
  p.out = (float*)d_out;
  p.ws = (char*)d_ws;
#if COOP
  (void)hipMemsetAsync(d_ws, 0, XCD_BAR_WORDS * 4, stream);
  void* args[] = {&p};
  hipError_t e = hipLaunchCooperativeKernel((void*)mega, dim3(grid_blocks), dim3(256), args, 0, stream);
  if (e != hipSuccess) fprintf(stderr, "cooperative launch failed: %s (grid %d)\n", hipGetErrorString(e), grid_blocks);
#else
  launch_from<0>(p, grid_blocks, stream);
#endif
}
```

```cpp
#include <hip/hip_runtime.h>
#include <hip/hip_cooperative_groups.h>
#include <stdint.h>
#include <cstdio>
namespace cg = cooperative_groups;

#ifndef COOP
#define COOP 1
#endif

typedef unsigned short u16;
typedef short bf16x8 __attribute__((ext_vector_type(8)));
typedef short s16x4 __attribute__((ext_vector_type(4)));
typedef float f32x16 __attribute__((ext_vector_type(16)));
typedef float f32x4 __attribute__((ext_vector_type(4)));
typedef float f32x2 __attribute__((ext_vector_type(2)));
typedef unsigned u32x4 __attribute__((ext_vector_type(4)));
typedef unsigned u32x2 __attribute__((ext_vector_type(2)));
typedef __bf16 bfv2 __attribute__((ext_vector_type(2)));
#define DI __device__ __forceinline__
#define MFMA32(a, b, c) __builtin_amdgcn_mfma_f32_32x32x16_bf16((a), (b), (c), 0, 0, 0)

constexpr int D = 2048, NTOK = 12288, NCTX = 4096;
constexpr float EPS = 1e-6f;
constexpr int LDH = 2112, LDW = 2112, LDC = 576, LDKB = 3136, LDQ = 1088;
constexpr size_t OUT_CKV = 25165824, OUT_KROPE = 29360128, OUT_S5 = 29884416, OUT_GLA = 30408704;
constexpr size_t WS_BAR = 0;
constexpr size_t WS_WT_MLA_IN = 16384;
constexpr size_t WS_WT_MLA_UKV = WS_WT_MLA_IN + 2ull * 5760 * LDW * 2;
constexpr size_t WS_WT_MLA_OUT = WS_WT_MLA_UKV + 2ull * 4096 * LDC * 2;
constexpr size_t WS_WT_S5_IN = WS_WT_MLA_OUT + 2ull * 2048 * LDW * 2;
constexpr size_t WS_WT_S5_GLU = WS_WT_S5_IN + 4096ull * LDW * 2;
constexpr size_t WS_WT_S5_OUT = WS_WT_S5_GLU + 2048ull * LDW * 2;
constexpr size_t WS_WT_GLA_IN = WS_WT_S5_OUT + 2048ull * LDW * 2;
constexpr size_t WS_WT_GLA_OUT = WS_WT_GLA_IN + 6272ull * LDW * 2;
constexpr size_t WS_MOD = WS_WT_GLA_OUT + 2048ull * LDW * 2;
constexpr size_t WS_H = WS_MOD + 4ull * 9 * 6144 * 4;
constexpr size_t WS_OP = WS_H + 12288ull * LDH * 2;
constexpr size_t WS_SCR = WS_OP + 12288ull * 2048 * 4;
constexpr size_t A_QB = WS_SCR;
constexpr size_t A_CKVRAW = A_QB + 12288ull * 3072 * 2;
constexpr size_t A_CKVALL = A_CKVRAW + 12288ull * 512 * 4;
constexpr size_t A_SGATE = A_CKVALL + 14336ull * LDC * 2;
constexpr size_t A_KB = A_SGATE + 12288ull * 2048 * 2;
constexpr size_t A_VT = A_KB + 14336ull * LDKB * 2;
constexpr size_t B_U = WS_SCR;
constexpr size_t B_SGATE = B_U + 12288ull * 2048 * 4;
constexpr size_t B_YB = B_SGATE + 12288ull * 2048 * 2;
constexpr size_t B_Z = B_YB + 12288ull * 2048 * 4;
constexpr size_t C_QG = WS_SCR;
constexpr size_t C_KG = C_QG + 12288ull * 1024 * 2;
constexpr size_t C_VT = C_KG + 12288ull * 1024 * 2;
constexpr size_t C_SGATE = C_VT + 12288ull * 2048 * 2;
constexpr size_t C_GLR = C_SGATE + 12288ull * 2048 * 2;
constexpr size_t C_QT = C_GLR + 12288ull * 32 * 4;
constexpr size_t C_KT = C_QT + 2ull * 12288 * LDQ * 2;
constexpr size_t C_KDT = C_KT + 2ull * 12288 * LDQ * 2;
constexpr size_t C_DN = C_KDT + 2ull * 12288 * 1024 * 2;
constexpr size_t C_OB = C_DN + 2ull * 192 * 1024 * 4;

struct Params {
  const float *x_prompt, *x_sample, *cache_ckv, *cache_krope, *state_s5, *state_gla, *c, *c_ctx;
  const float *ada_w, *ada_b, *norm_pre, *norm_post;
  const float *mla_w_in, *mla_kv_norm, *mla_w_ukv, *mla_w_out;
  const float *s5_w_in, *s5_a_re, *s5_a_im, *s5_log_dt, *s5_b_re, *s5_b_im, *s5_c_re, *s5_c_im, *s5_d, *s5_w_glu, *s5_b_glu, *s5_w_out;
  const float *gla_w_in, *gla_w_g2, *gla_b_g, *gla_norm, *gla_w_out;
  float* out;
  char* ws;
};

DI unsigned pk2(float a, float b) { f32x2 v; v.x = a; v.y = b; bfv2 r = __builtin_convertvector(v, bfv2); return __builtin_bit_cast(unsigned, r); }
DI u16 f2bf(float a) { return (u16)(pk2(a, 0.f) & 0xffffu); }
DI float bf2f(u16 v) { return __uint_as_float(((unsigned)v) << 16); }
DI float bflo(unsigned v) { return __uint_as_float(v << 16); }
DI float bfhi(unsigned v) { return __uint_as_float(v & 0xffff0000u); }
DI float siluf(float x) { return x / (1.f + __expf(-x)); }
DI float sigmf(float x) { return 1.f / (1.f + __expf(-x)); }
DI f32x4 ld_bf4(const u16* p) { const u32x2 v = *(const u32x2*)p; f32x4 o = {bflo(v.x), bfhi(v.x), bflo(v.y), bfhi(v.y)}; return o; }
DI int crow(int reg, int h) { return (reg & 3) + 8 * (reg >> 2) + 4 * h; }
DI void st_bf4(u16* p, float a, float b, float c, float d) { u32x2 v; v.x = pk2(a, b); v.y = pk2(c, d); *(u32x2*)p = v; }
DI bf16x8 pack8(const f32x16& x, int s) {
  u32x4 p;
  p.x = pk2(x[8 * s + 0], x[8 * s + 1]); p.y = pk2(x[8 * s + 2], x[8 * s + 3]);
  p.z = pk2(x[8 * s + 4], x[8 * s + 5]); p.w = pk2(x[8 * s + 6], x[8 * s + 7]);
  return __builtin_bit_cast(bf16x8, p);
}
DI bf16x8 cat4(s16x4 lo, s16x4 hi) { return __builtin_shufflevector(lo, hi, 0, 1, 2, 3, 4, 5, 6, 7); }
DI float wave_sum(float v) {
#pragma unroll
  for (int o = 32; o >= 1; o >>= 1) v += __shfl_xor(v, o);
  return v;
}
DI int tid_() { int t = threadIdx.x; asm volatile("" : "+v"(t)); return t; }
DI int cond_of(int T) { return T < NCTX ? 8 : ((T - NCTX) >> 10); }
DI int kvrow_of(int T) { return T < NCTX ? T : NCTX + ((T - NCTX) >> 10) * 1280 + ((T - NCTX) & 1023); }

DI void ada_phase(const Params& p, float* smem) {
  const int tid = tid_();
  float* mod = (float*)(p.ws + WS_MOD);
  for (int it = blockIdx.x; it < 384; it += gridDim.x) {
    const int l = it / 96, n0 = (it % 96) * 64;
    __syncthreads();
    for (int i = tid; i < 9 * 2048; i += 256) { const int cd = i >> 11, k = i & 2047; const float v = cd < 8 ? p.c[cd * 2048 + k] : p.c_ctx[k]; smem[i] = siluf(v); }
    __syncthreads();
    const int c4 = tid & 15, ks = tid >> 4;
    const float* w = p.ada_w + (size_t)l * 2048 * 6144 + n0 + c4 * 4;
    float acc[9][4];
#pragma unroll
    for (int cd = 0; cd < 9; ++cd)
#pragma unroll
      for (int e = 0; e < 4; ++e) acc[cd][e] = 0.f;
#pragma unroll 4
    for (int kk = 0; kk < 128; ++kk) {
      const int k = ks * 128 + kk;
      const f32x4 wv = __builtin_nontemporal_load((const f32x4*)(w + (size_t)k * 6144));
#pragma unroll
      for (int cd = 0; cd < 9; ++cd) {
        const float s = smem[cd * 2048 + k];
#pragma unroll
        for (int e = 0; e < 4; ++e) acc[cd][e] += s * wv[e];
      }
    }
    __syncthreads();
#pragma unroll
    for (int cd = 0; cd < 9; ++cd)
#pragma unroll
      for (int e = 0; e < 4; ++e) smem[(ks * 9 + cd) * 64 + c4 * 4 + e] = acc[cd][e];
    __syncthreads();
    for (int o = tid; o < 576; o += 256) {
      const int cd = o >> 6, col = o & 63;
      float s = 0.f;
#pragma unroll
      for (int k2 = 0; k2 < 16; ++k2) s += smem[(k2 * 9 + cd) * 64 + col];
      mod[(size_t)(l * 9 + cd) * 6144 + n0 + col] = s + p.ada_b[l * 6144 + n0 + col];
    }
  }
  __syncthreads();
}

DI void transpose_job(const float* __restrict__ src, u16* __restrict__ dst, int K, int N, int Npad, int ldw, float* tile) {
  const int tid = tid_();
  const int nkt = K / 64, total = nkt * (Npad / 64);
  for (int t = blockIdx.x; t < total; t += gridDim.x) {
    const int k0 = (t % nkt) * 64, n0 = (t / nkt) * 64;
    const int c = tid & 63, r0 = tid >> 6;
#pragma unroll
    for (int i = 0; i < 16; ++i) { const int r = r0 + 4 * i; tile[r * 65 + c] = (n0 + c < N) ? src[(size_t)(k0 + r) * N + n0 + c] : 0.f; }
    __syncthreads();
    const int n = tid >> 2, ks = (tid & 3) * 16;
    u32x4 v0, v1;
    v0.x = pk2(tile[(ks + 0) * 65 + n], tile[(ks + 1) * 65 + n]); v0.y = pk2(tile[(ks + 2) * 65 + n], tile[(ks + 3) * 65 + n]);
    v0.z = pk2(tile[(ks + 4) * 65 + n], tile[(ks + 5) * 65 + n]); v0.w = pk2(tile[(ks + 6) * 65 + n], tile[(ks + 7) * 65 + n]);
    v1.x = pk2(tile[(ks + 8) * 65 + n], tile[(ks + 9) * 65 + n]); v1.y = pk2(tile[(ks + 10) * 65 + n], tile[(ks + 11) * 65 + n]);
    v1.z = pk2(tile[(ks + 12) * 65 + n], tile[(ks + 13) * 65 + n]); v1.w = pk2(tile[(ks + 14) * 65 + n], tile[(ks + 15) * 65 + n]);
    u16* d = dst + (size_t)(n0 + n) * ldw + k0 + ks;
    *(u32x4*)d = v0; *(u32x4*)(d + 8) = v1;
    __syncthreads();
  }
}

DI void phase0(const Params& p, char* smem) {
  ada_phase(p, (float*)smem);
  float* tile = (float*)smem;
  char* ws = p.ws;
  for (int j = 0; j < 2; ++j) {
    transpose_job(p.mla_w_in + (size_t)j * 2048 * 5696, (u16*)(ws + WS_WT_MLA_IN) + (size_t)j * 5760 * LDW, 2048, 5696, 5760, LDW, tile);
    transpose_job(p.mla_w_ukv + (size_t)j * 512 * 4096, (u16*)(ws + WS_WT_MLA_UKV) + (size_t)j * 4096 * LDC, 512, 4096, 4096, LDC, tile);
    transpose_job(p.mla_w_out + (size_t)j * 2048 * 2048, (u16*)(ws + WS_WT_MLA_OUT) + (size_t)j * 2048 * LDW, 2048, 2048, 2048, LDW, tile);
  }
  transpose_job(p.s5_w_in, (u16*)(ws + WS_WT_S5_IN), 2048, 4096, 4096, LDW, tile);
  transpose_job(p.s5_w_glu, (u16*)(ws + WS_WT_S5_GLU), 2048, 2048, 2048, LDW, tile);
  transpose_job(p.s5_w_out, (u16*)(ws + WS_WT_S5_OUT), 2048, 2048, 2048, LDW, tile);
  transpose_job(p.gla_w_in, (u16*)(ws + WS_WT_GLA_IN), 2048, 6176, 6272, LDW, tile);
  transpose_job(p.gla_w_out, (u16*)(ws + WS_WT_GLA_OUT), 2048, 2048, 2048, LDW, tile);
}

DI void norm_phase(const Params& p, int l, bool first) {
  const int lane = tid_() & 63, wv = tid_() >> 6;
  const float* mod = (const float*)(p.ws + WS_MOD);
  const u16* OP = (const u16*)(p.ws + WS_OP);
  u16* H = (u16*)(p.ws + WS_H);
  for (int T = blockIdx.x * 4 + wv; T < NTOK; T += gridDim.x * 4) {
    const int cd = cond_of(T);
    const float* xin = T < NCTX ? p.x_prompt + (size_t)T * D : p.x_sample + (size_t)(T - NCTX) * D;
    float* xrow = p.out + (size_t)T * D;
    f32x4 x[8];
    if (first) {
#pragma unroll
      for (int j = 0; j < 8; ++j) x[j] = *(const f32x4*)(xin + (j * 64 + lane) * 4);
    } else {
      const float* xold = (l == 1) ? xin : xrow;
      const u16* op = OP + (size_t)T * D;
      f32x4 o[8];
      float ss = 0.f;
#pragma unroll
      for (int j = 0; j < 8; ++j) { o[j] = ld_bf4(op + (j * 64 + lane) * 4); ss += o[j][0] * o[j][0] + o[j][1] * o[j][1] + o[j][2] * o[j][2] + o[j][3] * o[j][3]; }
      ss = wave_sum(ss);
      const float rstd = rsqrtf(ss * (1.f / D) + EPS);
      const float* npost = p.norm_post + (l - 1) * D;
      const float* gate = mod + (size_t)((l - 1) * 9 + cd) * 6144 + 4096;
#pragma unroll
      for (int j = 0; j < 8; ++j) {
        const int col = (j * 64 + lane) * 4;
        const f32x4 xo = *(const f32x4*)(xold + col), np = *(const f32x4*)(npost + col), g = *(const f32x4*)(gate + col);
        x[j] = xo + g * (o[j] * rstd * np);
        *(f32x4*)(xrow + col) = x[j];
      }
    }
    if (l < 4) {
      float ss = 0.f;
#pragma unroll
      for (int j = 0; j < 8; ++j) ss += x[j][0] * x[j][0] + x[j][1] * x[j][1] + x[j][2] * x[j][2] + x[j][3] * x[j][3];
      ss = wave_sum(ss);
      const float rstd = rsqrtf(ss * (1.f / D) + EPS);
      const float* npre = p.norm_pre + l * D;
      const float* sh = mod + (size_t)(l * 9 + cd) * 6144;
      u16* hrow = H + (size_t)T * LDH;
#pragma unroll
      for (int j = 0; j < 8; ++j) {
        const int col = (j * 64 + lane) * 4;
        const f32x4 np = *(const f32x4*)(npre + col), s1 = *(const f32x4*)(sh + col), sc = *(const f32x4*)(sh + 2048 + col);
        const f32x4 hv = x[j] * rstd * np * (1.f + sc) + s1;
        st_bf4(hrow + col, hv[0], hv[1], hv[2], hv[3]);
      }
    }
  }
}

template <int BM, bool SWAP, class Epi>
DI void gemm_tile(const int w, const u16* __restrict__ A, int lda, const u16* __restrict__ Bt, int ldb, int K, int m0, int n0, const Epi& epi, char* smem) {
  u16* As = (u16*)smem;
  u16* Bs = As + 256 * 72;
  const int tid = tid_(), lane = tid & 63, r = lane & 31, h = lane >> 5;
  const int wm = w >> 1, wn = w & 1;
  const int lrow = tid >> 3, lseg = tid & 7;
  const __amdgpu_buffer_rsrc_t Ars = __builtin_amdgcn_make_buffer_rsrc((void*)(A + (size_t)m0 * lda), 0, 0x7fffffff, 0x00020000);
  const __amdgpu_buffer_rsrc_t Brs = __builtin_amdgcn_make_buffer_rsrc((void*)(Bt + (size_t)n0 * ldb), 0, 0x7fffffff, 0x00020000);
  const int aoff = (lrow * lda + lseg * 8) * 2, boff = (lrow * ldb + lseg * 8) * 2;
  constexpr int NA = BM / 32, NI = BM / 64;
  u32x4 ra[NA], rb[4];
  f32x16 acc[NI][2];
#pragma unroll
  for (int i = 0; i < NI; ++i)
#pragma unroll
    for (int j = 0; j < 2; ++j)
#pragma unroll
      for (int e = 0; e < 16; ++e) acc[i][j][e] = 0.f;
#define GT_GL(K0) { _Pragma("unroll") for (int q = 0; q < NA; ++q) ra[q] = __builtin_bit_cast(u32x4, __builtin_amdgcn_raw_buffer_load_b128(Ars, aoff, (32 * q * lda + (K0)) * 2, 0)); \
                    _Pragma("unroll") for (int q = 0; q < 4; ++q) rb[q] = __builtin_bit_cast(u32x4, __builtin_amdgcn_raw_buffer_load_b128(Brs, boff, (32 * q * ldb + (K0)) * 2, 0)); }
#define GT_LS() { _Pragma("unroll") for (int q = 0; q < NA; ++q) *(u32x4*)(As + (lrow + 32 * q) * 72 + lseg * 8) = ra[q]; \
                  _Pragma("unroll") for (int q = 0; q < 4; ++q) *(u32x4*)(Bs + (lrow + 32 * q) * 72 + lseg * 8) = rb[q]; }
  const int nk = K >> 6;
  GT_GL(0);
  __syncthreads();
  GT_LS();
  __syncthreads();
  const u16* as = As + (wm * (BM / 2) + r) * 72 + h * 8;
  const u16* bs = Bs + (wn * 64 + r) * 72 + h * 8;
  for (int kt = 0; kt < nk; ++kt) {
    { const int k1 = (kt + 1 < nk ? kt + 1 : kt) << 6; GT_GL(k1); }
    __builtin_amdgcn_sched_barrier(0);
    __builtin_amdgcn_s_setprio(2);
#pragma unroll
    for (int ks = 0; ks < 4; ++ks) {
      bf16x8 b[2];
#pragma unroll
      for (int j = 0; j < 2; ++j) b[j] = *(const bf16x8*)(bs + j * 32 * 72 + ks * 16);
#pragma unroll
      for (int i = 0; i < NI; ++i) {
        const bf16x8 a = *(const bf16x8*)(as + i * 32 * 72 + ks * 16);
#pragma unroll
        for (int j = 0; j < 2; ++j) acc[i][j] = SWAP ? MFMA32(b[j], a, acc[i][j]) : MFMA32(a, b[j], acc[i][j]);
      }
    }
    __builtin_amdgcn_s_setprio(0);
    __syncthreads();
    GT_LS();
    __syncthreads();
  }
#undef GT_GL
#undef GT_LS
  int lane2;
  asm volatile("v_mbcnt_lo_u32_b32 %0, -1, 0\n\tv_mbcnt_hi_u32_b32 %0, -1, %0" : "=v"(lane2));
  const int r2 = lane2 & 31, h2 = lane2 >> 5;
#pragma unroll
  for (int i = 0; i < NI; ++i)
#pragma unroll
    for (int j = 0; j < 2; ++j) epi(m0 + wm * (BM / 2) + i * 32, n0 + wn * 64 + j * 32, acc[i][j], r2, h2);
}

template <class F>
DI void for_tiles(int MT, int NT, const F& f) {
  const int G = gridDim.x;
  if ((G & 7) == 0 && (MT & 7) == 0) {
    const int G8 = G >> 3, xcd = blockIdx.x & 7, loc = blockIdx.x >> 3;
    const int SM = MT >> 3, SN = (NT + 7) >> 3, total = SM * SN * 64;
    for (int i = 0;; ++i) {
      const int u = (i * 8 + xcd) * G8 + loc;
      if (u >= total) break;
      const int sup = u >> 6, win = u & 63;
      const int mt = (sup % SM) * 8 + (win & 7), nt = (sup / SM) * 8 + (win >> 3);
      if (nt < NT) f(mt, nt);
    }
  } else {
    for (int t = blockIdx.x; t < MT * NT; t += G) f(t % MT, t / MT);
  }
}

DI void rope16(f32x16& v, int pos, int h) {
#pragma unroll
  for (int g = 0; g < 2; ++g)
#pragma unroll
    for (int e = 0; e < 4; ++e) {
      const int f = 8 * g + 4 * h + e;
      const float invf = exp2f(-(float)f * 0.83048202372184058696f);
      const float rev = ((float)pos * invf) * 0.15915494309189533577f;
      const float sn = __builtin_amdgcn_sinf(rev), cs = __builtin_amdgcn_cosf(rev);
      const float x1 = v[4 * g + e], x2 = v[4 * (g + 2) + e];
      v[4 * g + e] = x1 * cs - x2 * sn;
      v[4 * (g + 2) + e] = x1 * sn + x2 * cs;
    }
}

DI void mla_g1(const Params& p, int j, char* smem) {
  char* ws = p.ws;
  const u16* H = (const u16*)(ws + WS_H);
  const u16* Wt = (const u16*)(ws + WS_WT_MLA_IN) + (size_t)j * 5760 * LDW;
  auto epi = [&](int tm, int tn, const f32x16& acc, int r, int h) {
    char* ws2 = p.ws;
    u16* QB = (u16*)(ws2 + A_QB); float* CKVRAW = (float*)(ws2 + A_CKVRAW); u16* SG = (u16*)(ws2 + A_SGATE); u16* KB = (u16*)(ws2 + A_KB);
    float* okr = p.out + OUT_KROPE;
    const int m = tm + r;
    if (tn < 3072) {
      const int within = tn % 192;
      f32x16 v = acc;
      if (within >= 128 && m >= NCTX) { const int tl = (m - NCTX) & 1023; rope16(v, within < 160 ? (tl >> 6) : (tl & 63), h); }
#pragma unroll
      for (int g = 0; g < 4; ++g) st_bf4(QB + (size_t)m * 3072 + tn + 8 * g + 4 * h, v[4 * g], v[4 * g + 1], v[4 * g + 2], v[4 * g + 3]);
    } else if (tn < 3584) {
#pragma unroll
      for (int g = 0; g < 4; ++g) { f32x4 o = {acc[4 * g], acc[4 * g + 1], acc[4 * g + 2], acc[4 * g + 3]}; *(f32x4*)(CKVRAW + (size_t)m * 512 + (tn - 3072) + 8 * g + 4 * h) = o; }
    } else if (tn < 3648) {
      f32x16 v = acc;
      const int c0 = tn - 3584;
      if (m >= NCTX) { const int tl = (m - NCTX) & 1023; rope16(v, c0 == 0 ? (tl >> 6) : (tl & 63), h); }
      else {
        const int b = m >> 8, t = m & 255;
#pragma unroll
        for (int g = 0; g < 4; ++g) { f32x4 o = {v[4 * g], v[4 * g + 1], v[4 * g + 2], v[4 * g + 3]}; *(f32x4*)(okr + ((size_t)(b * 2 + j) * 256 + t) * 64 + c0 + 8 * g + 4 * h) = o; }
      }
      const size_t R = kvrow_of(m);
      for (int hd = 0; hd < 16; ++hd)
#pragma unroll
        for (int g = 0; g < 4; ++g) st_bf4(KB + R * LDKB + hd * 192 + 128 + c0 + 8 * g + 4 * h, v[4 * g], v[4 * g + 1], v[4 * g + 2], v[4 * g + 3]);
    } else if (tn < 5696) {
#pragma unroll
      for (int g = 0; g < 4; ++g) st_bf4(SG + (size_t)m * 2048 + (tn - 3648) + 8 * g + 4 * h, siluf(acc[4 * g]), siluf(acc[4 * g + 1]), siluf(acc[4 * g + 2]), siluf(acc[4 * g + 3]));
    }
  };
  const int wv_ = __builtin_amdgcn_readfirstlane(tid_() >> 6);
  for_tiles(48, 45, [&](int mt, int nt) { gemm_tile<256, true>(wv_, H, LDH, Wt, LDW, 2048, mt * 256, nt * 128, epi, smem); });
}

DI void mla_a2(const Params& p, int j) {
  char* ws = p.ws;
  const int lane = tid_() & 63, wv = tid_() >> 6;
  const float* CKVRAW = (const float*)(ws + A_CKVRAW); u16* CKVALL = (u16*)(ws + A_CKVALL); u16* KB = (u16*)(ws + A_KB);
  const float* kvn = p.mla_kv_norm + j * 512;
  float* ockv = p.out + OUT_CKV;
  for (int R = blockIdx.x * 4 + wv; R < 14336; R += gridDim.x * 4) {
    int T = -1, cb = 0, ct = 0;
    if (R < NCTX) T = R;
    else { const int r2 = R - NCTX; cb = r2 / 1280; const int tp = r2 - cb * 1280; if (tp < 1024) T = NCTX + cb * 1024 + tp; else ct = tp - 1024; }
    u16* dst = CKVALL + (size_t)R * LDC;
    if (T >= 0) {
      const float* src = CKVRAW + (size_t)T * 512;
      const f32x4 a = *(const f32x4*)(src + lane * 4), b = *(const f32x4*)(src + 256 + lane * 4);
      float ss = a[0] * a[0] + a[1] * a[1] + a[2] * a[2] + a[3] * a[3] + b[0] * b[0] + b[1] * b[1] + b[2] * b[2] + b[3] * b[3];
      ss = wave_sum(ss);
      const float rstd = rsqrtf(ss * (1.f / 512.f) + EPS);
      const f32x4 g0 = *(const f32x4*)(kvn + lane * 4), g1 = *(const f32x4*)(kvn + 256 + lane * 4);
      const f32x4 y0 = a * rstd * g0, y1 = b * rstd * g1;
      st_bf4(dst + lane * 4, y0[0], y0[1], y0[2], y0[3]);
      st_bf4(dst + 256 + lane * 4, y1[0], y1[1], y1[2], y1[3]);
      if (T < NCTX) {
        float* o = ockv + ((size_t)((T >> 8) * 2 + j) * 256 + (T & 255)) * 512;
        *(f32x4*)(o + lane * 4) = y0; *(f32x4*)(o + 256 + lane * 4) = y1;
      }
    } else {
      const float* src = p.cache_ckv + ((size_t)(cb * 2 + j) * 256 + ct) * 512;
      const f32x4 a = *(const f32x4*)(src + lane * 4), b = *(const f32x4*)(src + 256 + lane * 4);
      st_bf4(dst + lane * 4, a[0], a[1], a[2], a[3]);
      st_bf4(dst + 256 + lane * 4, b[0], b[1], b[2], b[3]);
      const float kr = p.cache_krope[((size_t)(cb * 2 + j) * 256 + ct) * 64 + lane];
      const u16 kb = f2bf(kr);
      for (int hd = 0; hd < 16; ++hd) KB[(size_t)R * LDKB + hd * 192 + 128 + lane] = kb;
    }
  }
}

DI void mla_g2(const Params& p, int j, char* smem) {
  char* ws = p.ws;
  const u16* CKVALL = (const u16*)(ws + A_CKVALL);
  const u16* Wt = (const u16*)(ws + WS_WT_MLA_UKV) + (size_t)j * 4096 * LDC;
  u16* KB = (u16*)(ws + A_KB); u16* VT = (u16*)(ws + A_VT);
  auto epiK = [&](int tm, int tn, const f32x16& acc, int r, int h) {
    const size_t R = tm + r; const int hd = tn >> 8, wi = tn & 255;
#pragma unroll
    for (int g = 0; g < 4; ++g) st_bf4(KB + R * LDKB + hd * 192 + wi + 8 * g + 4 * h, acc[4 * g], acc[4 * g + 1], acc[4 * g + 2], acc[4 * g + 3]);
  };
  auto epiV = [&](int tm, int tn, const f32x16& acc, int r, int h) {
    const int n = tn + r; const int hd = n >> 8, d = (n & 255) - 128;
    size_t base; int nkeys, key0;
    if (tm < NCTX) { base = (size_t)(tm >> 8) * 256 * 2048; nkeys = 256; key0 = tm & 255; }
    else { const int r2 = tm - NCTX; const int b = r2 / 1280; base = (size_t)NCTX * 2048 + (size_t)b * 1280 * 2048; nkeys = 1280; key0 = r2 - b * 1280; }
    u16* dst = VT + base + (size_t)(hd * 128 + d) * nkeys + key0;
#pragma unroll
    for (int g = 0; g < 4; ++g) st_bf4(dst + 8 * g + 4 * h, acc[4 * g], acc[4 * g + 1], acc[4 * g + 2], acc[4 * g + 3]);
  };
  const int wv_ = __builtin_amdgcn_readfirstlane(tid_() >> 6);
  for_tiles(56, 32, [&](int mt, int nt) {
    if ((nt & 1) == 0) gemm_tile<256, true>(wv_, CKVALL, LDC, Wt, LDC, 512, mt * 256, nt * 128, epiK, smem);
    else gemm_tile<256, false>(wv_, CKVALL, LDC, Wt, LDC, 512, mt * 256, nt * 128, epiV, smem);
  });
}

DI void mla_attn(const Params& p, char* smem) {
  char* ws = p.ws;
  const u16* QB = (const u16*)(ws + A_QB); const u16* KB = (const u16*)(ws + A_KB); const u16* VT = (const u16*)(ws + A_VT); const u16* SG = (const u16*)(ws + A_SGATE);
  u16* OG = (u16*)(ws + WS_H);
  char* Ks = smem;
  char* Vs = smem + 25600;
  const int tid = tid_();
  const int lane = tid & 63, w = tid >> 6, r = lane & 31, h = lane >> 5;
  const float SC = 0.07216878364870322f * 1.4426950408889634f;
  for (int it = blockIdx.x; it < 1536; it += gridDim.x) {
    int head, T0, R0, nkeys; size_t vbase;
    if (it < 1024) { const int b = it >> 7; head = (it >> 3) & 15; T0 = NCTX + b * 1024 + (it & 7) * 128; R0 = NCTX + b * 1280; nkeys = 1280; vbase = (size_t)NCTX * 2048 + (size_t)b * 1280 * 2048; }
    else { const int i2 = it - 1024; const int b = i2 >> 5; head = (i2 >> 1) & 15; T0 = b * 256 + (i2 & 1) * 128; R0 = b * 256; nkeys = 256; vbase = (size_t)b * 256 * 2048; }
    T0 += w * 32;
    bf16x8 qf[12];
    const u16* qp = QB + (size_t)(T0 + r) * 3072 + head * 192 + 8 * h;
#pragma unroll
    for (int ks = 0; ks < 12; ++ks) qf[ks] = *(const bf16x8*)(qp + ks * 16);
    f32x16 O[4];
#pragma unroll
    for (int dt = 0; dt < 4; ++dt)
#pragma unroll
      for (int e = 0; e < 16; ++e) O[dt][e] = 0.f;
    float mrun = -INFINITY, lrun = 0.f;
    const u16* kg = KB + (size_t)R0 * LDKB + head * 192;
    const u16* vg = VT + vbase + (size_t)(head * 128) * nkeys;
    u32x4 rk[6], rv[4];
    const __amdgpu_buffer_rsrc_t Krs = __builtin_amdgcn_make_buffer_rsrc((void*)kg, 0, 0x7fffffff, 0x00020000);
    const __amdgpu_buffer_rsrc_t Vrs = __builtin_amdgcn_make_buffer_rsrc((void*)vg, 0, 0x7fffffff, 0x00020000);
    const int kvo = (tid >> 2) * (LDKB * 2) + (tid & 3) * 16;
    const int vvo = (tid >> 3) * nkeys * 2 + (tid & 7) * 16;
#define AT_LOAD(KT0) { _Pragma("unroll") for (int i = 0; i < 6; ++i) rk[i] = __builtin_bit_cast(u32x4, __builtin_amdgcn_raw_buffer_load_b128(Krs, kvo + 64 * i, (KT0) * (LDKB * 2), 0)); \
                       _Pragma("unroll") for (int i = 0; i < 4; ++i) rv[i] = __builtin_bit_cast(u32x4, __builtin_amdgcn_raw_buffer_load_b128(Vrs, vvo, (32 * i * nkeys + (KT0)) * 2, 0)); }
#define AT_STORE() { _Pragma("unroll") for (int i = 0; i < 6; ++i) *(u32x4*)(Ks + (tid >> 2) * 400 + ((tid & 3) + 4 * i) * 16) = rk[i]; \
                     _Pragma("unroll") for (int i = 0; i < 4; ++i) { const int sg = tid & 7; char* d = Vs + ((tid >> 3) + 32 * i) * 144 + (sg >> 1) * 32 + (sg & 1) * 8; \
                       u32x2 lo, hi; lo.x = rv[i].x; lo.y = rv[i].y; hi.x = rv[i].z; hi.y = rv[i].w; *(u32x2*)d = lo; *(u32x2*)(d + 16) = hi; } }
    AT_LOAD(0);
    __syncthreads();
    AT_STORE();
    __syncthreads();
    for (int kt0 = 0; kt0 < nkeys; kt0 += 64) {
      { const int kn = kt0 + 64 < nkeys ? kt0 + 64 : kt0; AT_LOAD(kn); }
#pragma unroll
      for (int sub = 0; sub < 2; ++sub) {
        f32x16 S;
#pragma unroll
        for (int e = 0; e < 16; ++e) S[e] = 0.f;
#pragma unroll
        for (int ks = 0; ks < 12; ++ks) { const bf16x8 kf = *(const bf16x8*)(Ks + (sub * 32 + r) * 400 + ks * 32 + h * 16); S = MFMA32(kf, qf[ks], S); }
        float mx = -INFINITY;
#pragma unroll
        for (int e = 0; e < 16; ++e) { S[e] *= SC; mx = fmaxf(mx, S[e]); }
        mx = fmaxf(mx, __shfl_xor(mx, 32));
        const float mnew = fmaxf(mrun, mx);
        const float alpha = __builtin_amdgcn_exp2f(mrun - mnew);
        mrun = mnew;
        float ps = 0.f;
#pragma unroll
        for (int e = 0; e < 16; ++e) { S[e] = __builtin_amdgcn_exp2f(S[e] - mnew); ps += S[e]; }
        lrun = lrun * alpha + ps;
#pragma unroll
        for (int dt = 0; dt < 4; ++dt)
#pragma unroll
          for (int e = 0; e < 16; ++e) O[dt][e] *= alpha;
#pragma unroll
        for (int s = 0; s < 2; ++s) {
          const bf16x8 pf = pack8(S, s);
#pragma unroll
          for (int dt = 0; dt < 4; ++dt) {
            const bf16x8 vf = *(const bf16x8*)(Vs + (dt * 32 + r) * 144 + (sub * 2 + s) * 32 + h * 16);
            O[dt] = MFMA32(vf, pf, O[dt]);
          }
        }
      }
      __syncthreads();
      AT_STORE();
      __syncthreads();
    }
#undef AT_LOAD
#undef AT_STORE
    lrun += __shfl_xor(lrun, 32);
    const float inv = 1.f / lrun;
#pragma unroll
    for (int dt = 0; dt < 4; ++dt)
#pragma unroll
      for (int g = 0; g < 4; ++g) {
        const size_t o = (size_t)(T0 + r) * 2048 + head * 128 + dt * 32 + 8 * g + 4 * h;
        const size_t oo = (size_t)(T0 + r) * LDH + head * 128 + dt * 32 + 8 * g + 4 * h;
        const u32x2 sg = *(const u32x2*)(SG + o);
        st_bf4(OG + oo, O[dt][4 * g] * inv * bflo(sg.x), O[dt][4 * g + 1] * inv * bfhi(sg.x), O[dt][4 * g + 2] * inv * bflo(sg.y), O[dt][4 * g + 3] * inv * bfhi(sg.y));
      }
  }
}

DI void gemm_out(const Params& p, const u16* A, const u16* Wt, char* smem) {
  u16* OP = (u16*)(p.ws + WS_OP);
  auto epi = [&](int tm, int tn, const f32x16& acc, int r, int h) {
    const size_t m = tm + r;
#pragma unroll
    for (int g = 0; g < 4; ++g) st_bf4(OP + m * 2048 + tn + 8 * g + 4 * h, acc[4 * g], acc[4 * g + 1], acc[4 * g + 2], acc[4 * g + 3]);
  };
  const int wv_ = __builtin_amdgcn_readfirstlane(tid_() >> 6);
  for_tiles(96, 16, [&](int mt, int nt) { gemm_tile<128, true>(wv_, A, LDH, Wt, LDW, 2048, mt * 128, nt * 128, epi, smem); });
}

DI void s5_g1(const Params& p, char* smem) {
  char* ws = p.ws;
  const u16* H = (const u16*)(ws + WS_H); const u16* Wt = (const u16*)(ws + WS_WT_S5_IN);
  u16* U = (u16*)(ws + B_U); u16* SG = (u16*)(ws + B_SGATE);
  auto epi = [&](int tm, int tn, const f32x16& acc, int r, int h) {
    const size_t m = tm + r;
    if (tn < 2048) {
#pragma unroll
      for (int g = 0; g < 4; ++g) st_bf4(U + m * 2048 + tn + 8 * g + 4 * h, acc[4 * g], acc[4 * g + 1], acc[4 * g + 2], acc[4 * g + 3]);
    } else {
#pragma unroll
      for (int g = 0; g < 4; ++g) st_bf4(SG + m * 2048 + (tn - 2048) + 8 * g + 4 * h, siluf(acc[4 * g]), siluf(acc[4 * g + 1]), siluf(acc[4 * g + 2]), siluf(acc[4 * g + 3]));
    }
  };
  const int wv_ = __builtin_amdgcn_readfirstlane(tid_() >> 6);
  for_tiles(48, 32, [&](int mt, int nt) { gemm_tile<256, true>(wv_, H, LDH, Wt, LDW, 2048, mt * 256, nt * 128, epi, smem); });
}

DI void s5_scan(const Params& p, char* smem) {
  char* ws = p.ws;
  const u16* U = (const u16*)(ws + B_U);
  u16* YF = (u16*)(ws + WS_OP); u16* YB = (u16*)(ws + B_YB);
  const int tid = tid_();
  const int lane = tid & 63;
  const int w = __builtin_amdgcn_readfirstlane(tid >> 6);
  char* Hs = smem + w * 12800;
  char* BUs = Hs + 4352;
  const int pcol = lane & 15, quad = lane >> 4;
  for (int it = blockIdx.x * 4 + w; it < 6144; it += gridDim.x * 4) {
    const int g = ((it >> 2) & 31) * 4 + (it & 3);
    const int db = it >> 7, dir = db & 1, bseq = db >> 1;
    const bool lat = bseq < 8;
    int b, L, T0;
    if (lat) { b = bseq; L = 1024; T0 = NCTX + b * 1024; }
    else { b = bseq - 8; L = 256; T0 = b * 256; }
    const int n = lane;
    const int pidx = (dir * 128 + g) * 64 + n;
    const float are = p.s5_a_re[pidx], aim = p.s5_a_im[pidx];
    const float dt = __expf(p.s5_log_dt[dir * 128 + g]);
    const float mag = __expf(are * dt), rev = (aim * dt) * 0.15915494309189533577f;
    const float abr = mag * __builtin_amdgcn_cosf(rev), abi = mag * __builtin_amdgcn_sinf(rev);
    const float nr = abr - 1.f, ni = abi, den = 1.f / (are * are + aim * aim);
    const float cr = (nr * are + ni * aim) * den, ci = (ni * are - nr * aim) * den;
    {
      const float* br = p.s5_b_re + (size_t)pidx * 16; const float* bi = p.s5_b_im + (size_t)pidx * 16;
      u32x4 re0, re1, im0, im1;
      {
        const f32x4 x0 = *(const f32x4*)(br), x1 = *(const f32x4*)(br + 4), x2 = *(const f32x4*)(br + 8), x3 = *(const f32x4*)(br + 12);
        const f32x4 y0 = *(const f32x4*)(bi), y1 = *(const f32x4*)(bi + 4), y2 = *(const f32x4*)(bi + 8), y3 = *(const f32x4*)(bi + 12);
        const f32x4 r0 = cr * x0 - ci * y0, r1 = cr * x1 - ci * y1, r2 = cr * x2 - ci * y2, r3 = cr * x3 - ci * y3;
        const f32x4 i0 = cr * y0 + ci * x0, i1 = cr * y1 + ci * x1, i2 = cr * y2 + ci * x2, i3 = cr * y3 + ci * x3;
        re0.x = pk2(r0[0], r0[1]); re0.y = pk2(r0[2], r0[3]); re0.z = pk2(r1[0], r1[1]); re0.w = pk2(r1[2], r1[3]);
        re1.x = pk2(r2[0], r2[1]); re1.y = pk2(r2[2], r2[3]); re1.z = pk2(r3[0], r3[1]); re1.w = pk2(r3[2], r3[3]);
        im0.x = pk2(i0[0], i0[1]); im0.y = pk2(i0[2], i0[3]); im0.z = pk2(i1[0], i1[1]); im0.w = pk2(i1[2], i1[3]);
        im1.x = pk2(i2[0], i2[1]); im1.y = pk2(i2[2], i2[3]); im1.z = pk2(i3[0], i3[1]); im1.w = pk2(i3[2], i3[3]);
      }
      char* d = BUs + n * 64;
      *(u32x4*)(d) = re0; *(u32x4*)(d + 16) = re1; *(u32x4*)(d + 32) = im0; *(u32x4*)(d + 48) = im1;
    }
    bf16x8 bfr[8];
#pragma unroll
    for (int nt = 0; nt < 8; ++nt) {
      u32x4 v = {0u, 0u, 0u, 0u};
      if (quad < 2) v = *(const u32x4*)(BUs + (16 * nt + pcol) * 32 + quad * 16);
      bfr[nt] = __builtin_bit_cast(bf16x8, v);
    }
    bf16x8 cf[4];
    {
      const float* c1 = p.s5_c_re + ((size_t)(dir * 128 + g) * 16 + pcol) * 64; const float* c2 = p.s5_c_im + ((size_t)(dir * 128 + g) * 16 + pcol) * 64;
#pragma unroll
      for (int s = 0; s < 4; ++s) {
        const f32x4 x = *(const f32x4*)(c1 + 16 * s + 4 * quad), y = *(const f32x4*)(c2 + 16 * s + 4 * quad);
        u32x4 pk; pk.x = pk2(x[0], -y[0]); pk.y = pk2(x[1], -y[1]); pk.z = pk2(x[2], -y[2]); pk.w = pk2(x[3], -y[3]);
        cf[s] = __builtin_bit_cast(bf16x8, pk);
      }
    }
    float hr = 0.f, hi = 0.f;
    if (lat) { const float* s0 = p.state_s5 + ((size_t)((b * 2 + dir) * 128 + g) * 64 + n) * 2; hr = s0[0]; hi = s0[1]; }
    u16* Y = dir ? YB : YF;
    const int t0 = dir ? L - 1 : 0, tstep = dir ? -1 : 1;
    const u16* ub = U + (size_t)T0 * 2048 + g * 16 + (quad & 1) * 8;
    u32x4 ua = {0u, 0u, 0u, 0u};
    if (quad < 2) ua = *(const u32x4*)(ub + (size_t)(t0 + tstep * pcol) * 2048);
    for (int s0_ = 0; s0_ < L; s0_ += 16) {
      const int tchunk = t0 + tstep * s0_;
      const bf16x8 af = __builtin_bit_cast(bf16x8, ua);
      if (s0_ + 16 < L && quad < 2) ua = *(const u32x4*)(ub + (size_t)(tchunk + tstep * (16 + pcol)) * 2048);
#pragma unroll
      for (int nt = 0; nt < 8; ++nt) {
        f32x4 z = {0.f, 0.f, 0.f, 0.f};
        z = __builtin_amdgcn_mfma_f32_16x16x32_bf16(af, bfr[nt], z, 0, 0, 0);
#pragma unroll
        for (int i = 0; i < 4; ++i) *(float*)(BUs + (4 * quad + i) * 528 + (16 * nt + pcol) * 4) = z[i];
      }
#pragma unroll 4
      for (int row = 0; row < 16; ++row) {
        const f32x2 bu = *(const f32x2*)(BUs + row * 528 + n * 8);
        const float nhr = abr * hr - abi * hi + bu.x, nhi = abr * hi + abi * hr + bu.y;
        hr = nhr; hi = nhi;
        if (!lat && s0_ == 0 && row == 0) { float* so = p.out + OUT_S5 + ((size_t)((b * 2 + dir) * 128 + g) * 64 + n) * 2; so[0] = hr; so[1] = hi; }
        *(unsigned*)(Hs + row * 272 + n * 4) = pk2(hr, hi);
      }
      f32x4 yacc = {0.f, 0.f, 0.f, 0.f};
#pragma unroll
      for (int s = 0; s < 4; ++s) {
        const bf16x8 hf = *(const bf16x8*)(Hs + pcol * 272 + s * 64 + quad * 16);
        yacc = __builtin_amdgcn_mfma_f32_16x16x32_bf16(hf, cf[s], yacc, 0, 0, 0);
      }
#pragma unroll
      for (int i = 0; i < 4; ++i) { const int tok = tchunk + tstep * (4 * quad + i); Y[(size_t)(T0 + tok) * 2048 + g * 16 + pcol] = f2bf(yacc[i]); }
    }
  }
}

DI float gelu_tanh(float x) {
  const float t = 0.7978845608028654f * (x + 0.044715f * x * x * x);
  const float e = __expf(2.f * t);
  const float th = 1.f - 2.f / (e + 1.f);
  return 0.5f * x * (1.f + th);
}

DI void s5_combine(const Params& p) {
  char* ws = p.ws;
  const u16* U = (const u16*)(ws + B_U); const u16* YF = (const u16*)(ws + WS_OP); const u16* YB = (const u16*)(ws + B_YB);
  u16* YG = (u16*)(ws + WS_H);
  const size_t n4 = (size_t)NTOK * 2048 / 4;
  for (size_t i = (size_t)blockIdx.x * 256 + tid_(); i < n4; i += (size_t)gridDim.x * 256) {
    const int col = (int)((i * 4) & 2047);
    const f32x4 u = ld_bf4(U + i * 4), a = ld_bf4(YF + i * 4), b = ld_bf4(YB + i * 4), d = *(const f32x4*)(p.s5_d + col);
    const f32x4 y = d * u + a + b;
    st_bf4(YG + ((i * 4) >> 11) * LDH + col, gelu_tanh(y[0]), gelu_tanh(y[1]), gelu_tanh(y[2]), gelu_tanh(y[3]));
  }
}

DI void s5_g2(const Params& p, char* smem) {
  char* ws = p.ws;
  const u16* YG = (const u16*)(ws + WS_H); const u16* Wt = (const u16*)(ws + WS_WT_S5_GLU); const u16* SG = (const u16*)(ws + B_SGATE);
  u16* Z = (u16*)(ws + B_Z);
  auto epi = [&](int tm, int tn, const f32x16& acc, int r, int h) {
    const size_t m = tm + r;
#pragma unroll
    for (int g = 0; g < 4; ++g) {
      const int n = tn + 8 * g + 4 * h;
      const f32x4 bg = *(const f32x4*)(p.s5_b_glu + n);
      const u32x2 yv = *(const u32x2*)(YG + m * LDH + n), sg = *(const u32x2*)(SG + m * 2048 + n);
      st_bf4(Z + m * LDH + n, bflo(yv.x) * sigmf(acc[4 * g] + bg[0]) * bflo(sg.x), bfhi(yv.x) * sigmf(acc[4 * g + 1] + bg[1]) * bfhi(sg.x),
             bflo(yv.y) * sigmf(acc[4 * g + 2] + bg[2]) * bflo(sg.y), bfhi(yv.y) * sigmf(acc[4 * g + 3] + bg[3]) * bfhi(sg.y));
    }
  };
  const int wv_ = __builtin_amdgcn_readfirstlane(tid_() >> 6);
  for_tiles(96, 16, [&](int mt, int nt) { gemm_tile<128, true>(wv_, YG, LDH, Wt, LDW, 2048, mt * 128, nt * 128, epi, smem); });
}

DI void gla_g1(const Params& p, char* smem) {
  char* ws = p.ws;
  const u16* H = (const u16*)(ws + WS_H); const u16* Wt = (const u16*)(ws + WS_WT_GLA_IN);
  u16* VT = (u16*)(ws + C_VT);
  auto epi = [&](int tm, int tn, const f32x16& acc, int r, int h) {
    char* ws2 = p.ws;
    u16* QG = (u16*)(ws2 + C_QG); u16* KG = (u16*)(ws2 + C_KG); u16* SG = (u16*)(ws2 + C_SGATE); float* GLR = (float*)(ws2 + C_GLR);
    const size_t m = tm + r;
    if (tn < 1024) {
#pragma unroll
      for (int g = 0; g < 4; ++g) st_bf4(QG + m * 1024 + tn + 8 * g + 4 * h, acc[4 * g] * 0.0625f, acc[4 * g + 1] * 0.0625f, acc[4 * g + 2] * 0.0625f, acc[4 * g + 3] * 0.0625f);
    } else if (tn < 2048) {
#pragma unroll
      for (int g = 0; g < 4; ++g) st_bf4(KG + m * 1024 + (tn - 1024) + 8 * g + 4 * h, acc[4 * g], acc[4 * g + 1], acc[4 * g + 2], acc[4 * g + 3]);
    } else if (tn >= 4096 && tn < 6144) {
#pragma unroll
      for (int g = 0; g < 4; ++g) st_bf4(SG + m * 2048 + (tn - 4096) + 8 * g + 4 * h, siluf(acc[4 * g]), siluf(acc[4 * g + 1]), siluf(acc[4 * g + 2]), siluf(acc[4 * g + 3]));
    } else if (tn == 6144) {
#pragma unroll
      for (int g = 0; g < 4; ++g) { f32x4 o = {acc[4 * g], acc[4 * g + 1], acc[4 * g + 2], acc[4 * g + 3]}; *(f32x4*)(GLR + m * 32 + 8 * g + 4 * h) = o; }
    }
  };
  auto epiV = [&](int tm, int tn, const f32x16& acc, int r, int h) {
    const int dv = tn - 2048 + r;
    u16* dst = VT + ((size_t)(tm >> 6) * 2048 + dv) * 64 + (tm & 63);
#pragma unroll
    for (int g = 0; g < 4; ++g) st_bf4(dst + 8 * g + 4 * h, acc[4 * g], acc[4 * g + 1], acc[4 * g + 2], acc[4 * g + 3]);
  };
  const int wv_ = __builtin_amdgcn_readfirstlane(tid_() >> 6);
  for_tiles(48, 49, [&](int mt, int nt) {
    if (nt >= 16 && nt < 32) gemm_tile<256, false>(wv_, H, LDH, Wt, LDW, 2048, mt * 256, nt * 128, epiV, smem);
    else gemm_tile<256, true>(wv_, H, LDH, Wt, LDW, 2048, mt * 256, nt * 128, epi, smem);
  });
}

DI float logsigf(float z) { return fminf(z, 0.f) - __logf(1.f + __expf(-fabsf(z))); }

DI void gla_gate(const Params& p, float* smem) {
  char* ws = p.ws;
  const u16* QG = (const u16*)(ws + C_QG); const u16* KG = (const u16*)(ws + C_KG); const float* GLR = (const float*)(ws + C_GLR);
  u16* QT = (u16*)(ws + C_QT); u16* KT = (u16*)(ws + C_KT); u16* KDT = (u16*)(ws + C_KDT); float* DN = (float*)(ws + C_DN);
  const int tid = tid_();
  for (int it = blockIdx.x; it < 1536; it += gridDim.x) {
    const int dir = it & 1, hd = (it >> 1) & 3, c = it >> 3;
    const int ch = hd * 256 + tid;
    __syncthreads();
    for (int i = tid; i < 1024; i += 256) smem[i] = GLR[(size_t)(c * 64 + (i >> 4)) * 32 + dir * 16 + (i & 15)];
    __syncthreads();
    float wg[16];
#pragma unroll
    for (int q = 0; q < 16; ++q) wg[q] = p.gla_w_g2[(size_t)(dir * 16 + q) * 1024 + ch];
    const float bg = p.gla_b_g[dir * 1024 + ch];
    float tot = 0.f;
    for (int i = 0; i < 64; ++i) {
      float z = bg;
#pragma unroll
      for (int q = 0; q < 16; ++q) z += smem[i * 16 + q] * wg[q];
      tot += logsigf(z) * 0.0625f;
    }
    DN[(size_t)(dir * 192 + c) * 1024 + ch] = __expf(tot);
    float run = 0.f;
    u16* kdrow = KDT + ((size_t)((dir * 192 + c) * 4 + hd) * 256 + tid) * 64;
    for (int i8 = 0; i8 < 8; ++i8) {
      float kdv[8];
#pragma unroll
      for (int e = 0; e < 8; ++e) {
        const int ii = i8 * 8 + e;
        const int i = dir ? 63 - ii : ii;
        float z = bg;
#pragma unroll
        for (int q = 0; q < 16; ++q) z += smem[i * 16 + q] * wg[q];
        run += logsigf(z) * 0.0625f;
        const size_t T = (size_t)c * 64 + i;
        const float q_ = bf2f(QG[T * 1024 + ch]), k_ = bf2f(KG[T * 1024 + ch]);
        QT[((size_t)dir * NTOK + T) * LDQ + ch] = f2bf(q_ * __expf(run));
        KT[((size_t)dir * NTOK + T) * LDQ + ch] = f2bf(k_ * __expf(-run));
        kdv[e] = k_ * __expf(tot - run);
      }
      u32x4 pk;
      if (dir) { pk.x = pk2(kdv[7], kdv[6]); pk.y = pk2(kdv[5], kdv[4]); pk.z = pk2(kdv[3], kdv[2]); pk.w = pk2(kdv[1], kdv[0]); }
      else { pk.x = pk2(kdv[0], kdv[1]); pk.y = pk2(kdv[2], kdv[3]); pk.z = pk2(kdv[4], kdv[5]); pk.w = pk2(kdv[6], kdv[7]); }
      const int tb = dir ? 56 - i8 * 8 : i8 * 8;
      *(u32x4*)(kdrow + tb) = pk;
    }
  }
  __syncthreads();
}

DI void gla_main(const Params& p, char* smem) {
  char* ws = p.ws;
  const u16* QT = (const u16*)(ws + C_QT); const u16* KT = (const u16*)(ws + C_KT); const u16* KDT = (const u16*)(ws + C_KDT); const u16* VT = (const u16*)(ws + C_VT);
  const float* DN = (const float*)(ws + C_DN);
  u16* OF = (u16*)(ws + WS_OP); u16* OB = (u16*)(ws + C_OB);
  char* buf = smem;
  u16* att = (u16*)(smem + 36864);
  float* dns = (float*)(smem + 36864 + 9216);
  const int tid = tid_();
  const int lane = tid & 63, w = tid >> 6, r = lane & 31, h = lane >> 5;
  int it0, itn, its;
  if (gridDim.x == 512) { if (blockIdx.x < 256) { it0 = blockIdx.x; itn = 1; } else { it0 = 256 + ((int)blockIdx.x - 256) * 2; itn = 2; } its = 1; }
  else { it0 = blockIdx.x; its = gridDim.x; itn = it0 < 768 ? (768 - it0 + its - 1) / its : 0; }
  for (int qi = 0; qi < itn; ++qi) {
    const int it = it0 + qi * its;
    const bool lat = it < 256;
    const int i2 = lat ? it : it - 256;
    const int bs = i2 >> 5, hd = (i2 >> 3) & 3, dir = (i2 >> 2) & 1, sl = i2 & 3;
    const int nc = lat ? 16 : 4, T0 = lat ? NCTX + bs * 1024 : bs * 256;
    const int vcol0 = hd * 512 + sl * 128 + w * 32;
    f32x16 S[8];
    if (lat) {
      const float* s0 = p.state_gla + ((size_t)((bs * 2 + dir) * 4 + hd) * 256) * 512 + (sl * 128 + w * 32 + r);
#pragma unroll
      for (int mt = 0; mt < 8; ++mt)
#pragma unroll
        for (int e = 0; e < 16; ++e) S[mt][e] = s0[(size_t)(32 * mt + crow(e, h)) * 512];
    } else {
#pragma unroll
      for (int mt = 0; mt < 8; ++mt)
#pragma unroll
        for (int e = 0; e < 16; ++e) S[mt][e] = 0.f;
    }
    u16* OD = dir ? OB : OF;
    for (int cc = 0; cc < nc; ++cc) {
      const int c = dir ? nc - 1 - cc : cc;
      const int Tc = T0 + c * 64, cgx = Tc >> 6;
      const u16* kt = KT + ((size_t)dir * NTOK + Tc) * LDQ + hd * 256;
      const u16* kdT = KDT + ((size_t)((dir * 192 + cgx) * 4 + hd) * 256) * 64;
      const u16* vT = VT + ((size_t)cgx * 2048 + vcol0 + r) * 64;
      {
        u32x4 rq[8];
        const u16* qt = QT + ((size_t)dir * NTOK + Tc) * LDQ + hd * 256;
        const __amdgpu_buffer_rsrc_t qrs = __builtin_amdgcn_make_buffer_rsrc((void*)qt, 0, 0x7fffffff, 0x00020000);
#pragma unroll
        for (int i = 0; i < 8; ++i) rq[i] = __builtin_bit_cast(u32x4, __builtin_amdgcn_raw_buffer_load_b128(qrs, (tid >> 5) * (LDQ * 2) + (tid & 31) * 16, i * 8 * (LDQ * 2), 0));
        const float dnv = DN[(size_t)(dir * 192 + cgx) * 1024 + hd * 256 + tid];
        __syncthreads();
#pragma unroll
        for (int i = 0; i < 8; ++i) *(u32x4*)(buf + ((tid >> 5) + 8 * i) * 528 + (tid & 31) * 16) = rq[i];
        dns[tid] = dnv;
        __syncthreads();
      }
      {
        f32x16 a;
#pragma unroll
        for (int e = 0; e < 16; ++e) a[e] = 0.f;
        const int ci = w >> 1, si = w & 1;
        const char* qa = buf + (32 * ci + r) * 528 + h * 16; const u16* kb = kt + (size_t)(32 * si + r) * LDQ + 8 * h;
#pragma unroll
        for (int ks = 0; ks < 16; ++ks) a = MFMA32(*(const bf16x8*)(qa + ks * 32), *(const bf16x8*)(kb + ks * 16), a);
#pragma unroll
        for (int e = 0; e < 16; ++e) {
          const int cr_ = 32 * ci + crow(e, h), sc_ = 32 * si + r;
          const bool keep = dir ? (sc_ >= cr_) : (sc_ <= cr_);
          att[cr_ * 72 + sc_] = keep ? f2bf(a[e]) : (u16)0;
        }
      }
      f32x16 o[2];
#pragma unroll
      for (int q = 0; q < 2; ++q)
#pragma unroll
        for (int e = 0; e < 16; ++e) o[q][e] = 0.f;
#pragma unroll
      for (int mt = 0; mt < 8; ++mt)
#pragma unroll
        for (int s = 0; s < 2; ++s) {
          const bf16x8 sf = pack8(S[mt], s);
#pragma unroll
          for (int q = 0; q < 2; ++q) {
            const char* qa = buf + (32 * q + r) * 528 + (32 * mt + 16 * s + 4 * h) * 2;
            const s16x4 lo = *(const s16x4*)qa, hi = *(const s16x4*)(qa + 16);
            o[q] = MFMA32(cat4(lo, hi), sf, o[q]);
          }
        }
      {
        u32x4 rq[8];
        const __amdgpu_buffer_rsrc_t krs = __builtin_amdgcn_make_buffer_rsrc((void*)kdT, 0, 0x7fffffff, 0x00020000);
#pragma unroll
        for (int i = 0; i < 8; ++i) rq[i] = __builtin_bit_cast(u32x4, __builtin_amdgcn_raw_buffer_load_b128(krs, tid * 16, i * 4096, 0));
        __syncthreads();
#pragma unroll
        for (int i = 0; i < 8; ++i) *(u32x4*)(buf + ((tid >> 3) + 32 * i) * 144 + (tid & 7) * 16) = rq[i];
        __syncthreads();
      }
      bf16x8 vf[4];
#pragma unroll
      for (int ks = 0; ks < 4; ++ks) vf[ks] = *(const bf16x8*)(vT + ks * 16 + 8 * h);
#pragma unroll
      for (int q = 0; q < 2; ++q)
#pragma unroll
        for (int ks = 0; ks < 4; ++ks) { const bf16x8 af = *(const bf16x8*)(att + (32 * q + r) * 72 + ks * 16 + 8 * h); o[q] = MFMA32(af, vf[ks], o[q]); }
#pragma unroll
      for (int q = 0; q < 2; ++q)
#pragma unroll
        for (int e = 0; e < 16; ++e) OD[(size_t)(Tc + 32 * q + crow(e, h)) * 2048 + vcol0 + r] = f2bf(o[q][e]);
#pragma unroll
      for (int mt = 0; mt < 8; ++mt) {
#pragma unroll
        for (int g = 0; g < 4; ++g) {
          const f32x4 d4 = *(const f32x4*)(dns + 32 * mt + 8 * g + 4 * h);
#pragma unroll
          for (int e = 0; e < 4; ++e) S[mt][4 * g + e] *= d4[e];
        }
#pragma unroll
        for (int ks = 0; ks < 4; ++ks) { const bf16x8 af = *(const bf16x8*)(buf + (32 * mt + r) * 144 + ks * 32 + h * 16); S[mt] = MFMA32(af, vf[ks], S[mt]); }
      }
    }
    if (!lat) {
      float* so = p.out + OUT_GLA + ((size_t)((bs * 2 + dir) * 4 + hd) * 256) * 512 + (sl * 128 + w * 32 + r);
#pragma unroll
      for (int mt = 0; mt < 8; ++mt)
#pragma unroll
        for (int e = 0; e < 16; ++e) so[(size_t)(32 * mt + crow(e, h)) * 512] = S[mt][e];
    }
  }
  __syncthreads();
}

DI void gla_norm(const Params& p) {
  char* ws = p.ws;
  const u16* OF = (const u16*)(ws + WS_OP); const u16* OB = (const u16*)(ws + C_OB); const u16* SG = (const u16*)(ws + C_SGATE);
  u16* OG = (u16*)(ws + WS_H);
  const int lane = tid_() & 63, wv = tid_() >> 6;
  for (int T = blockIdx.x * 4 + wv; T < NTOK; T += gridDim.x * 4) {
    f32x4 x[8];
    float ss[4] = {0.f, 0.f, 0.f, 0.f};
#pragma unroll
    for (int j = 0; j < 8; ++j) {
      const size_t o = (size_t)T * 2048 + (j * 64 + lane) * 4;
      x[j] = ld_bf4(OF + o) + ld_bf4(OB + o);
      ss[j >> 1] += x[j][0] * x[j][0] + x[j][1] * x[j][1] + x[j][2] * x[j][2] + x[j][3] * x[j][3];
    }
#pragma unroll
    for (int q = 0; q < 4; ++q) ss[q] = rsqrtf(wave_sum(ss[q]) * (1.f / 512.f) + EPS);
#pragma unroll
    for (int j = 0; j < 8; ++j) {
      const int col = (j * 64 + lane) * 4;
      const size_t o = (size_t)T * 2048 + col;
      const f32x4 ng = *(const f32x4*)(p.gla_norm + (col & 511));
      const u32x2 sg = *(const u32x2*)(SG + o);
      const f32x4 y = x[j] * ss[j >> 1] * ng;
      st_bf4(OG + (size_t)T * LDH + col, y[0] * bflo(sg.x), y[1] * bfhi(sg.x), y[2] * bflo(sg.y), y[3] * bfhi(sg.y));
    }
  }
}

#define XB_TMO      128
#define XB_XCNT(j)  (256  + 64 * (j))
#define XB_XSUB(j)  (1280 + 64 * (j))
#define XB_XGEN(j)  (2304 + 64 * (j))
#define XB_TOP      3328
#define XB_TOPGEN   3392
#define XCD_BAR_WORDS 3456
#define XB_SPIN_CAP (1u << 18)
#define LAS __attribute__((address_space(3)))
DI unsigned xb_ld(unsigned* p) { return __hip_atomic_load(p, __ATOMIC_RELAXED, __HIP_MEMORY_SCOPE_AGENT); }
DI unsigned xb_add(unsigned* p, unsigned v) { return __hip_atomic_fetch_add(p, v, __ATOMIC_RELAXED, __HIP_MEMORY_SCOPE_AGENT); }
DI unsigned xb_xcc_id() { return (unsigned)__builtin_amdgcn_s_getreg((3 << 11) | 20) & 0xFu; }
#define XB_SPIN(cond, bar) do { unsigned _sp = 0; while (cond) { __builtin_amdgcn_s_sleep(1); \
    if ((++_sp & 255u) == 0u) { if (xb_ld(&(bar)[XB_TMO])) break; if (_sp > XB_SPIN_CAP) { atomicAdd(&(bar)[XB_TMO], 1u); break; } } } } while (0)
struct XcdBarrier { unsigned* bar; unsigned x; volatile LAS unsigned* st; };
DI XcdBarrier xcd_barrier_post(unsigned* bar, volatile LAS unsigned* st) {
  XcdBarrier b; b.bar = bar; b.x = xb_xcc_id(); b.st = st;
  if (threadIdx.x == 0) (void)xb_add(&bar[XB_XCNT(b.x)], 1u);
  return b;
}
DI void xcd_barrier_complete(unsigned* bar, unsigned x, unsigned& nloc, unsigned& nx) {
  const unsigned G = gridDim.x * gridDim.y * gridDim.z;
  unsigned sum, cnt, mine, sp = 0u;
  for (;;) {
    sum = 0u; cnt = 0u; mine = 0u;
#pragma unroll
    for (unsigned j = 0; j < 16; ++j) { const unsigned c = xb_ld(&bar[XB_XCNT(j)]); sum += c; cnt += (c > 0u) ? 1u : 0u; mine = (j == x) ? c : mine; }
    if (sum == G) break;
    __builtin_amdgcn_s_sleep(1);
    if ((++sp & 255u) == 0u) { if (xb_ld(&bar[XB_TMO])) break; if (sp > XB_SPIN_CAP) { atomicAdd(&bar[XB_TMO], 1u); break; } }
  }
  nloc = mine > 0u ? mine : 1u; nx = cnt > 0u ? cnt : 1u;
}
DI void xcd_barrier(const XcdBarrier& b) {
  asm volatile("s_waitcnt vmcnt(0)" ::: "memory");
  __syncthreads();
  if (threadIdx.x == 0) {
    unsigned* bar = b.bar;
    __builtin_amdgcn_s_waitcnt(0);
    unsigned nloc = b.st[0], nx = b.st[1];
    if (nloc == 0u) { xcd_barrier_complete(bar, b.x, nloc, nx); b.st[0] = nloc; b.st[1] = nx; }
    const unsigned old = xb_add(&bar[XB_XSUB(b.x)], 1u);
    const unsigned gen = old / nloc;
    if (old + 1u == (gen + 1u) * nloc) {
      __builtin_amdgcn_fence(__ATOMIC_RELEASE, "agent");
      asm volatile("s_waitcnt vmcnt(0)" ::: "memory");
      const unsigned og = xb_add(&bar[XB_TOP], 1u);
      const unsigned tg = og / nx;
      if (og + 1u == (tg + 1u) * nx) xb_add(&bar[XB_TOPGEN], 1u);
      else XB_SPIN(xb_ld(&bar[XB_TOPGEN]) == tg, bar);
      __builtin_amdgcn_fence(__ATOMIC_ACQUIRE, "agent");
      xb_add(&bar[XB_XGEN(b.x)], 1u);
      asm volatile("s_waitcnt vmcnt(0)" ::: "memory");
    } else {
      XB_SPIN(xb_ld(&bar[XB_XGEN(b.x)]) == gen, bar);
      __builtin_amdgcn_fence(__ATOMIC_ACQUIRE, "agent");
      asm volatile("s_waitcnt vmcnt(0)" ::: "memory");
    }
  }
  __syncthreads();
}

constexpr int NPHASE = 26;
#ifndef DUPMASK
#define DUPMASK 0u
#endif
template <int PH>
DI void run_phase(const Params& p, char* smem) {
  char* ws = p.ws;
  if constexpr (PH == 0) phase0(p, smem);
  else if constexpr (PH == 1) norm_phase(p, 0, true);
  else if constexpr (PH == 2) mla_g1(p, 0, smem);
  else if constexpr (PH == 3) mla_a2(p, 0);
  else if constexpr (PH == 4) mla_g2(p, 0, smem);
  else if constexpr (PH == 5) mla_attn(p, smem);
  else if constexpr (PH == 6) gemm_out(p, (const u16*)(ws + WS_H), (const u16*)(ws + WS_WT_MLA_OUT), smem);
  else if constexpr (PH == 7) norm_phase(p, 1, false);
  else if constexpr (PH == 8) s5_g1(p, smem);
  else if constexpr (PH == 9) s5_scan(p, smem);
  else if constexpr (PH == 10) s5_combine(p);
  else if constexpr (PH == 11) s5_g2(p, smem);
  else if constexpr (PH == 12) gemm_out(p, (const u16*)(ws + B_Z), (const u16*)(ws + WS_WT_S5_OUT), smem);
  else if constexpr (PH == 13) norm_phase(p, 2, false);
  else if constexpr (PH == 14) gla_g1(p, smem);
  else if constexpr (PH == 15) gla_gate(p, (float*)smem);
  else if constexpr (PH == 16) gla_main(p, smem);
  else if constexpr (PH == 17) gla_norm(p);
  else if constexpr (PH == 18) gemm_out(p, (const u16*)(ws + WS_H), (const u16*)(ws + WS_WT_GLA_OUT), smem);
  else if constexpr (PH == 19) norm_phase(p, 3, false);
  else if constexpr (PH == 20) mla_g1(p, 1, smem);
  else if constexpr (PH == 21) mla_a2(p, 1);
  else if constexpr (PH == 22) mla_g2(p, 1, smem);
  else if constexpr (PH == 23) mla_attn(p, smem);
  else if constexpr (PH == 24) gemm_out(p, (const u16*)(ws + WS_H), (const u16*)(ws + WS_WT_MLA_OUT) + (size_t)2048 * LDW, smem);
  else if constexpr (PH == 25) norm_phase(p, 4, false);
}

template <int PH>
DI void run_from(const Params& p, char* smem, const XcdBarrier& xb) {
  run_phase<PH>(p, smem);
  if constexpr ((DUPMASK >> PH) & 1u) { __syncthreads(); run_phase<PH>(p, smem); }
  if constexpr (PH + 1 < NPHASE) { xcd_barrier(xb); run_from<PH + 1>(p, smem, xb); }
}

#if COOP
__global__ void __launch_bounds__(256, 2) mega(Params p) {
  __shared__ __attribute__((aligned(16))) char smem[73728];
  __shared__ uint4 xb_words;
  cg::grid_group grid = cg::this_grid();
  if (p.out == nullptr) grid.sync();
  if (threadIdx.x == 0) xb_words = make_uint4(0u, 0u, 0u, 0u);
  __syncthreads();
  const XcdBarrier xb = xcd_barrier_post((unsigned*)(p.ws + WS_BAR), (volatile LAS unsigned*)&xb_words);
  run_from<0>(p, smem, xb);
}
#else
template <int PH>
__global__ void __launch_bounds__(256, 2) phase_k(Params p) {
  __shared__ __attribute__((aligned(16))) char smem[73728];
  run_phase<PH>(p, smem);
}
template <int PH>
static void launch_from(const Params& p, int grid, hipStream_t stream) {
  hipLaunchKernelGGL(phase_k<PH>, dim3(grid), dim3(256), 0, stream, p);
  if constexpr (PH + 1 < NPHASE) launch_from<PH + 1>(p, grid, stream);
}
#endif

extern "C" void kernel_launch(void* const* d_in, const int* in_sizes, int n_in, void* d_out, int out_size, void* d_ws, size_t ws_size, hipStream_t stream) {
  static int grid_blocks = 0;
  if (!grid_blocks) {
    int dev = 0, cus = 0, per_cu = 0;
    (void)hipGetDevice(&dev);
    (void)hipDeviceGetAttribute(&cus, hipDeviceAttributeMultiprocessorCount, dev);
#if COOP
    (void)hipOccupancyMaxActiveBlocksPerMultiprocessor(&per_cu, mega, 256, 0);
#else
    per_cu = 2;
#endif
    if (per_cu < 1) per_cu = 1;
    if (per_cu > 2) per_cu = 2;
    grid_blocks = cus * per_cu;
  }
  Params p{};
  const float** pp = (const float**)&p;
  for (int i = 0; i < 33; ++i) pp[i] = (const float*)d_in[i];
  p.out = (float*)d_out;
  p.ws = (char*)d_ws;
#if COOP
  (void)hipMemsetAsync(d_ws, 0, XCD_BAR_WORDS * 4, stream);
  void* args[] = {&p};
  hipError_t e = hipLaunchCooperativeKernel((void*)mega, dim3(grid_blocks), dim3(256), args, 0, stream);
  if (e != hipSuccess) fprintf(stderr, "cooperative launch failed: %s (grid %d)\n", hipGetErrorString(e), grid_blocks);
#else
  launch_from<0>(p, grid_blocks, stream);
#endif
}
```
